# Optimizing an MI355X kernel written in HIP

```python
import functools
import jax
import jax.numpy as jnp
from jax import lax
import numpy as np

D_MODEL = 1024
BATCH = 4
SEQ = 4096
DEPTH = 2
DEC_BATCH = 32
DEC_SEQ = 4
PAST_LEN = 16384
PAGE_SIZE = 128

HEAD_DIM = 64
N_ATTN_HEADS = 8
N_MLSTM_HEADS = 4
N_HGRN_HEADS = 4
ATTN_WIDTH = N_ATTN_HEADS * HEAD_DIM
MLSTM_WIDTH = N_MLSTM_HEADS * HEAD_DIM
HGRN_WIDTH = N_HGRN_HEADS * HEAD_DIM
MIX_WIDTH = ATTN_WIDTH + MLSTM_WIDTH + HGRN_WIDTH
PROJ_SPLITS = (ATTN_WIDTH, ATTN_WIDTH, ATTN_WIDTH,
               MLSTM_WIDTH, MLSTM_WIDTH, MLSTM_WIDTH, MLSTM_WIDTH, N_MLSTM_HEADS, N_MLSTM_HEADS,
               HGRN_WIDTH, HGRN_WIDTH, HGRN_WIDTH, HGRN_WIDTH)
PROJ_WIDTH = 3 * ATTN_WIDTH + 4 * MLSTM_WIDTH + 2 * N_MLSTM_HEADS + 4 * HGRN_WIDTH
DILATED_PATTERNS = ((128, 1), (512, 4), (2048, 16))
MAX_WINDOW = 2048
QBLOCK = 128
N_REL_BUCKETS = 32
REL_MAX_DISTANCE = 2048
CONV_WIDTH = 4
MLSTM_CHUNK = 64
HGRN_CHUNK = 64
D_FF = 4 * D_MODEL
EPS = 1e-6
NEG_BIG = -1e30

kernel_name = 'hymba_dilated_mlstm_hgrn2_step'


def rmsnorm(x, g):
    xf = x.astype(jnp.float32)
    y = xf * lax.rsqrt(jnp.mean(xf * xf, axis=-1, keepdims=True) + EPS)
    return (y * g.astype(jnp.float32)).astype(x.dtype)


def head_rmsnorm(h, g):
    y = h * lax.rsqrt(jnp.mean(h * h, axis=-1, keepdims=True) + EPS)
    return y * g.astype(jnp.float32).reshape(h.shape[-2:])


def t5_causal_bucket(dist):
    n = np.asarray(dist).astype(np.int32)
    max_exact = N_REL_BUCKETS // 2
    scaled = np.log(np.maximum(n, 1) / max_exact) / np.log(REL_MAX_DISTANCE / max_exact)
    large = np.minimum(max_exact + (scaled * (N_REL_BUCKETS - max_exact)).astype(np.int32), N_REL_BUCKETS - 1)
    return np.where(n < max_exact, n, large).astype(np.int32)


def dilated_branch_prompt(q, k, v, rel_bias, window, dilation):
    B, S, H, E = q.shape
    ls = S // dilation
    nsub = window // dilation
    nb = -(-ls // QBLOCK)
    lp = nb * QBLOCK

    def to_blocks(t):
        t = jnp.swapaxes(t.reshape(B, ls, dilation, H, E), 1, 2)
        t = jnp.pad(t, ((0, 0), (0, 0), (0, lp - ls), (0, 0), (0, 0)))
        return t.reshape(B, dilation, nb, QBLOCK, H, E)

    def with_prev(t):
        prev = jnp.pad(t, ((0, 0), (0, 0), (1, 0), (0, 0), (0, 0), (0, 0)))[:, :, :-1]
        return jnp.concatenate([prev, t], axis=3)

    def from_blocks(t):
        t = t.reshape((B, dilation, lp) + t.shape[4:])[:, :, :ls]
        t = jnp.swapaxes(t, 1, 2)
        return t.reshape((B, S) + t.shape[3:])

    qb = to_blocks(q)
    kk = with_prev(to_blocks(k))
    vv = with_prev(to_blocks(v))
    s = jnp.einsum('brnqhe,brnkhe->brnhqk', qb, kk, preferred_element_type=jnp.float32) * E ** -0.5
    a = np.arange(QBLOCK)[:, None]
    b = np.arange(2 * QBLOCK)[None, :]
    rel = QBLOCK + a - b
    band = (rel >= 0) & (rel <= nsub)
    bias = jnp.transpose(rel_bias.astype(jnp.float32)[t5_causal_bucket(np.clip(rel, 0, None) * dilation)], (2, 0, 1))
    first = (np.arange(nb) == 0)[:, None, None]
    valid = band[None] & ~(first & (b < QBLOCK)[None])
    s = jnp.where(valid[None, None, :, None], s + bias, NEG_BIG)
    m = jnp.max(s, axis=-1, keepdims=True)
    p = jnp.exp(s - m)
    l = jnp.sum(p, axis=-1, keepdims=True)
    o = jnp.einsum('brnhqk,brnkhe->brnqhe', p, vv.astype(jnp.float32)) / jnp.transpose(l, (0, 1, 2, 4, 3, 5))
    lse = jnp.transpose((m + jnp.log(l))[..., 0], (0, 1, 2, 4, 3))
    return from_blocks(o), from_blocks(lse)


def dilated_branch_sample(q, k_all, v_all, rel_bias, window, dilation, n_past):
    T, E = q.shape[1], q.shape[3]
    j = np.arange(window // dilation + 1)
    idx = n_past + np.arange(T)[:, None] - dilation * j[None, :]
    valid = idx >= 0
    idx = np.maximum(idx, 0)
    kg = k_all[:, idx]
    vg = v_all[:, idx]
    s = jnp.einsum('bthe,btjhe->bhtj', q, kg, preferred_element_type=jnp.float32) * E ** -0.5
    bias = rel_bias.astype(jnp.float32)[t5_causal_bucket(dilation * j)].T
    s = jnp.where(valid[None, None], s + bias[:, None, :], NEG_BIG)
    m = jnp.max(s, axis=-1, keepdims=True)
    p = jnp.exp(s - m)
    l = jnp.sum(p, axis=-1, keepdims=True)
    o = jnp.einsum('bhtj,btjhe->bthe', p, vg.astype(jnp.float32)) / jnp.swapaxes(l, 1, 2)
    lse = jnp.swapaxes((m + jnp.log(l))[..., 0], 1, 2)
    return o, lse


def dilated_mixture(branches):
    outs = jnp.stack([o for o, _ in branches])
    w = jax.nn.softmax(jnp.stack([lse for _, lse in branches]), axis=0)
    return jnp.sum(w[..., None] * outs, axis=0)


def attn_prompt(q, k, v, rel_bias):
    return dilated_mixture([dilated_branch_prompt(q, k, v, rel_bias, w, d) for w, d in DILATED_PATTERNS])


def attn_sample(q, k, v, rel_bias, k_buf, v_buf):
    n_past = k_buf.shape[1]
    k_all = jnp.concatenate([k_buf.astype(k.dtype), k], axis=1)
    v_all = jnp.concatenate([v_buf.astype(v.dtype), v], axis=1)
    return dilated_mixture([dilated_branch_sample(q, k_all, v_all, rel_bias, w, d, n_past) for w, d in DILATED_PATTERNS])


def causal_conv(x, buf, w):
    S = x.shape[1]
    xp = jnp.concatenate([buf.astype(x.dtype), x], axis=1)
    y = xp[:, :S] * w[0]
    for j in range(1, CONV_WIDTH):
        y = y + xp[:, j:j + S] * w[j]
    return y, xp[:, S:]


def _chunk_len(S, C):
    return C if S % C == 0 else S


def _to_chunks(t, L):
    B, S = t.shape[:2]
    t = t.reshape((B, S // L, L) + t.shape[2:])
    return jnp.moveaxis(jnp.moveaxis(t, 1, 0), 3, 2)


def _from_chunks(t):
    nc, B, H, L, E = t.shape
    return jnp.transpose(t, (1, 0, 3, 2, 4)).reshape(B, nc * L, H, E)


def mlstm_chunked(q, k, v, ig, lf, C0, n0, m0):
    S = q.shape[1]
    L = _chunk_len(S, MLSTM_CHUNK)
    causal = np.tril(np.ones((L, L), dtype=bool))

    def step(carry, xs):
        C, n, m = carry
        qc, kc, vc, ic, fc = xs
        b = jnp.cumsum(fc, axis=-1)
        D = jnp.where(causal, b[..., :, None] - b[..., None, :] + ic[..., None, :], NEG_BIG)
        inter = b + m[..., None]
        mt = jnp.maximum(jnp.max(D, axis=-1), inter)
        wts = jnp.exp(D - mt[..., None]) * jnp.einsum('bhte,bhse->bhts', qc, kc)
        g = jnp.exp(inter - mt)
        num = jnp.einsum('bhts,bhse->bhte', wts, vc) + g[..., None] * jnp.einsum('bhte,bhef->bhtf', qc, C)
        den = jnp.sum(wts, axis=-1) + g * jnp.einsum('bhte,bhe->bht', qc, n)
        h = num / jnp.maximum(jnp.abs(den), jnp.exp(-mt))[..., None]
        mL = mt[..., -1]
        decay = jnp.exp(b[..., -1:] - b + ic - mL[..., None])
        gL = g[..., -1]
        C = gL[..., None, None] * C + jnp.einsum('bhs,bhse,bhsf->bhef', decay, kc, vc)
        n = gL[..., None] * n + jnp.einsum('bhs,bhse->bhe', decay, kc)
        return (C, n, mL), h

    xs = (_to_chunks(q, L), _to_chunks(k, L), _to_chunks(v, L), _to_chunks(ig, L), _to_chunks(lf, L))
    (C, n, m), h = lax.scan(step, (C0, n0, m0), xs)
    return _from_chunks(h), C, n, m


def hgrn2_chunked(q, k, log_f, i, S0):
    S = q.shape[1]
    L = _chunk_len(S, HGRN_CHUNK)
    causal = np.tril(np.ones((L, L), dtype=bool))

    def step(St, xs):
        qc, kc, fc, ic = xs
        b = jnp.cumsum(fc, axis=2)
        diff = b[:, :, :, None, :] - b[:, :, None, :, :]
        dec = jnp.exp(jnp.where(causal[:, :, None], diff, NEG_BIG))
        A = jnp.einsum('bhtk,bhsk,bhtsk->bhts', qc, kc, dec)
        o = jnp.einsum('bhts,bhsv->bhtv', A, ic) + jnp.einsum('bhtk,bhkv->bhtv', qc * jnp.exp(b), St)
        bL = b[:, :, -1:, :]
        St = jnp.exp(bL[:, :, 0])[..., None] * St + jnp.einsum('bhsk,bhsv->bhkv', kc * jnp.exp(bL - b), ic)
        return St, o

    xs = (_to_chunks(q, L), _to_chunks(k, L), _to_chunks(log_f, L), _to_chunks(i, L))
    St, o = lax.scan(step, S0, xs)
    return _from_chunks(o), St


def trunk_layer(x, attn_fn, conv_buf, C0, n0, m0, S0,
                g_mix, w_in, gate_b, conv_w, mlstm_g, lb, hgrn_g, w_out, g_ffn, w_up, w_down):
    f32 = jnp.float32
    B, S, _ = x.shape

    def heads(t):
        return t.reshape(B, S, -1, HEAD_DIM)

    z = rmsnorm(x, g_mix) @ w_in
    cuts = [int(c) for c in np.cumsum(PROJ_SPLITS)[:-1]]
    (aq, ak, av, mq, mk, mv, mo, mi, mf, hq, hf, hi, hg) = jnp.split(z, cuts, axis=-1)
    ak, av = heads(ak), heads(av)
    attn_out = attn_fn(heads(aq), ak, av)
    qk, conv_new = causal_conv(jnp.concatenate([mq, mk], axis=-1), conv_buf, conv_w)
    qk = jax.nn.silu(qk.astype(f32))
    ig = mi.astype(f32) + gate_b[0].astype(f32)
    lf = jax.nn.log_sigmoid(mf.astype(f32) + gate_b[1].astype(f32))
    h_m, C, n, m = mlstm_chunked(heads(qk[..., :MLSTM_WIDTH]), heads(qk[..., MLSTM_WIDTH:]) * HEAD_DIM ** -0.5,
                                 heads(mv).astype(f32), ig, lf, C0.astype(f32), n0.astype(f32), m0.astype(f32))
    mlstm_out = jax.nn.sigmoid(heads(mo).astype(f32)) * head_rmsnorm(h_m, mlstm_g)
    lbh = lb.reshape(N_HGRN_HEADS, HEAD_DIM)
    fpre = heads(hf).astype(f32)
    f_gate = lbh + (1.0 - lbh) * jax.nn.sigmoid(fpre)
    log_f = jnp.log(f_gate)
    k_h = 1.0 - f_gate
    h_h, S_new = hgrn2_chunked(jax.nn.silu(heads(hq).astype(f32)), k_h, log_f, heads(hi).astype(f32), S0.astype(f32))
    hgrn_out = jax.nn.sigmoid(heads(hg).astype(f32)) * head_rmsnorm(h_h, hgrn_g)
    mix = jnp.concatenate([attn_out.reshape(B, S, ATTN_WIDTH), mlstm_out.reshape(B, S, MLSTM_WIDTH),
                           hgrn_out.reshape(B, S, HGRN_WIDTH)], axis=-1)
    x = x + mix.astype(x.dtype) @ w_out
    u = rmsnorm(x, g_ffn) @ w_up
    x = x + jnp.square(jax.nn.relu(u)) @ w_down
    return x, (ak, av, conv_new, C, n, m, S_new)


def setup_inputs(seed: int = 0) -> dict:
    key = jax.random.key(seed)
    ks = jax.random.split(key, 24)
    f32 = jnp.float32

    def nrm(k, shape, scale):
        return scale * jax.random.normal(k, shape, f32)

    n_buf = min(MAX_WINDOW, PAST_LEN)
    f_bias = jnp.linspace(3.0, 6.0, N_MLSTM_HEADS, dtype=f32)
    mlstm_gate_b = jnp.stack([nrm(ks[10], (DEPTH, N_MLSTM_HEADS), 0.1),
                              f_bias + nrm(ks[11], (DEPTH, N_MLSTM_HEADS), 0.1)], axis=1)
    return {
        'x_prompt': nrm(ks[0], (BATCH, SEQ, D_MODEL), 1.0),
        'x_sample': nrm(ks[1], (DEC_BATCH, DEC_SEQ, D_MODEL), 1.0),
        'cache_attn_k': nrm(ks[2], (DEPTH, DEC_BATCH, n_buf, N_ATTN_HEADS, HEAD_DIM), 1.0),
        'cache_attn_v': nrm(ks[3], (DEPTH, DEC_BATCH, n_buf, N_ATTN_HEADS, HEAD_DIM), 1.0),
        'state_mlstm_conv': nrm(ks[4], (DEPTH, DEC_BATCH, CONV_WIDTH - 1, 2 * MLSTM_WIDTH), 1.0),
        'state_mlstm_C': nrm(ks[5], (DEPTH, DEC_BATCH, N_MLSTM_HEADS, HEAD_DIM, HEAD_DIM), 0.3),
        'state_mlstm_n': nrm(ks[6], (DEPTH, DEC_BATCH, N_MLSTM_HEADS, HEAD_DIM), 0.3),
        'state_mlstm_m': nrm(ks[7], (DEPTH, DEC_BATCH, N_MLSTM_HEADS), 1.0),
        'state_hgrn_S': nrm(ks[8], (DEPTH, DEC_BATCH, N_HGRN_HEADS, HEAD_DIM, HEAD_DIM), 1.0),
        'rel_bias': nrm(ks[9], (N_REL_BUCKETS, N_ATTN_HEADS), 0.5),
        'g_mix': 1.0 + nrm(ks[12], (DEPTH, D_MODEL), 0.05),
        'w_in': nrm(ks[13], (DEPTH, D_MODEL, PROJ_WIDTH), D_MODEL ** -0.5),
        'mlstm_gate_b': mlstm_gate_b,
        'mlstm_conv_w': nrm(ks[14], (DEPTH, CONV_WIDTH, 2 * MLSTM_WIDTH), CONV_WIDTH ** -0.5),
        'mlstm_norm_g': 1.0 + nrm(ks[15], (DEPTH, MLSTM_WIDTH), 0.05),
        'hgrn_lb_raw': nrm(ks[16], (DEPTH, HGRN_WIDTH), 0.5),
        'hgrn_norm_g': 1.0 + nrm(ks[17], (DEPTH, HGRN_WIDTH), 0.05),
        'w_out': nrm(ks[18], (DEPTH, MIX_WIDTH, D_MODEL), MIX_WIDTH ** -0.5),
        'g_ffn': 1.0 + nrm(ks[19], (DEPTH, D_MODEL), 0.05),
        'w_up': nrm(ks[20], (DEPTH, D_MODEL, D_FF), D_MODEL ** -0.5),
        'w_down': nrm(ks[21], (DEPTH, D_FF, D_MODEL), D_FF ** -0.5),
        'g_final': 1.0 + nrm(ks[22], (D_MODEL,), 0.05),
    }


def reference(x_prompt, x_sample, cache_attn_k, cache_attn_v, state_mlstm_conv, state_mlstm_C,
              state_mlstm_n, state_mlstm_m, state_hgrn_S, rel_bias, g_mix, w_in, mlstm_gate_b,
              mlstm_conv_w, mlstm_norm_g, hgrn_lb_raw, hgrn_norm_g, w_out, g_ffn, w_up, w_down, g_final):
    f32 = jnp.float32
    bp, sp = x_prompt.shape[:2]
    n_keep = min(MAX_WINDOW, sp)
    lb_p = jax.nn.softmax(hgrn_lb_raw.astype(f32), axis=0)
    hgrn_lb = jnp.cumsum(lb_p, axis=0) - lb_p[0]
    zeros_conv = jnp.zeros((bp, CONV_WIDTH - 1, 2 * MLSTM_WIDTH), x_prompt.dtype)
    zeros_C = jnp.zeros((bp, N_MLSTM_HEADS, HEAD_DIM, HEAD_DIM), f32)
    zeros_n = jnp.zeros((bp, N_MLSTM_HEADS, HEAD_DIM), f32)
    zeros_m = jnp.zeros((bp, N_MLSTM_HEADS), f32)
    zeros_S = jnp.zeros((bp, N_HGRN_HEADS, HEAD_DIM, HEAD_DIM), f32)
    prompt_attn = functools.partial(attn_prompt, rel_bias=rel_bias)
    hp, hs = x_prompt, x_sample
    p_states, s_states = [], []
    for l in range(DEPTH):
        weights = (g_mix[l], w_in[l], mlstm_gate_b[l], mlstm_conv_w[l], mlstm_norm_g[l], hgrn_lb[l],
                   hgrn_norm_g[l], w_out[l], g_ffn[l], w_up[l], w_down[l])
        hp, (pk, pv, pconv, pC, pn, pm, pS) = trunk_layer(hp, prompt_attn, zeros_conv, zeros_C, zeros_n, zeros_m,
                                                         zeros_S, *weights)
        p_states.append((pk[:, sp - n_keep:], pv[:, sp - n_keep:], pconv, pC, pn, pm, pS))
        sample_attn = functools.partial(attn_sample, rel_bias=rel_bias, k_buf=cache_attn_k[l], v_buf=cache_attn_v[l])
        hs, s_st = trunk_layer(hs, sample_attn, state_mlstm_conv[l], state_mlstm_C[l], state_mlstm_n[l],
                               state_mlstm_m[l], state_hgrn_S[l], *weights)
        s_states.append(s_st)
    y_prompt = rmsnorm(hp, g_final)
    y_sample = rmsnorm(hs, g_final)
    p_attn_k, p_attn_v, p_mlstm_conv, p_mlstm_C, p_mlstm_n, p_mlstm_m, p_hgrn_S = [jnp.stack(a) for a in zip(*p_states)]
    s_attn_k, s_attn_v, s_mlstm_conv, s_mlstm_C, s_mlstm_n, s_mlstm_m, s_hgrn_S = [jnp.stack(a) for a in zip(*s_states)]
    return (y_prompt, y_sample,
            p_attn_k, p_attn_v, p_mlstm_conv, p_mlstm_C, p_mlstm_n, p_mlstm_m, p_hgrn_S,
            s_attn_k, s_attn_v, s_mlstm_conv, s_mlstm_C, s_mlstm_n, s_mlstm_m, s_hgrn_S)
```

```cpp
#include <hip/hip_runtime.h>
#include <hip/hip_cooperative_groups.h>
#include <cstdio>
#include <cstdint>
#include <cmath>
namespace cg = cooperative_groups;

#ifndef MK_MULTI
#define MK_MULTI 0
#endif

namespace pg8 {
#define PG8_LAS __attribute__((address_space(3)))
typedef unsigned short bf16_t;
typedef short bf16x8 __attribute__((ext_vector_type(8)));
typedef float f32x4 __attribute__((ext_vector_type(4)));
typedef unsigned u32x4 __attribute__((ext_vector_type(4)));
constexpr int BM = 256, BK = 64, HALF = 128, HTB = HALF * BK * 2, STAGE_BYTES = 8 * HTB, NXCD = 8, WGM = 8;

__host__ __device__ __forceinline__ int lds_byte(int r, int c) { const int st = (r >> 4) * 2 + (c >> 5), rr = r & 15, cc = c & 31, ob = rr * 64 + cc * 2; return st * 1024 + (ob ^ (((ob >> 9) & 1) << 5)); }
__host__ __device__ __forceinline__ void stage_rc(int b, int& R, int& C) { const int st = b / 1024, sb = b % 1024, swz = sb ^ (((sb >> 9) & 1) << 5); R = (st >> 1) * 16 + swz / 64; C = (st & 1) * 32 + (swz % 64) / 2; }
__host__ __device__ __forceinline__ int perm32(int rho) { const int n = rho >> 4, i = rho & 15; return 8 * (i >> 2) + 4 * n + (i & 3); }

struct Unit { int pm, pn; };
struct Gemm { const bf16_t* A; const bf16_t* Bt; int M, N, K; };

struct StaticOrder {
    int nM, nN, nwg, G, c;
    __host__ __device__ void init(int M, int N, int G_, int c_) { nM = M / BM; nN = N / BM; nwg = nM * nN; G = G_; c = c_; }
    __host__ __device__ bool next(int i, Unit& u) const {
        const long L = (long)i * G + c; if (L >= nwg) return false;
        int wgid = (int)L; { const int q = nwg / NXCD, r = nwg % NXCD, xcd = wgid % NXCD, off = wgid / NXCD; wgid = (xcd < r ? xcd * (q + 1) : r * (q + 1) + (xcd - r) * q) + off; }
        const int nig = WGM * nN, gid = wgid / nig, fm = gid * WGM, gsz = (nM - fm) < WGM ? (nM - fm) : WGM;
        u.pm = fm + ((wgid % nig) % gsz); u.pn = (wgid % nig) / gsz; return true;
    }
    __device__ __forceinline__ void a_ready(const Unit&) const {}
    __device__ __forceinline__ void done(const Unit&) const {}
};

__device__ __forceinline__ unsigned cvt_pk_bf16(float lo, float hi) { unsigned r; asm volatile("v_cvt_pk_bf16_f32 %0, %1, %2" : "=v"(r) : "v"(lo), "v"(hi)); return r; }

template <class Epi, class Sched, bool ALIGN_EPI = false, bool SP2 = false>
__device__ __forceinline__ void gemm_phase(PG8_LAS unsigned char* lds, const Gemm g, const Sched& S, const Epi& E) {
    const int tid = threadIdx.x, wid = __builtin_amdgcn_readfirstlane(tid >> 6), lane = tid & 63, wr = wid >> 2, wc = wid & 3, fr = lane & 15, fq = lane >> 4;
    const int K = g.K, nt = K / BK;
    unsigned voffA[2], voffB[2];
#pragma unroll
    for (int i = 0; i < 2; ++i) { int R, C; stage_rc(tid * 16 + i * 8192, R, C); const int Rb = Epi::PERM ? ((R & ~31) + perm32(R & 31)) : R;
        voffA[i] = (unsigned)(R * K + C) * 2u; voffB[i] = (unsigned)(Rb * K + C) * 2u; }
    const size_t kstep = (size_t)(BK * 2);
    const size_t hstep = (size_t)HALF * K * 2;
    const size_t tstep = 2 * hstep;
    const unsigned ldsw = (unsigned)wid * 1024u;
    const int aoff = lds_byte(wr * 64 + fr, fq * 8), boff = lds_byte(wc * 32 + fr, fq * 8);
#define PG8_SA(b, h) (((b) * 2 + (h)) * HTB)
#define PG8_SB(b, h) ((4 + (b) * 2 + (h)) * HTB)
#define PG8_STAGE(bufoff, gbase, voff) do { _Pragma("unroll") for (int _i = 0; _i < 2; ++_i) \
        __builtin_amdgcn_global_load_lds((const unsigned*)((const char*)(gbase) + (voff)[_i]), (PG8_LAS unsigned*)(lds + (bufoff) + ldsw + _i * 8192), 16, 0, 0); } while (0)
#define PG8_LDA(dst, b, h) do { _Pragma("unroll") for (int m = 0; m < 4; ++m) _Pragma("unroll") for (int k = 0; k < 2; ++k) dst[m][k] = *(const PG8_LAS bf16x8*)(lds + PG8_SA(b, h) + aoff + m * 2048 + k * 1024); } while (0)
#define PG8_LDB(dst, b, h) do { _Pragma("unroll") for (int n = 0; n < 2; ++n) _Pragma("unroll") for (int k = 0; k < 2; ++k) dst[n][k] = *(const PG8_LAS bf16x8*)(lds + PG8_SB(b, h) + boff + n * 2048 + k * 1024); } while (0)
#define PG8_MMA(ai, bj, At, Bt) do { __builtin_amdgcn_s_setprio(1); _Pragma("unroll") for (int m = 0; m < 4; ++m) _Pragma("unroll") for (int n = 0; n < 2; ++n) _Pragma("unroll") for (int k = 0; k < 2; ++k) \
        acc[ai][bj][m][n] = __builtin_amdgcn_mfma_f32_16x16x32_bf16(Bt[n][k], At[m][k], acc[ai][bj][m][n], 0, 0, 0); __builtin_amdgcn_s_setprio(0); } while (0)
#define PG8_WAIT_V(n) asm volatile("s_waitcnt vmcnt(" #n ")" ::: "memory")
#define PG8_WAIT_L(n) asm volatile("s_waitcnt lgkmcnt(" #n ")" ::: "memory")
#define PG8_BAR __builtin_amdgcn_s_barrier()
#define PG8_SCHED __builtin_amdgcn_sched_barrier(0)
    Unit cur, nxt; int ui = 0;
    if (!S.next(0, cur)) return;
    f32x4 acc[2][2][4][2];
#pragma unroll
    for (int a = 0; a < 2; ++a)
#pragma unroll
        for (int b = 0; b < 2; ++b)
#pragma unroll
            for (int m = 0; m < 4; ++m)
#pragma unroll
                for (int n = 0; n < 2; ++n) acc[a][b][m][n] = (f32x4){0.f, 0.f, 0.f, 0.f};
    bf16x8 At[4][2], B0[2][2], B1[2][2];
    const char* cA = (const char*)g.A + (size_t)cur.pm * tstep; const char* cB = (const char*)g.Bt + (size_t)cur.pn * tstep;
    S.a_ready(cur);
    if constexpr (SP2) {
        PG8_STAGE(PG8_SB(0, 0), cB, voffB); PG8_STAGE(PG8_SB(0, 1), cB + hstep, voffB); PG8_STAGE(PG8_SA(0, 0), cA, voffA); PG8_STAGE(PG8_SA(0, 1), cA + hstep, voffA);
        if (wr == 1) PG8_BAR;
        PG8_WAIT_V(2); PG8_BAR;
        PG8_STAGE(PG8_SB(1, 0), cB + kstep, voffB); PG8_STAGE(PG8_SA(1, 0), cA + kstep, voffA); PG8_STAGE(PG8_SB(1, 1), cB + hstep + kstep, voffB);
        PG8_WAIT_V(6); PG8_BAR;
    } else {
        PG8_STAGE(PG8_SB(0, 0), cB, voffB); PG8_STAGE(PG8_SA(0, 0), cA, voffA); PG8_STAGE(PG8_SB(0, 1), cB + hstep, voffB); PG8_STAGE(PG8_SA(0, 1), cA + hstep, voffA);
        if (wr == 1) PG8_BAR;
        PG8_WAIT_V(4); PG8_BAR;
        PG8_STAGE(PG8_SB(1, 0), cB + kstep, voffB); PG8_STAGE(PG8_SA(1, 0), cA + kstep, voffA); PG8_STAGE(PG8_SB(1, 1), cB + hstep + kstep, voffB);
        PG8_WAIT_V(6); PG8_BAR;
    }
    for (;;) {
        const bool has_next = S.next(ui + 1, nxt);
        const char* nA = has_next ? (const char*)g.A + (size_t)nxt.pm * tstep : cA; const char* nB = has_next ? (const char*)g.Bt + (size_t)nxt.pn * tstep : cB;
        for (int t = 0; t < nt; t += 2) {
            const bool last = (t == nt - 2);
            const char* a1 = cA + (size_t)(t + 1) * kstep;
            const char* a2 = last ? nA : cA + (size_t)(t + 2) * kstep; const char* b2 = last ? nB : cB + (size_t)(t + 2) * kstep;
            const char* a3 = a2 + kstep; const char* b3 = b2 + kstep;
            if (last && has_next) S.a_ready(nxt);
            if constexpr (SP2) {
            PG8_LDB(B0, 0, 0); PG8_LDB(B1, 0, 1); PG8_SCHED; PG8_LDA(At, 0, 0); PG8_STAGE(PG8_SA(1, 1), a1 + hstep, voffA);
            PG8_WAIT_V(8); PG8_WAIT_L(0); PG8_BAR; PG8_MMA(0, 0, At, B0); PG8_MMA(0, 1, At, B1); PG8_BAR; PG8_SCHED;
            PG8_LDA(At, 0, 1); PG8_STAGE(PG8_SB(0, 0), b2, voffB); PG8_STAGE(PG8_SB(0, 1), b2 + hstep, voffB); PG8_STAGE(PG8_SA(0, 0), a2, voffA);
            PG8_WAIT_V(8); PG8_WAIT_L(0); PG8_BAR; PG8_MMA(1, 0, At, B0); PG8_MMA(1, 1, At, B1); PG8_BAR; PG8_SCHED;
            PG8_LDB(B0, 1, 0); PG8_LDB(B1, 1, 1); PG8_SCHED; PG8_LDA(At, 1, 0); PG8_STAGE(PG8_SA(0, 1), a2 + hstep, voffA);
            PG8_WAIT_V(8); PG8_WAIT_L(0); PG8_BAR; PG8_MMA(0, 0, At, B0); PG8_MMA(0, 1, At, B1); PG8_BAR; PG8_SCHED;
            PG8_LDA(At, 1, 1); PG8_STAGE(PG8_SB(1, 0), b3, voffB); PG8_STAGE(PG8_SB(1, 1), b3 + hstep, voffB); PG8_STAGE(PG8_SA(1, 0), a3, voffA);
            PG8_WAIT_V(8); PG8_WAIT_L(0); PG8_BAR; PG8_MMA(1, 0, At, B0); PG8_MMA(1, 1, At, B1); PG8_BAR; PG8_SCHED;
            } else {
            PG8_LDB(B0, 0, 0); PG8_SCHED; PG8_LDA(At, 0, 0); PG8_STAGE(PG8_SA(1, 1), a1 + hstep, voffA);
            PG8_WAIT_L(8); PG8_BAR; PG8_WAIT_L(0); PG8_MMA(0, 0, At, B0); PG8_BAR; PG8_SCHED;
            PG8_LDB(B1, 0, 1); PG8_STAGE(PG8_SB(0, 0), b2, voffB);
            PG8_BAR; PG8_WAIT_L(0); PG8_MMA(0, 1, At, B1); PG8_BAR;
            PG8_LDA(At, 0, 1); PG8_STAGE(PG8_SA(0, 0), a2, voffA);
            PG8_BAR; PG8_WAIT_L(0); PG8_MMA(1, 0, At, B0); PG8_BAR; PG8_SCHED;
            PG8_STAGE(PG8_SB(0, 1), b2 + hstep, voffB);
            PG8_WAIT_V(6); PG8_BAR; PG8_MMA(1, 1, At, B1); PG8_BAR;
            PG8_LDB(B0, 1, 0); PG8_SCHED; PG8_LDA(At, 1, 0); PG8_STAGE(PG8_SA(0, 1), a2 + hstep, voffA);
            PG8_WAIT_L(8); PG8_BAR; PG8_WAIT_L(0); PG8_MMA(0, 0, At, B0); PG8_BAR; PG8_SCHED;
            PG8_LDB(B1, 1, 1); PG8_STAGE(PG8_SB(1, 0), b3, voffB);
            PG8_BAR; PG8_WAIT_L(0); PG8_MMA(0, 1, At, B1); PG8_BAR;
            PG8_LDA(At, 1, 1); PG8_STAGE(PG8_SA(1, 0), a3, voffA);
            PG8_BAR; PG8_WAIT_L(0); PG8_MMA(1, 0, At, B0); PG8_BAR; PG8_SCHED;
            PG8_STAGE(PG8_SB(1, 1), b3 + hstep, voffB);
            PG8_WAIT_V(6); PG8_BAR; PG8_MMA(1, 1, At, B1); PG8_BAR;
            }
        }
        if constexpr (ALIGN_EPI) { if (wr == 0) PG8_BAR; }
        E(acc, cur, wr, wc, fr, fq);
        if (!has_next) break;
#pragma unroll
        for (int a = 0; a < 2; ++a)
#pragma unroll
            for (int b = 0; b < 2; ++b)
#pragma unroll
                for (int m = 0; m < 4; ++m)
#pragma unroll
                    for (int n = 0; n < 2; ++n) acc[a][b][m][n] = (f32x4){0.f, 0.f, 0.f, 0.f};
        cur = nxt; cA = nA; cB = nB; ++ui;
        if constexpr (ALIGN_EPI) { if (wr == 1) PG8_BAR; }
    }
    PG8_WAIT_V(0);
    if constexpr (!ALIGN_EPI) { if (wr == 0) PG8_BAR; }
    PG8_BAR;
#undef PG8_SA
#undef PG8_SB
#undef PG8_STAGE
#undef PG8_LDA
#undef PG8_LDB
#undef PG8_MMA
#undef PG8_WAIT_V
#undef PG8_WAIT_L
#undef PG8_BAR
#undef PG8_SCHED
}
}

#define LAS __attribute__((address_space(3)))
#define DI __device__ __forceinline__
typedef unsigned short bf16;
typedef short bf16x8 __attribute__((ext_vector_type(8)));
typedef short s16x4 __attribute__((ext_vector_type(4)));
typedef float f32x16 __attribute__((ext_vector_type(16)));
typedef float f32x4 __attribute__((ext_vector_type(4)));
typedef float f32x2 __attribute__((ext_vector_type(2)));
typedef unsigned u32x4 __attribute__((ext_vector_type(4)));
typedef unsigned u32x2 __attribute__((ext_vector_type(2)));
typedef __bf16 bf16x2_t __attribute__((ext_vector_type(2)));
typedef short v4i16_t __attribute__((ext_vector_type(4)));

constexpr int D = 1024, SEQ = 4096, NB = 4, MP = NB * SEQ, SB = 32, STK = 4, MS = SB * STK, MT = MP + MS, MPAD = 16640;
constexpr int NZ = 3840, FF = 4096, NWAVES = 8, NCHUNK = 64, WB = 2048;
constexpr int ZQ = 0, ZK = 512, ZV = 1024, ZMQ = 1536, ZMK = 1792, ZMV = 2048, ZMO = 2304, ZHQ = 2560, ZHF = 2816, ZHI = 3072, ZHG = 3328, ZG = 3584;
constexpr float EPS = 1e-6f;
constexpr float LOG2E = 1.4426950408889634f;

constexpr size_t O_YP = 0, O_YS = O_YP + (size_t)MP * D, O_PK = O_YS + (size_t)MS * D, O_PV = O_PK + (size_t)2 * NB * WB * 512, O_PCONV = O_PV + (size_t)2 * NB * WB * 512,
    O_PC = O_PCONV + 2 * NB * 3 * 512, O_PN = O_PC + 2 * NB * 4 * 4096, O_PM = O_PN + 2 * NB * 4 * 64, O_PS = O_PM + 2 * NB * 4, O_SK = O_PS + 2 * NB * 4 * 4096,
    O_SV = O_SK + (size_t)2 * SB * STK * 512, O_SCONV = O_SV + (size_t)2 * SB * STK * 512, O_SC = O_SCONV + 2 * SB * 3 * 512, O_SN = O_SC + (size_t)2 * SB * 4 * 4096,
    O_SM = O_SN + 2 * SB * 4 * 64, O_SS = O_SM + 2 * SB * 4, O_END = O_SS + (size_t)2 * SB * 4 * 4096;

constexpr size_t al256(size_t x) { return (x + 255) & ~(size_t)255; }
constexpr size_t WS_WIN = 0;
constexpr size_t WS_WOUT = WS_WIN + (size_t)2 * NZ * D * 2;
constexpr size_t WS_WUP = WS_WOUT + (size_t)2 * D * D * 2;
constexpr size_t WS_WDN = WS_WUP + (size_t)2 * FF * D * 2;
constexpr size_t WS_H = WS_WDN + (size_t)2 * D * FF * 2;
constexpr size_t WS_HB = WS_H + (size_t)MPAD * D * 4;
constexpr size_t WS_SSQ = WS_HB + (size_t)MPAD * D * 2;
constexpr size_t WS_Z = al256(WS_SSQ + (size_t)5 * MPAD * 4);
constexpr size_t WS_GATE = WS_Z + (size_t)MPAD * NZ * 2;
constexpr size_t WS_MIX = WS_GATE + (size_t)MPAD * 8 * 4;
constexpr size_t WS_ACT = WS_MIX + (size_t)MPAD * D * 2;
constexpr size_t WS_PO = WS_ACT + (size_t)MPAD * FF * 2;
constexpr size_t WS_PLSE = WS_PO + (size_t)2 * MP * 512 * 2;
constexpr size_t WS_BIAST = WS_PLSE + (size_t)2 * MP * 8 * 4;
constexpr size_t WS_LBV = al256(WS_BIAST + 3 * 8 * 132 * 4);
constexpr size_t WS_MLQC = WS_LBV + 2 * 256 * 4;
constexpr size_t WS_MLKC = WS_MLQC + (size_t)MP * 256 * 2;
constexpr size_t WS_MLB = WS_MLKC + (size_t)MP * 256 * 2;
constexpr size_t WS_MLU = WS_MLB + (size_t)16 * SEQ * 4;
constexpr size_t WS_MLA = WS_MLU + (size_t)16 * SEQ * 4;
constexpr size_t WS_MLBL = WS_MLA + 16 * 64 * 4;
constexpr size_t WS_MLMC = WS_MLBL + 16 * 64 * 4;
constexpr size_t WS_MLKVT = WS_MLMC + 16 * 64 * 4;
constexpr size_t WS_MLKN = WS_MLKVT + (size_t)16 * 64 * 4096 * 4;
constexpr size_t WS_MLCT = WS_MLKN + (size_t)16 * 64 * 64 * 4;
constexpr size_t WS_MLNC = WS_MLCT + (size_t)16 * 64 * 4096 * 2;
constexpr size_t WS_HGQT = WS_MLNC + (size_t)16 * 64 * 64 * 4;
constexpr size_t WS_HGKT = WS_HGQT + (size_t)MP * 256 * 2;
constexpr size_t WS_HGQB = WS_HGKT + (size_t)MP * 256 * 2;
constexpr size_t WS_HGGT = WS_HGQB + (size_t)MP * 256 * 2;
constexpr size_t WS_HGDL = WS_HGGT + (size_t)16 * 64 * 4096 * 4;
constexpr size_t WS_HGST = WS_HGDL + (size_t)16 * 64 * 64 * 4;
constexpr size_t WS_END = WS_HGST + (size_t)16 * 64 * 4096 * 2;

constexpr int LDS_BYTES = 147456;
constexpr int WLDS = 18432;
constexpr int VSTR = 144;

struct Params {
    const float* in[22];
    float* out;
    unsigned char* ws;
    int ph_lo, ph_hi;
    unsigned char bucket[3][136];
};

DI float bf2f(bf16 v) { return __builtin_bit_cast(float, (unsigned)v << 16); }
DI unsigned pk2(float lo, float hi) { f32x2 v = {lo, hi}; bf16x2_t b = __builtin_convertvector(v, bf16x2_t); return __builtin_bit_cast(unsigned, b); }
DI bf16 f2bf(float x) { return (bf16)(pk2(x, 0.f) & 0xffffu); }
DI float lo16(unsigned w) { return __builtin_bit_cast(float, w << 16); }
DI float hi16(unsigned w) { return __builtin_bit_cast(float, w & 0xffff0000u); }
DI int crow(int reg, int hh) { return (reg & 3) + 8 * (reg >> 2) + 4 * hh; }
DI bf16x8 ldg8(const bf16* p) { return *(const bf16x8*)p; }
DI float fexp(float x) { return __builtin_amdgcn_exp2f(x * LOG2E); }
DI float flog(float x) { return __builtin_amdgcn_logf(x) * 0.6931471805599453f; }
DI float sigm(float x) { return 1.0f / (1.0f + fexp(-x)); }
DI float silu(float x) { return x * sigm(x); }
DI float logsig(float x) { return fminf(x, 0.f) - flog(1.0f + fexp(-fabsf(x))); }
DI float wave_sum(float v) {
#pragma unroll
    for (int o = 1; o < 64; o <<= 1) v += __shfl_xor(v, o);
    return v; }
DI float wave_max(float v) {
#pragma unroll
    for (int o = 1; o < 64; o <<= 1) v = fmaxf(v, __shfl_xor(v, o));
    return v; }
#define MFMA32(a, b, c) __builtin_amdgcn_mfma_f32_32x32x16_bf16((a), (b), (c), 0, 0, 0)
DI bf16x8 pack8(const f32x16& x, int s) {
    u32x4 p; p.x = pk2(x[8 * s], x[8 * s + 1]); p.y = pk2(x[8 * s + 2], x[8 * s + 3]); p.z = pk2(x[8 * s + 4], x[8 * s + 5]); p.w = pk2(x[8 * s + 6], x[8 * s + 7]);
    return __builtin_bit_cast(bf16x8, p); }
DI s16x4 vtr(LAS const unsigned char* p) { return __builtin_bit_cast(s16x4, __builtin_amdgcn_ds_read_tr16_b64_v4i16((LAS v4i16_t*)p)); }
template <bool PERMK> DI bf16x8 tr_frag(LAS const unsigned char* tile, int k0, int n0, int lane) {
    const int hh = lane >> 5, q = (lane & 15) >> 2, col = n0 + 16 * ((lane >> 4) & 1) + 4 * (lane & 3);
    const int r1 = k0 + (PERMK ? 4 * hh : 8 * hh) + q, r2 = r1 + (PERMK ? 8 : 4);
    const s16x4 lo = vtr(tile + r1 * VSTR + col * 2), hi = vtr(tile + r2 * VSTR + col * 2);
    return __builtin_shufflevector(lo, hi, 0, 1, 2, 3, 4, 5, 6, 7); }
DI f32x16 zero16() { f32x16 z; for (int i = 0; i < 16; ++i) z[i] = 0.f; return z; }

struct Ctx {
    const Params* P; LAS unsigned char* lds; LAS unsigned char* wl; int tid, lane, wave, vcu, G, gw, NGW;
    unsigned char* ws; float* out;
};

struct EpiZ {
    static constexpr bool PERM = true;
    bf16* Z; const float* ssq; float* gate;
    DI void operator()(const f32x4 (&acc)[2][2][4][2], const pg8::Unit& u, int wr, int wc, int fr, int fq) const {
        const int row0 = u.pm * 256 + wr * 64 + fr, col0 = u.pn * 256 + wc * 32 + 8 * fq;
#pragma unroll
        for (int ai = 0; ai < 2; ++ai)
#pragma unroll
            for (int m = 0; m < 4; ++m) { const int row = row0 + ai * 128 + m * 16; const float rs = __builtin_amdgcn_rsqf(ssq[row] * (1.0f / D) + EPS);
                bf16* rowp = Z + (size_t)row * NZ + col0;
#pragma unroll
                for (int bj = 0; bj < 2; ++bj) { const f32x4 v0 = acc[ai][bj][m][0] * rs, v1 = acc[ai][bj][m][1] * rs;
                    u32x4 w; w.x = pk2(v0[0], v0[1]); w.y = pk2(v0[2], v0[3]); w.z = pk2(v1[0], v1[1]); w.w = pk2(v1[2], v1[3]);
                    *(u32x4*)(rowp + bj * 128) = w;
                    if (u.pn == 14 && bj == 0 && col0 == ZG) { *(f32x4*)(gate + (size_t)row * 8) = v0; *(f32x4*)(gate + (size_t)row * 8 + 4) = v1; } } }
    }
};
struct EpiAct {
    static constexpr bool PERM = true;
    bf16* O; const float* ssq;
    DI void operator()(const f32x4 (&acc)[2][2][4][2], const pg8::Unit& u, int wr, int wc, int fr, int fq) const {
        const int row0 = u.pm * 256 + wr * 64 + fr, col0 = u.pn * 256 + wc * 32 + 8 * fq;
#pragma unroll
        for (int ai = 0; ai < 2; ++ai)
#pragma unroll
            for (int m = 0; m < 4; ++m) { const int row = row0 + ai * 128 + m * 16; const float rs = __builtin_amdgcn_rsqf(ssq[row] * (1.0f / D) + EPS);
                bf16* rowp = O + (size_t)row * FF + col0;
#pragma unroll
                for (int bj = 0; bj < 2; ++bj) { f32x4 v0 = acc[ai][bj][m][0] * rs, v1 = acc[ai][bj][m][1] * rs;
#pragma unroll
                    for (int j = 0; j < 4; ++j) { const float a = fmaxf(v0[j], 0.f), b = fmaxf(v1[j], 0.f); v0[j] = a * a; v1[j] = b * b; }
                    u32x4 w; w.x = pk2(v0[0], v0[1]); w.y = pk2(v0[2], v0[3]); w.z = pk2(v1[0], v1[1]); w.w = pk2(v1[2], v1[3]);
                    *(u32x4*)(rowp + bj * 128) = w; } }
    }
};
struct EpiRes {
    static constexpr bool PERM = false;
    float* H; bf16* HB; float* ssq;
    DI void operator()(const f32x4 (&acc)[2][2][4][2], const pg8::Unit& u, int wr, int wc, int fr, int fq) const {
        const int row0 = u.pm * 256 + wr * 64 + fr, col0 = u.pn * 256 + wc * 32 + 4 * fq;
#pragma unroll
        for (int ai = 0; ai < 2; ++ai)
#pragma unroll
            for (int m = 0; m < 4; ++m) { const int row = row0 + ai * 128 + m * 16; float* hp = H + (size_t)row * D + col0; bf16* bp = HB + (size_t)row * D + col0; float s = 0.f;
#pragma unroll
                for (int bj = 0; bj < 2; ++bj)
#pragma unroll
                    for (int n = 0; n < 2; ++n) { const f32x4 x = *(const f32x4*)(hp + bj * 128 + n * 16) + acc[ai][bj][m][n];
                        *(f32x4*)(hp + bj * 128 + n * 16) = x; u32x2 w; w.x = pk2(x[0], x[1]); w.y = pk2(x[2], x[3]); *(u32x2*)(bp + bj * 128 + n * 16) = w;
                        s += (x[0] * x[0] + x[1] * x[1]) + (x[2] * x[2] + x[3] * x[3]); }
                s += __shfl_xor(s, 16); s += __shfl_xor(s, 32);
                if (fq == 0) atomicAdd(ssq + row, s); }
    }
};

DI void transpose_item(const float* __restrict__ W, int K, int Nsrc, int src_c0, int nvalid, const float* __restrict__ gs, bf16* __restrict__ WT, int dst_row0, int k0, LAS float* scr, int lane) {
#pragma unroll 8
    for (int i = 0; i < 32; ++i) { const int kk = 2 * i + (lane >> 5), n = lane & 31;
        float v = 0.f; if (n < nvalid) { v = W[(size_t)(k0 + kk) * Nsrc + src_c0 + n]; if (gs) v *= gs[k0 + kk]; }
        scr[kk * 33 + n] = v; }
    asm volatile("s_waitcnt lgkmcnt(0)" ::: "memory");
    const int c = lane & 7;
#pragma unroll
    for (int j = 0; j < 4; ++j) { const int n = (lane >> 3) + 8 * j; const LAS float* s = scr + (8 * c) * 33 + n;
        u32x4 o; o.x = pk2(s[0 * 33], s[1 * 33]); o.y = pk2(s[2 * 33], s[3 * 33]); o.z = pk2(s[4 * 33], s[5 * 33]); o.w = pk2(s[6 * 33], s[7 * 33]);
        *(u32x4*)(WT + (size_t)(dst_row0 + n) * K + k0 + 8 * c) = o; }
    asm volatile("s_waitcnt lgkmcnt(0)" ::: "memory");
}
DI void ph_prologue(const Ctx& C) {
    const Params& P = *C.P; const int lane = C.lane;
    LAS float* scr = (LAS float*)C.wl;
    constexpr int I_IN = 16 * (NZ / 32), I_OUT = 16 * (D / 32), I_UP = 16 * (FF / 32), I_DN = 64 * (D / 32), I_L = I_IN + I_OUT + I_UP + I_DN;
    for (int it = C.gw; it < 2 * I_L; it += C.NGW) {
        const int l = it / I_L; int r = it % I_L;
        if (r < I_IN) { const int nb = r % (NZ / 32), kb = r / (NZ / 32), n0 = nb * 32;
            int c0, nv;
            if (n0 < 2560) { c0 = n0; nv = 32; } else if (n0 < ZG) { c0 = n0 + 8; nv = 32; } else if (n0 == ZG) { c0 = 2560; nv = 8; } else { c0 = 0; nv = 0; }
            transpose_item(P.in[11] + (size_t)l * D * 3592, D, 3592, c0, nv, P.in[10] + l * D, (bf16*)(C.ws + WS_WIN) + (size_t)l * NZ * D, n0, kb * 64, scr, lane); continue; }
        r -= I_IN;
        if (r < I_OUT) { const int nb = r % (D / 32), kb = r / (D / 32);
            transpose_item(P.in[17] + (size_t)l * D * D, D, D, nb * 32, 32, nullptr, (bf16*)(C.ws + WS_WOUT) + (size_t)l * D * D, nb * 32, kb * 64, scr, lane); continue; }
        r -= I_OUT;
        if (r < I_UP) { const int nb = r % (FF / 32), kb = r / (FF / 32);
            transpose_item(P.in[19] + (size_t)l * D * FF, D, FF, nb * 32, 32, P.in[18] + l * D, (bf16*)(C.ws + WS_WUP) + (size_t)l * FF * D, nb * 32, kb * 64, scr, lane); continue; }
        r -= I_UP;
        { const int nb = r % (D / 32), kb = r / (D / 32);
            transpose_item(P.in[20] + (size_t)l * FF * D, FF, D, nb * 32, 32, nullptr, (bf16*)(C.ws + WS_WDN) + (size_t)l * D * FF, nb * 32, kb * 64, scr, lane); }
    }
    float* H = (float*)(C.ws + WS_H); bf16* HB = (bf16*)(C.ws + WS_HB); float* SSQ = (float*)(C.ws + WS_SSQ);
    for (int m = C.gw; m < MPAD; m += C.NGW) {
        f32x4 v[4]; float s = 0.f;
        if (m < MT) { const float* xr = (m < MP) ? P.in[0] + (size_t)m * D : P.in[1] + (size_t)(m - MP) * D;
#pragma unroll
            for (int j = 0; j < 4; ++j) { v[j] = *(const f32x4*)(xr + 4 * lane + 256 * j); s += (v[j].x * v[j].x + v[j].y * v[j].y) + (v[j].z * v[j].z + v[j].w * v[j].w); }
        } else {
#pragma unroll
            for (int j = 0; j < 4; ++j) v[j] = (f32x4){0.f, 0.f, 0.f, 0.f}; }
        s = wave_sum(s);
#pragma unroll
        for (int j = 0; j < 4; ++j) { *(f32x4*)(H + (size_t)m * D + 4 * lane + 256 * j) = v[j]; u32x2 w; w.x = pk2(v[j].x, v[j].y); w.y = pk2(v[j].z, v[j].w); *(u32x2*)(HB + (size_t)m * D + 4 * lane + 256 * j) = w; }
        if (lane == 0) SSQ[m] = s;
    }
    for (int i = C.gw * 64 + lane; i < 4 * MPAD; i += C.NGW * 64) SSQ[MPAD + i] = 0.f;
    float* BT = (float*)(C.ws + WS_BIAST);
    for (int i = C.gw * 64 + lane; i < 3 * 8 * 132; i += C.NGW * 64) { const int br = i / (8 * 132), h = (i / 132) % 8, j = i % 132; BT[i] = (j <= 128) ? P.in[9][(int)P.bucket[br][j] * 8 + h] : 0.f; }
    float* LBV = (float*)(C.ws + WS_LBV);
    for (int i = C.gw * 64 + lane; i < 512; i += C.NGW * 64) { const int c = i & 255; LBV[i] = (i < 256) ? 0.f : sigm(P.in[15][256 + c] - P.in[15][c]); }
}

template <int br> DI void attn_unit(const Ctx& C, int l, int u) {
    const int lane = C.lane, t = lane & 31, hh = lane >> 5;
    constexpr int dil = br == 0 ? 1 : (br == 1 ? 4 : 16), nblk = 128 / dil;
    const int bh = u >> 7, rem = u & 127, r = rem / nblk, blk = rem % nblk, b = bh >> 3, h = bh & 7, i0 = blk * 32;
    const bf16* zb = (const bf16*)(C.ws + WS_Z) + (size_t)(b * SEQ) * NZ;
    const float* BT = (const float*)(C.ws + WS_BIAST) + (br * 8 + h) * 132;
    const int pq = (i0 + t) * dil + r;
    bf16x8 qf[4];
#pragma unroll
    for (int s = 0; s < 4; ++s) qf[s] = ldg8(zb + (size_t)pq * NZ + ZQ + h * 64 + 16 * s + 8 * hh);
    const int kt0 = blk < 4 ? 4 - blk : 0;
    const ptrdiff_t tile_step = (ptrdiff_t)32 * dil * NZ;
    const bf16* kp = zb + ((ptrdiff_t)(i0 - 128 + t) * dil + r) * NZ + ZK + h * 64 + 8 * hh + kt0 * tile_step;
    const bf16* vp = zb + ((ptrdiff_t)(i0 - 128 + (lane >> 3)) * dil + r) * NZ + ZV + h * 64 + 8 * (lane & 7) + kt0 * tile_step;
    f32x16 O[2]; O[0] = zero16(); O[1] = zero16();
    float mx = -1e30f, lsum = 0.f;
#pragma unroll 1
    for (int kt = kt0; kt < 5; ++kt, kp += tile_step, vp += tile_step) {
        f32x16 S = zero16();
#pragma unroll
        for (int s = 0; s < 4; ++s) S = MFMA32(ldg8(kp + 16 * s), qf[s], S);
        LAS unsigned char* vt = C.wl + (kt & 1) * (32 * VSTR);
#pragma unroll
        for (int i = 0; i < 4; ++i) *(LAS bf16x8*)(vt + ((lane >> 3) + 8 * i) * VSTR + (lane & 7) * 16) = ldg8(vp + (ptrdiff_t)(8 * i) * dil * NZ);
        float tm = -1e30f;
        const int jb = 128 + t - 32 * kt;
#pragma unroll
        for (int reg = 0; reg < 16; ++reg) { const int j = jb - crow(reg, hh); const bool ok = (j >= 0) && (j <= 128);
            const float sc = ok ? S[reg] * 0.125f + BT[ok ? j : 0] : -1e30f; S[reg] = sc; tm = fmaxf(tm, sc); }
        tm = fmaxf(tm, __shfl_xor(tm, 32));
        const float mn = fmaxf(mx, tm), alpha = fexp(mx - mn); mx = mn;
        float ps = 0.f;
#pragma unroll
        for (int reg = 0; reg < 16; ++reg) { const float p = fexp(S[reg] - mn); S[reg] = p; ps += p; }
        lsum = lsum * alpha + ps;
#pragma unroll
        for (int reg = 0; reg < 16; ++reg) { O[0][reg] *= alpha; O[1][reg] *= alpha; }
#pragma unroll
        for (int ks = 0; ks < 2; ++ks) { const bf16x8 pf = pack8(S, ks);
#pragma unroll
            for (int db = 0; db < 2; ++db) O[db] = MFMA32(tr_frag<true>(vt, 16 * ks, 32 * db, lane), pf, O[db]); }
    }
    lsum += __shfl_xor(lsum, 32);
    const float inv = 1.0f / lsum, lse = mx + flog(lsum);
    const size_t row = (size_t)b * SEQ + pq;
    if (br != 0) {
        bf16* po = (bf16*)(C.ws + WS_PO) + (size_t)(br - 1) * MP * 512 + row * 512 + h * 64;
#pragma unroll
        for (int db = 0; db < 2; ++db)
#pragma unroll
            for (int g = 0; g < 4; ++g) { u32x2 w; w.x = pk2(O[db][4 * g] * inv, O[db][4 * g + 1] * inv); w.y = pk2(O[db][4 * g + 2] * inv, O[db][4 * g + 3] * inv);
                *(u32x2*)(po + 32 * db + 8 * g + 4 * hh) = w; }
        if (hh == 0) ((float*)(C.ws + WS_PLSE))[(size_t)(br - 1) * MP * 8 + row * 8 + h] = lse;
    } else {
        const float l1 = ((const float*)(C.ws + WS_PLSE))[row * 8 + h], l2 = ((const float*)(C.ws + WS_PLSE))[(size_t)MP * 8 + row * 8 + h];
        const float M = fmaxf(lse, fmaxf(l1, l2)), w0 = fexp(lse - M), w1 = fexp(l1 - M), w2 = fexp(l2 - M), iw = 1.0f / (w0 + w1 + w2);
        const float c0 = w0 * iw * inv, c1 = w1 * iw, c2 = w2 * iw;
        const bf16* p1 = (const bf16*)(C.ws + WS_PO) + row * 512 + h * 64; const bf16* p2 = p1 + (size_t)MP * 512;
        bf16* mx_ = (bf16*)(C.ws + WS_MIX) + row * D + h * 64;
#pragma unroll
        for (int db = 0; db < 2; ++db)
#pragma unroll
            for (int g = 0; g < 4; ++g) { const int d0 = 32 * db + 8 * g + 4 * hh; const u32x2 a = *(const u32x2*)(p1 + d0), bq = *(const u32x2*)(p2 + d0);
                const float y0 = c0 * O[db][4 * g] + c1 * lo16(a.x) + c2 * lo16(bq.x), y1 = c0 * O[db][4 * g + 1] + c1 * hi16(a.x) + c2 * hi16(bq.x);
                const float y2 = c0 * O[db][4 * g + 2] + c1 * lo16(a.y) + c2 * lo16(bq.y), y3 = c0 * O[db][4 * g + 3] + c1 * hi16(a.y) + c2 * hi16(bq.y);
                u32x2 w; w.x = pk2(y0, y1); w.y = pk2(y2, y3); *(u32x2*)(mx_ + d0) = w; }
    }
}

DI void attn_sample_item(const Ctx& C, int l, int it) {
    const Params& P = *C.P; const int lane = C.lane, g = lane >> 4, i = lane & 15;
    const int b = it >> 5, t = (it >> 3) & 3, h = it & 7, srow = MP + b * 4 + t;
    const bf16* z = (const bf16*)(C.ws + WS_Z);
    LAS float* sc = (LAS float*)C.wl;
    const float* BT = (const float*)(C.ws + WS_BIAST);
    const u32x2 qw = *(const u32x2*)(z + (size_t)srow * NZ + ZQ + h * 64 + 4 * i);
    const float q0 = lo16(qw.x), q1 = hi16(qw.x), q2 = lo16(qw.y), q3 = hi16(qw.y);
    const float* ck = P.in[2] + ((size_t)(l * SB + b) * WB) * 512 + h * 64 + 4 * i;
    const float* cv = P.in[3] + ((size_t)(l * SB + b) * WB) * 512 + h * 64 + 4 * i;
    for (int n0 = 0; n0 < 388; n0 += 4) { const int n = n0 + g; float s = 0.f;
        if (n < 387) { const int br = n / 129, j = n - br * 129, dil = br == 0 ? 1 : (br == 1 ? 4 : 16), idx = WB + t - dil * j;
            f32x4 k;
            if (idx >= WB) { const u32x2 w = *(const u32x2*)(z + (size_t)(MP + b * 4 + idx - WB) * NZ + ZK + h * 64 + 4 * i); k = (f32x4){lo16(w.x), hi16(w.x), lo16(w.y), hi16(w.y)}; }
            else k = *(const f32x4*)(ck + (size_t)idx * 512);
            s = q0 * k.x + q1 * k.y + q2 * k.z + q3 * k.w; }
        s += __shfl_xor(s, 1); s += __shfl_xor(s, 2); s += __shfl_xor(s, 4); s += __shfl_xor(s, 8);
        if (n < 387 && i == 0) { const int br = n / 129, j = n - br * 129; sc[n] = s * 0.125f + BT[(br * 8 + h) * 132 + j]; } }
    float mx = -1e30f;
    for (int n = lane; n < 387; n += 64) mx = fmaxf(mx, sc[n]);
    mx = wave_max(mx);
    float ls = 0.f;
    for (int n = lane; n < 387; n += 64) { const float p = fexp(sc[n] - mx); sc[n] = p; ls += p; }
    ls = wave_sum(ls);
    f32x4 acc = (f32x4){0.f, 0.f, 0.f, 0.f};
    for (int n0 = 0; n0 < 388; n0 += 4) { const int n = n0 + g;
        if (n < 387) { const int br = n / 129, j = n - br * 129, dil = br == 0 ? 1 : (br == 1 ? 4 : 16), idx = WB + t - dil * j; const float p = sc[n];
            f32x4 v;
            if (idx >= WB) { const u32x2 w = *(const u32x2*)(z + (size_t)(MP + b * 4 + idx - WB) * NZ + ZV + h * 64 + 4 * i); v = (f32x4){lo16(w.x), hi16(w.x), lo16(w.y), hi16(w.y)}; }
            else v = *(const f32x4*)(cv + (size_t)idx * 512);
            acc += v * p; } }
#pragma unroll
    for (int c = 0; c < 4; ++c) { acc[c] += __shfl_xor(acc[c], 16); acc[c] += __shfl_xor(acc[c], 32); }
    if (g == 0) { const float inv = 1.0f / ls; u32x2 w; w.x = pk2(acc.x * inv, acc.y * inv); w.y = pk2(acc.z * inv, acc.w * inv);
        *(u32x2*)((bf16*)(C.ws + WS_MIX) + (size_t)srow * D + h * 64 + 4 * i) = w; }
}

DI float scan_add(float x, int lane) {
#pragma unroll
    for (int o = 1; o < 64; o <<= 1) { const float v = __shfl_up(x, o); if (lane >= o) x += v; }
    return x; }
DI float scan_max(float x, int lane) {
#pragma unroll
    for (int o = 1; o < 64; o <<= 1) { const float v = __shfl_up(x, o); if (lane >= o) x = fmaxf(x, v); }
    return x; }

DI void conv8(const bf16* zcol, int ts, const float* w, float scale, float (&y)[8]) {
#pragma unroll
    for (int e = 0; e < 8; ++e) y[e] = 0.f;
#pragma unroll
    for (int j = 0; j < 4; ++j) { const int tj = ts - 3 + j;
        if (tj >= 0) { const bf16x8 x = ldg8(zcol + (ptrdiff_t)(j - 3) * NZ); const f32x4 w0 = *(const f32x4*)(w + j * 512), w1 = *(const f32x4*)(w + j * 512 + 4);
            const u32x4 xw = __builtin_bit_cast(u32x4, x);
            y[0] += w0.x * lo16(xw.x); y[1] += w0.y * hi16(xw.x); y[2] += w0.z * lo16(xw.y); y[3] += w0.w * hi16(xw.y);
            y[4] += w1.x * lo16(xw.z); y[5] += w1.y * hi16(xw.z); y[6] += w1.z * lo16(xw.w); y[7] += w1.w * hi16(xw.w); } }
#pragma unroll
    for (int e = 0; e < 8; ++e) y[e] = silu(y[e]) * scale;
}

DI void mlstm_m1_item(const Ctx& C, int l, int it) {
    const Params& P = *C.P; const int lane = C.lane, hh = lane >> 5;
    const int bh = it >> 6, c = it & 63, b = bh >> 2, h = bh & 3, row0 = b * SEQ + c * 64;
    const bf16* z = (const bf16*)(C.ws + WS_Z);
    const float* gate = (const float*)(C.ws + WS_GATE);
    LAS unsigned char* kt_ = C.wl; LAS unsigned char* vt_ = C.wl + 32 * VSTR; LAS float* dpr = (LAS float*)(C.wl + 64 * VSTR);
    const float ig = gate[(size_t)(row0 + lane) * 8 + h] + P.in[12][l * 8 + h];
    const float lf = logsig(gate[(size_t)(row0 + lane) * 8 + 4 + h] + P.in[12][l * 8 + 4 + h]);
    const float bc = scan_add(lf, lane), bL = __shfl(bc, 63), uu = ig - bc, umax = wave_max(uu);
    dpr[lane] = fexp(uu - umax);
    ((float*)(C.ws + WS_MLB))[bh * SEQ + c * 64 + lane] = bc; ((float*)(C.ws + WS_MLU))[bh * SEQ + c * 64 + lane] = uu;
    if (lane == 0) { ((float*)(C.ws + WS_MLA))[bh * 64 + c] = bL + umax; ((float*)(C.ws + WS_MLBL))[bh * 64 + c] = bL; }
    const float* cw = P.in[13] + (size_t)l * 4 * 512;
    bf16* QC = (bf16*)(C.ws + WS_MLQC); bf16* KC = (bf16*)(C.ws + WS_MLKC);
#pragma unroll 2
    for (int i = 0; i < 8; ++i) { const int id = lane + 64 * i, rr = id >> 3, cgp = id & 7, ch = h * 64 + 8 * cgp, ts = c * 64 + rr; float y[8];
        conv8(z + (size_t)(row0 + rr) * NZ + ZMQ + ch, ts, cw + ch, 1.0f, y);
        u32x4 w; w.x = pk2(y[0], y[1]); w.y = pk2(y[2], y[3]); w.z = pk2(y[4], y[5]); w.w = pk2(y[6], y[7]);
        *(u32x4*)(QC + (size_t)(row0 + rr) * 256 + ch) = w; }
    f32x16 acc[2][2]; acc[0][0] = zero16(); acc[0][1] = zero16(); acc[1][0] = zero16(); acc[1][1] = zero16();
    float kn = 0.f;
    for (int hf = 0; hf < 2; ++hf) {
#pragma unroll 2
        for (int i = 0; i < 4; ++i) { const int id = lane + 64 * i, rr = id >> 3, cgp = id & 7, ch = h * 64 + 8 * cgp, rs = 32 * hf + rr, ts = c * 64 + rs; float y[8];
            conv8(z + (size_t)(row0 + rs) * NZ + ZMK + ch, ts, cw + 256 + ch, 0.125f, y);
            u32x4 w; w.x = pk2(y[0], y[1]); w.y = pk2(y[2], y[3]); w.z = pk2(y[4], y[5]); w.w = pk2(y[6], y[7]);
            *(u32x4*)(KC + (size_t)(row0 + rs) * 256 + ch) = w;
            *(LAS u32x4*)(kt_ + rr * VSTR + cgp * 16) = w;
            const float dp = dpr[rs];
            const u32x4 vw = __builtin_bit_cast(u32x4, ldg8(z + (size_t)(row0 + rs) * NZ + ZMV + ch));
            u32x4 vo; vo.x = pk2(lo16(vw.x) * dp, hi16(vw.x) * dp); vo.y = pk2(lo16(vw.y) * dp, hi16(vw.y) * dp); vo.z = pk2(lo16(vw.z) * dp, hi16(vw.z) * dp); vo.w = pk2(lo16(vw.w) * dp, hi16(vw.w) * dp);
            *(LAS u32x4*)(vt_ + rr * VSTR + cgp * 16) = vo; }
#pragma unroll
        for (int ks = 0; ks < 2; ++ks) { bf16x8 A[2], B[2];
#pragma unroll
            for (int x = 0; x < 2; ++x) { A[x] = tr_frag<false>(vt_, 16 * ks, 32 * x, lane); B[x] = tr_frag<false>(kt_, 16 * ks, 32 * x, lane); }
#pragma unroll
            for (int fb = 0; fb < 2; ++fb)
#pragma unroll
                for (int eb = 0; eb < 2; ++eb) acc[fb][eb] = MFMA32(A[fb], B[eb], acc[fb][eb]); }
        for (int s = 0; s < 32; ++s) kn += dpr[32 * hf + s] * bf2f(*(LAS const bf16*)(kt_ + s * VSTR + lane * 2));
    }
    float* KVT = (float*)(C.ws + WS_MLKVT) + (size_t)(bh * 64 + c) * 4096;
#pragma unroll
    for (int fb = 0; fb < 2; ++fb)
#pragma unroll
        for (int eb = 0; eb < 2; ++eb)
#pragma unroll
            for (int reg = 0; reg < 16; ++reg) KVT[(32 * fb + crow(reg, hh)) * 64 + 32 * eb + (lane & 31)] = acc[fb][eb][reg];
    ((float*)(C.ws + WS_MLKN))[(size_t)(bh * 64 + c) * 64 + lane] = kn;
}

DI void mlstm_m2_item(const Ctx& C, int l, int it) {
    const int lane = C.lane, bh = it >> 6, f = it & 63, b = bh >> 2, h = bh & 3;
    const float* __restrict__ MA = (const float*)(C.ws + WS_MLA) + bh * 64; const float* __restrict__ MBL = (const float*)(C.ws + WS_MLBL) + bh * 64;
    const float* __restrict__ KVT = (const float*)(C.ws + WS_MLKVT) + (size_t)bh * 64 * 4096 + f * 64 + lane;
    const float* __restrict__ KN = (const float*)(C.ws + WS_MLKN) + (size_t)bh * 64 * 64 + lane;
    bf16* __restrict__ CT = (bf16*)(C.ws + WS_MLCT) + (size_t)bh * 64 * 4096 + f * 64 + lane;
    float* __restrict__ NC = (float*)(C.ws + WS_MLNC) + (size_t)bh * 64 * 64 + lane;
    float* __restrict__ MC = (float*)(C.ws + WS_MLMC) + bh * 64;
    float m = 0.f, Cv = 0.f, nv = 0.f;
#pragma unroll 8
    for (int c = 0; c < 64; ++c) {
        const float a = MA[c], bL = MBL[c], mn = fmaxf(bL + m, a), gL = fexp(bL + m - mn), sc = fexp(a - mn);
        CT[(size_t)c * 4096] = f2bf(Cv);
        Cv = gL * Cv + sc * KVT[(size_t)c * 4096];
        if (f == 0) { NC[c * 64] = nv; nv = gL * nv + sc * KN[c * 64]; if (lane == 0) MC[c] = m; }
        m = mn;
    }
    C.out[O_PC + ((size_t)((l * NB + b) * 4 + h) * 64 + lane) * 64 + f] = Cv;
    if (f == 0) { C.out[O_PN + (size_t)((l * NB + b) * 4 + h) * 64 + lane] = nv; if (lane == 0) C.out[O_PM + (l * NB + b) * 4 + h] = m; }
}

DI void mlstm_m3_item(const Ctx& C, int l, int it) {
    const Params& P = *C.P; const int lane = C.lane, t = lane & 31, hh = lane >> 5;
    const int half = it & 1, c = (it >> 1) & 63, bh = it >> 7, b = bh >> 2, h = bh & 3, row0 = b * SEQ + c * 64, tok = 32 * half + t, row = row0 + tok;
    const bf16* z = (const bf16*)(C.ws + WS_Z);
    const bf16* QC = (const bf16*)(C.ws + WS_MLQC); const bf16* KC = (const bf16*)(C.ws + WS_MLKC);
    LAS float* us = (LAS float*)(C.wl + 64 * VSTR);
    bf16x8 qf[4];
#pragma unroll
    for (int s = 0; s < 4; ++s) qf[s] = ldg8(QC + (size_t)row * 256 + h * 64 + 16 * s + 8 * hh);
    const float u_l = ((const float*)(C.ws + WS_MLU))[bh * SEQ + c * 64 + lane], b_l = ((const float*)(C.ws + WS_MLB))[bh * SEQ + c * 64 + lane];
    const float m_c = ((const float*)(C.ws + WS_MLMC))[bh * 64 + c];
    const float cm = scan_max(u_l, lane), mt_l = b_l + fmaxf(m_c, cm);
    us[lane] = u_l;
    const float b_t = __shfl(b_l, tok), mt_t = __shfl(mt_l, tok), g_t = fexp(b_t + m_c - mt_t);
    f32x16 O[2]; O[0] = zero16(); O[1] = zero16();
    float den = 0.f;
    for (int kt = 0; kt <= half; ++kt) {
        const bf16* kp = KC + (size_t)(row0 + 32 * kt + t) * 256 + h * 64 + 8 * hh;
        f32x16 S = zero16();
#pragma unroll
        for (int s = 0; s < 4; ++s) S = MFMA32(ldg8(kp + 16 * s), qf[s], S);
#pragma unroll
        for (int reg = 0; reg < 16; ++reg) { const int sidx = 32 * kt + crow(reg, hh);
            const float w = (sidx <= tok) ? fexp(b_t + us[sidx] - mt_t) * S[reg] : 0.f; S[reg] = w; den += w; }
        LAS unsigned char* vt = C.wl + (kt & 1) * (32 * VSTR);
#pragma unroll
        for (int i = 0; i < 4; ++i) { const int id = lane + 64 * i, rr = id >> 3, cgp = id & 7;
            *(LAS bf16x8*)(vt + rr * VSTR + cgp * 16) = ldg8(z + (size_t)(row0 + 32 * kt + rr) * NZ + ZMV + h * 64 + 8 * cgp); }
#pragma unroll
        for (int ks = 0; ks < 2; ++ks) { const bf16x8 pf = pack8(S, ks);
#pragma unroll
            for (int fb = 0; fb < 2; ++fb) O[fb] = MFMA32(tr_frag<true>(vt, 16 * ks, 32 * fb, lane), pf, O[fb]); }
    }
    const bf16* CT = (const bf16*)(C.ws + WS_MLCT) + (size_t)(bh * 64 + c) * 4096;
    f32x16 X[2]; X[0] = zero16(); X[1] = zero16();
#pragma unroll
    for (int fb = 0; fb < 2; ++fb)
#pragma unroll
        for (int s = 0; s < 4; ++s) X[fb] = MFMA32(ldg8(CT + (32 * fb + t) * 64 + 16 * s + 8 * hh), qf[s], X[fb]);
    const float* NCp = (const float*)(C.ws + WS_MLNC) + (size_t)(bh * 64 + c) * 64;
    float qn = 0.f;
#pragma unroll
    for (int s = 0; s < 4; ++s) { const u32x4 qw = __builtin_bit_cast(u32x4, qf[s]); const f32x4 n0 = *(const f32x4*)(NCp + 16 * s + 8 * hh), n1 = *(const f32x4*)(NCp + 16 * s + 8 * hh + 4);
        qn += lo16(qw.x) * n0.x + hi16(qw.x) * n0.y + lo16(qw.y) * n0.z + hi16(qw.y) * n0.w + lo16(qw.z) * n1.x + hi16(qw.z) * n1.y + lo16(qw.w) * n1.z + hi16(qw.w) * n1.w; }
    qn += __shfl_xor(qn, 32); den += __shfl_xor(den, 32);
    den += g_t * qn;
    const float idn = 1.0f / fmaxf(fabsf(den), fexp(-mt_t));
    float ssq = 0.f;
#pragma unroll
    for (int fb = 0; fb < 2; ++fb)
#pragma unroll
        for (int reg = 0; reg < 16; ++reg) { const float hv = (O[fb][reg] + g_t * X[fb][reg]) * idn; O[fb][reg] = hv; ssq += hv * hv; }
    ssq += __shfl_xor(ssq, 32);
    const float rs = __builtin_amdgcn_rsqf(ssq * (1.0f / 64) + EPS);
    const float* gn = P.in[14] + l * 256 + h * 64;
    bf16* mxp = (bf16*)(C.ws + WS_MIX) + (size_t)row * D + 512 + h * 64;
    const bf16* og = z + (size_t)row * NZ + ZMO + h * 64;
#pragma unroll
    for (int fb = 0; fb < 2; ++fb)
#pragma unroll
        for (int g = 0; g < 4; ++g) { const int f0 = 32 * fb + 8 * g + 4 * hh; const u32x2 ow = *(const u32x2*)(og + f0); const f32x4 gv = *(const f32x4*)(gn + f0);
            u32x2 w; w.x = pk2(O[fb][4 * g] * rs * gv.x * sigm(lo16(ow.x)), O[fb][4 * g + 1] * rs * gv.y * sigm(hi16(ow.x)));
            w.y = pk2(O[fb][4 * g + 2] * rs * gv.z * sigm(lo16(ow.y)), O[fb][4 * g + 3] * rs * gv.w * sigm(hi16(ow.y)));
            *(u32x2*)(mxp + f0) = w; }
}

DI float rdlane(float x, int l) { return __builtin_bit_cast(float, __builtin_amdgcn_readlane(__builtin_bit_cast(int, x), l)); }
DI void mlstm_sample_item(const Ctx& C, int l, int it) {
    const Params& P = *C.P; const int lane = C.lane, b = it >> 2, h = it & 3;
    const bf16* z = (const bf16*)(C.ws + WS_Z); const float* gate = (const float*)(C.ws + WS_GATE);
    const size_t sb = (size_t)(l * SB + b) * 4 + h;
    const float* C0 = P.in[5] + sb * 4096;
    LAS float* Cs = (LAS float*)C.wl;
#pragma unroll 8
    for (int e = 0; e < 64; ++e) Cs[e * 64 + lane] = C0[e * 64 + lane];
    float nv = P.in[6][sb * 64 + lane], m = P.in[7][sb];
    const float* cw = P.in[13] + (size_t)l * 4 * 512; const float* cb = P.in[4] + (size_t)(l * SB + b) * 3 * 512;
    float xq[7], xk[7];
#pragma unroll
    for (int j = 0; j < 3; ++j) { xq[j] = cb[j * 512 + h * 64 + lane]; xk[j] = cb[j * 512 + 256 + h * 64 + lane]; }
#pragma unroll
    for (int j = 0; j < 4; ++j) { xq[3 + j] = bf2f(z[(size_t)(MP + b * 4 + j) * NZ + ZMQ + h * 64 + lane]); xk[3 + j] = bf2f(z[(size_t)(MP + b * 4 + j) * NZ + ZMK + h * 64 + lane]); }
    float wq[4], wk[4];
#pragma unroll
    for (int j = 0; j < 4; ++j) { wq[j] = cw[j * 512 + h * 64 + lane]; wk[j] = cw[j * 512 + 256 + h * 64 + lane]; }
    const float gnv = P.in[14][l * 256 + h * 64 + lane];
#pragma unroll
    for (int t = 0; t < 4; ++t) { const int row = MP + b * 4 + t;
        float qc = 0.f, kc = 0.f;
#pragma unroll
        for (int j = 0; j < 4; ++j) { qc += wq[j] * xq[t + j]; kc += wk[j] * xk[t + j]; }
        qc = silu(qc); kc = silu(kc) * 0.125f;
        const float ig = gate[(size_t)row * 8 + h] + P.in[12][l * 8 + h], lf = logsig(gate[(size_t)row * 8 + 4 + h] + P.in[12][l * 8 + 4 + h]);
        const float mn = fmaxf(lf + m, ig), fp = fexp(lf + m - mn), ip = fexp(ig - mn);
        const float vf = bf2f(z[(size_t)row * NZ + ZMV + h * 64 + lane]) * ip;
        float num = 0.f;
#pragma unroll 4
        for (int e = 0; e < 64; ++e) { const float ke = rdlane(kc, e), qe = rdlane(qc, e); const float cv = fp * Cs[e * 64 + lane] + ke * vf; Cs[e * 64 + lane] = cv; num += qe * cv; }
        nv = fp * nv + ip * kc;
        const float qn = wave_sum(qc * nv);
        const float hv = num / fmaxf(fabsf(qn), fexp(-mn));
        const float ssq = wave_sum(hv * hv), rs = __builtin_amdgcn_rsqf(ssq * (1.0f / 64) + EPS);
        const float og = bf2f(z[(size_t)row * NZ + ZMO + h * 64 + lane]);
        ((bf16*)(C.ws + WS_MIX))[(size_t)row * D + 512 + h * 64 + lane] = f2bf(hv * rs * gnv * sigm(og));
        m = mn; }
    float* oc = C.out + O_SC + sb * 4096;
#pragma unroll 8
    for (int e = 0; e < 64; ++e) oc[e * 64 + lane] = Cs[e * 64 + lane];
    C.out[O_SN + sb * 64 + lane] = nv; if (lane == 0) C.out[O_SM + sb] = m;
}

DI void hgrn_m1_item(const Ctx& C, int l, int it) {
    const int lane = C.lane, hh = lane >> 5;
    const int bh = it >> 6, c = it & 63, b = bh >> 2, h = bh & 3, row0 = b * SEQ + c * 64;
    const bf16* z = (const bf16*)(C.ws + WS_Z);
    LAS unsigned char* kt_ = C.wl; LAS unsigned char* vt_ = C.wl + 32 * VSTR;
    const float lb = ((const float*)(C.ws + WS_LBV))[l * 256 + h * 64 + lane];
    float ba = 0.f, r = 0.f;
#pragma unroll 4
    for (int t = 0; t < 64; ++t) { const float x = bf2f(z[(size_t)(row0 + t) * NZ + ZHF + h * 64 + lane]); const float fg = lb + (1.0f - lb) * sigm(x); ba += flog(fg); if (t == 31) r = ba; }
    const float bL = ba;
    bf16* QT = (bf16*)(C.ws + WS_HGQT); bf16* KT = (bf16*)(C.ws + WS_HGKT); bf16* QB = (bf16*)(C.ws + WS_HGQB);
    f32x16 acc[2][2]; acc[0][0] = zero16(); acc[0][1] = zero16(); acc[1][0] = zero16(); acc[1][1] = zero16();
    ba = 0.f;
    for (int hf = 0; hf < 2; ++hf) {
#pragma unroll 4
        for (int tt = 0; tt < 32; ++tt) { const int t = 32 * hf + tt; const size_t zr = (size_t)(row0 + t) * NZ;
            const float x = bf2f(z[zr + ZHF + h * 64 + lane]); const float fg = lb + (1.0f - lb) * sigm(x), kk = 1.0f - fg;
            ba += flog(fg);
            const float q = silu(bf2f(z[zr + ZHQ + h * 64 + lane]));
            const size_t o = (size_t)(row0 + t) * 256 + h * 64 + lane;
            QT[o] = f2bf(q * fexp(ba - r)); KT[o] = f2bf(kk * fexp(r - ba)); QB[o] = f2bf(q * fexp(ba));
            *(LAS bf16*)(kt_ + tt * VSTR + lane * 2) = f2bf(kk * fexp(bL - ba)); }
#pragma unroll
        for (int i = 0; i < 4; ++i) { const int id = lane + 64 * i, rr = id >> 3, cgp = id & 7;
            *(LAS bf16x8*)(vt_ + rr * VSTR + cgp * 16) = ldg8(z + (size_t)(row0 + 32 * hf + rr) * NZ + ZHI + h * 64 + 8 * cgp); }
#pragma unroll
        for (int ks = 0; ks < 2; ++ks) { bf16x8 A[2], B[2];
#pragma unroll
            for (int x = 0; x < 2; ++x) { A[x] = tr_frag<false>(vt_, 16 * ks, 32 * x, lane); B[x] = tr_frag<false>(kt_, 16 * ks, 32 * x, lane); }
#pragma unroll
            for (int vb = 0; vb < 2; ++vb)
#pragma unroll
                for (int kb = 0; kb < 2; ++kb) acc[vb][kb] = MFMA32(A[vb], B[kb], acc[vb][kb]); }
    }
    float* GT = (float*)(C.ws + WS_HGGT) + (size_t)(bh * 64 + c) * 4096;
#pragma unroll
    for (int vb = 0; vb < 2; ++vb)
#pragma unroll
        for (int kb = 0; kb < 2; ++kb)
#pragma unroll
            for (int reg = 0; reg < 16; ++reg) GT[(32 * vb + crow(reg, hh)) * 64 + 32 * kb + (lane & 31)] = acc[vb][kb][reg];
    ((float*)(C.ws + WS_HGDL))[(size_t)(bh * 64 + c) * 64 + lane] = fexp(bL);
}
DI void hgrn_m2_item(const Ctx& C, int l, int it) {
    const int lane = C.lane, bh = it >> 6, v = it & 63, b = bh >> 2, h = bh & 3;
    const float* __restrict__ GT = (const float*)(C.ws + WS_HGGT) + (size_t)bh * 64 * 4096 + v * 64 + lane;
    const float* __restrict__ DL = (const float*)(C.ws + WS_HGDL) + (size_t)bh * 64 * 64 + lane;
    bf16* __restrict__ ST = (bf16*)(C.ws + WS_HGST) + (size_t)bh * 64 * 4096 + v * 64 + lane;
    float S = 0.f;
#pragma unroll 8
    for (int c = 0; c < 64; ++c) { ST[(size_t)c * 4096] = f2bf(S); S = DL[c * 64] * S + GT[(size_t)c * 4096]; }
    C.out[O_PS + ((size_t)((l * NB + b) * 4 + h) * 64 + lane) * 64 + v] = S;
}
DI void hgrn_m3_item(const Ctx& C, int l, int it) {
    const Params& P = *C.P; const int lane = C.lane, t = lane & 31, hh = lane >> 5;
    const int half = it & 1, c = (it >> 1) & 63, bh = it >> 7, b = bh >> 2, h = bh & 3, row0 = b * SEQ + c * 64, tok = 32 * half + t, row = row0 + tok;
    const bf16* z = (const bf16*)(C.ws + WS_Z);
    const bf16* QT = (const bf16*)(C.ws + WS_HGQT); const bf16* KT = (const bf16*)(C.ws + WS_HGKT); const bf16* QB = (const bf16*)(C.ws + WS_HGQB);
    bf16x8 qf[4];
#pragma unroll
    for (int s = 0; s < 4; ++s) qf[s] = ldg8(QT + (size_t)row * 256 + h * 64 + 16 * s + 8 * hh);
    f32x16 O[2]; O[0] = zero16(); O[1] = zero16();
    for (int kt = 0; kt <= half; ++kt) {
        const bf16* kp = KT + (size_t)(row0 + 32 * kt + t) * 256 + h * 64 + 8 * hh;
        f32x16 S = zero16();
#pragma unroll
        for (int s = 0; s < 4; ++s) S = MFMA32(ldg8(kp + 16 * s), qf[s], S);
#pragma unroll
        for (int reg = 0; reg < 16; ++reg) { const int sidx = 32 * kt + crow(reg, hh); S[reg] = (sidx <= tok) ? S[reg] : 0.f; }
        LAS unsigned char* vt = C.wl + (kt & 1) * (32 * VSTR);
#pragma unroll
        for (int i = 0; i < 4; ++i) { const int id = lane + 64 * i, rr = id >> 3, cgp = id & 7;
            *(LAS bf16x8*)(vt + rr * VSTR + cgp * 16) = ldg8(z + (size_t)(row0 + 32 * kt + rr) * NZ + ZHI + h * 64 + 8 * cgp); }
#pragma unroll
        for (int ks = 0; ks < 2; ++ks) { const bf16x8 pf = pack8(S, ks);
#pragma unroll
            for (int vb = 0; vb < 2; ++vb) O[vb] = MFMA32(tr_frag<true>(vt, 16 * ks, 32 * vb, lane), pf, O[vb]); }
    }
    const bf16* ST = (const bf16*)(C.ws + WS_HGST) + (size_t)(bh * 64 + c) * 4096;
#pragma unroll
    for (int s = 0; s < 4; ++s) { const bf16x8 qb = ldg8(QB + (size_t)row * 256 + h * 64 + 16 * s + 8 * hh);
#pragma unroll
        for (int vb = 0; vb < 2; ++vb) O[vb] = MFMA32(ldg8(ST + (32 * vb + t) * 64 + 16 * s + 8 * hh), qb, O[vb]); }
    float ssq = 0.f;
#pragma unroll
    for (int vb = 0; vb < 2; ++vb)
#pragma unroll
        for (int reg = 0; reg < 16; ++reg) ssq += O[vb][reg] * O[vb][reg];
    ssq += __shfl_xor(ssq, 32);
    const float rs = __builtin_amdgcn_rsqf(ssq * (1.0f / 64) + EPS);
    const float* gn = P.in[16] + l * 256 + h * 64;
    bf16* mxp = (bf16*)(C.ws + WS_MIX) + (size_t)row * D + 768 + h * 64;
    const bf16* og = z + (size_t)row * NZ + ZHG + h * 64;
#pragma unroll
    for (int vb = 0; vb < 2; ++vb)
#pragma unroll
        for (int g = 0; g < 4; ++g) { const int f0 = 32 * vb + 8 * g + 4 * hh; const u32x2 ow = *(const u32x2*)(og + f0); const f32x4 gv = *(const f32x4*)(gn + f0);
            u32x2 w; w.x = pk2(O[vb][4 * g] * rs * gv.x * sigm(lo16(ow.x)), O[vb][4 * g + 1] * rs * gv.y * sigm(hi16(ow.x)));
            w.y = pk2(O[vb][4 * g + 2] * rs * gv.z * sigm(lo16(ow.y)), O[vb][4 * g + 3] * rs * gv.w * sigm(hi16(ow.y)));
            *(u32x2*)(mxp + f0) = w; }
}
DI void hgrn_sample_item(const Ctx& C, int l, int it) {
    const Params& P = *C.P; const int lane = C.lane, b = it >> 2, h = it & 3;
    const bf16* z = (const bf16*)(C.ws + WS_Z);
    const size_t sb = (size_t)(l * SB + b) * 4 + h;
    const float* S0 = P.in[8] + sb * 4096;
    LAS float* Ss = (LAS float*)C.wl;
#pragma unroll 8
    for (int k = 0; k < 64; ++k) Ss[k * 64 + lane] = S0[k * 64 + lane];
    const float lb = ((const float*)(C.ws + WS_LBV))[l * 256 + h * 64 + lane], gnv = P.in[16][l * 256 + h * 64 + lane];
#pragma unroll
    for (int t = 0; t < 4; ++t) { const size_t zr = (size_t)(MP + b * 4 + t) * NZ;
        const float fg = lb + (1.0f - lb) * sigm(bf2f(z[zr + ZHF + h * 64 + lane])), kk = 1.0f - fg, q = silu(bf2f(z[zr + ZHQ + h * 64 + lane]));
        const float iv = bf2f(z[zr + ZHI + h * 64 + lane]);
        float o = 0.f;
#pragma unroll 4
        for (int k = 0; k < 64; ++k) { const float sv = rdlane(fg, k) * Ss[k * 64 + lane] + rdlane(kk, k) * iv; Ss[k * 64 + lane] = sv; o += rdlane(q, k) * sv; }
        const float ssq = wave_sum(o * o), rs = __builtin_amdgcn_rsqf(ssq * (1.0f / 64) + EPS);
        const float og = bf2f(z[zr + ZHG + h * 64 + lane]);
        ((bf16*)(C.ws + WS_MIX))[(size_t)(MP + b * 4 + t) * D + 768 + h * 64 + lane] = f2bf(o * rs * gnv * sigm(og)); }
    float* os = C.out + O_SS + sb * 4096;
#pragma unroll 8
    for (int k = 0; k < 64; ++k) os[k * 64 + lane] = Ss[k * 64 + lane];
}

DI void copy_row(const bf16* src, float* dst, int lane) {
    const u32x4 w = __builtin_bit_cast(u32x4, ldg8(src + 8 * lane));
    *(f32x4*)(dst + 8 * lane) = (f32x4){lo16(w.x), hi16(w.x), lo16(w.y), hi16(w.y)};
    *(f32x4*)(dst + 8 * lane + 4) = (f32x4){lo16(w.z), hi16(w.z), lo16(w.w), hi16(w.w)}; }
constexpr int CO_PKV = 2 * NB * WB, CO_SKV = 2 * MS, CO_PCV = NB * 3, CO_SCV = SB * 3, CO_ALL = CO_PKV + CO_SKV + CO_PCV + CO_SCV;
DI void copyout_item(const Ctx& C, int l, int it) {
    const bf16* z = (const bf16*)(C.ws + WS_Z); const int lane = C.lane;
    if (it < CO_PKV) { const int which = it / (NB * WB), r = it % (NB * WB), b = r / WB, j = r % WB;
        copy_row(z + (size_t)(b * SEQ + (SEQ - WB) + j) * NZ + (which ? ZV : ZK), C.out + (which ? O_PV : O_PK) + ((size_t)(l * NB + b) * WB + j) * 512, lane); return; }
    it -= CO_PKV;
    if (it < CO_SKV) { const int which = it / MS, r = it % MS;
        copy_row(z + (size_t)(MP + r) * NZ + (which ? ZV : ZK), C.out + (which ? O_SV : O_SK) + ((size_t)l * MS + r) * 512, lane); return; }
    it -= CO_SKV;
    if (it < CO_PCV) { const int b = it / 3, j = it % 3;
        copy_row(z + (size_t)(b * SEQ + SEQ - 3 + j) * NZ + ZMQ, C.out + O_PCONV + ((size_t)(l * NB + b) * 3 + j) * 512, lane); return; }
    it -= CO_PCV;
    { const int b = it / 3, j = it % 3;
        copy_row(z + (size_t)(MP + b * 4 + 1 + j) * NZ + ZMQ, C.out + O_SCONV + ((size_t)(l * SB + b) * 3 + j) * 512, lane); }
}

#define ITEM_LOOP(N, rot, call) do { for (int it = (C.gw + C.NGW - ((rot) % C.NGW)) % C.NGW; it < (N); it += C.NGW) { call; } } while (0)
template <int l> DI void ph_m1(const Ctx& C) {
    ITEM_LOOP(4096, 0, attn_unit<1>(C, l, it));
    ITEM_LOOP(4096, 0, attn_unit<2>(C, l, it));
    ITEM_LOOP(1024, 0, mlstm_m1_item(C, l, it));
    ITEM_LOOP(1024, 1024, hgrn_m1_item(C, l, it));
    ITEM_LOOP(1024, 0, attn_sample_item(C, l, it));
    ITEM_LOOP(128, 1024, mlstm_sample_item(C, l, it));
    ITEM_LOOP(128, 1152, hgrn_sample_item(C, l, it));
}
template <int l> DI void ph_m2(const Ctx& C) {
    ITEM_LOOP(1024, 0, mlstm_m2_item(C, l, it));
    ITEM_LOOP(1024, 1024, hgrn_m2_item(C, l, it));
    ITEM_LOOP(CO_ALL, 0, copyout_item(C, l, it));
}
template <int l> DI void ph_m3(const Ctx& C) {
    ITEM_LOOP(4096, 0, attn_unit<0>(C, l, it));
    ITEM_LOOP(2048, 0, mlstm_m3_item(C, l, it));
    ITEM_LOOP(2048, 0, hgrn_m3_item(C, l, it));
}
DI void ph_final(const Ctx& C) {
    const Params& P = *C.P; const int lane = C.lane;
    const float* H = (const float*)(C.ws + WS_H); const float* SSQ = (const float*)(C.ws + WS_SSQ) + 4 * MPAD;
    for (int m = C.gw; m < MT; m += C.NGW) {
        const float rs = __builtin_amdgcn_rsqf(SSQ[m] * (1.0f / D) + EPS);
        float* o = (m < MP) ? C.out + O_YP + (size_t)m * D : C.out + O_YS + (size_t)(m - MP) * D;
#pragma unroll
        for (int j = 0; j < 4; ++j) { const f32x4 v = *(const f32x4*)(H + (size_t)m * D + 4 * lane + 256 * j), g = *(const f32x4*)(P.in[21] + 4 * lane + 256 * j);
            *(f32x4*)(o + 4 * lane + 256 * j) = v * rs * g; }
    }
}

constexpr int NPH = 16;
#define GRID_SYNC() cg::this_grid().sync()
template <int l> DI void layer_phases(const Ctx& C, const Params& P) {
    float* SSQ = (float*)(C.ws + WS_SSQ);
#define IN(k) (P.ph_lo <= (1 + 7 * l + (k)) && (1 + 7 * l + (k)) < P.ph_hi)
#define SEAM(k) do { if (IN(k) && (1 + 7 * l + (k)) + 1 < P.ph_hi) GRID_SYNC(); } while (0)
    if (IN(0)) { pg8::Gemm g{(const bf16*)(C.ws + WS_HB), (const bf16*)(C.ws + WS_WIN) + (size_t)l * NZ * D, MPAD, NZ, D}; pg8::StaticOrder S; S.init(MPAD, NZ, C.G, (int)blockIdx.x);
        EpiZ E{(bf16*)(C.ws + WS_Z), SSQ + (2 * l) * MPAD, (float*)(C.ws + WS_GATE)};
        pg8::gemm_phase<EpiZ, pg8::StaticOrder, true, true>(C.lds, g, S, E); }
    SEAM(0);
    if (IN(1)) ph_m1<l>(C);
    SEAM(1);
    if (IN(2)) ph_m2<l>(C);
    SEAM(2);
    if (IN(3)) ph_m3<l>(C);
    SEAM(3);
    if (IN(4)) { pg8::Gemm g{(const bf16*)(C.ws + WS_MIX), (const bf16*)(C.ws + WS_WOUT) + (size_t)l * D * D, MPAD, D, D}; pg8::StaticOrder S; S.init(MPAD, D, C.G, (int)blockIdx.x);
        EpiRes E{(float*)(C.ws + WS_H), (bf16*)(C.ws + WS_HB), SSQ + (2 * l + 1) * MPAD};
        pg8::gemm_phase<EpiRes, pg8::StaticOrder, true, true>(C.lds, g, S, E); }
    SEAM(4);
    if (IN(5)) { pg8::Gemm g{(const bf16*)(C.ws + WS_HB), (const bf16*)(C.ws + WS_WUP) + (size_t)l * FF * D, MPAD, FF, D}; pg8::StaticOrder S; S.init(MPAD, FF, C.G, (int)blockIdx.x);
        EpiAct E{(bf16*)(C.ws + WS_ACT), SSQ + (2 * l + 1) * MPAD};
        pg8::gemm_phase<EpiAct, pg8::StaticOrder, true, true>(C.lds, g, S, E); }
    SEAM(5);
    if (IN(6)) { pg8::Gemm g{(const bf16*)(C.ws + WS_ACT), (const bf16*)(C.ws + WS_WDN) + (size_t)l * D * FF, MPAD, D, FF}; pg8::StaticOrder S; S.init(MPAD, D, C.G, (int)blockIdx.x);
        EpiRes E{(float*)(C.ws + WS_H), (bf16*)(C.ws + WS_HB), SSQ + (2 * l + 2) * MPAD};
        pg8::gemm_phase<EpiRes, pg8::StaticOrder, true, true>(C.lds, g, S, E); }
    SEAM(6);
#undef IN
#undef SEAM
}
__global__ void __launch_bounds__(NWAVES * 64, 2) mk_fwd(Params P) {
    extern __shared__ __attribute__((aligned(16))) unsigned char smem[];
    Ctx C; C.P = &P; C.lds = (LAS unsigned char*)smem; C.tid = threadIdx.x; C.lane = C.tid & 63; C.wave = __builtin_amdgcn_readfirstlane(C.tid >> 6);
    C.wl = C.lds + C.wave * WLDS;
    C.G = gridDim.x; { const int bx = blockIdx.x; C.vcu = (C.G % 8 == 0) ? (bx % 8) * (C.G / 8) + bx / 8 : bx; }
    C.gw = C.vcu * NWAVES + C.wave; C.NGW = C.G * NWAVES; C.ws = P.ws; C.out = P.out;
    if (P.ph_lo <= 0 && 0 < P.ph_hi) { ph_prologue(C); if (1 < P.ph_hi) GRID_SYNC(); }
    layer_phases<0>(C, P);
    layer_phases<1>(C, P);
    if (P.ph_lo <= NPH - 1 && NPH - 1 < P.ph_hi) ph_final(C);
}

static int t5_bucket(int n) {
    const int max_exact = 16;
    if (n < max_exact) return n;
    const double scaled = std::log((double)(n < 1 ? 1 : n) / max_exact) / std::log(2048.0 / max_exact);
    int v = max_exact + (int)(scaled * (32 - max_exact));
    return v < 31 ? v : 31;
}

extern "C" void kernel_launch(void* const* d_in, const int* in_sizes, int n_in, void* d_out, int out_size, void* d_ws, size_t ws_size, hipStream_t stream) {
    static int grid = 0;
    if (grid == 0) {
        if (n_in != 22 || (size_t)out_size != O_END || ws_size < WS_END) { fprintf(stderr, "kernel_launch: unexpected shapes n_in %d out %d ws %zu (need %zu)\n", n_in, out_size, ws_size, (size_t)WS_END); grid = -1; return; }
        int dev = 0, cus = 0, per_cu = 0;
        hipGetDevice(&dev); hipDeviceGetAttribute(&cus, hipDeviceAttributeMultiprocessorCount, dev);
        hipFuncSetAttribute((const void*)mk_fwd, hipFuncAttributeMaxDynamicSharedMemorySize, LDS_BYTES);
        hipOccupancyMaxActiveBlocksPerMultiprocessor(&per_cu, (const void*)mk_fwd, NWAVES * 64, LDS_BYTES);
        if (per_cu < 1) { fprintf(stderr, "kernel_launch: occupancy query says %d blocks per CU\n", per_cu); per_cu = 1; }
        (void)hipGetLastError();
        grid = cus;
    }
    if (grid < 0) return;
    Params p{};
    for (int i = 0; i < 22; ++i) p.in[i] = (const float*)d_in[i];
    p.out = (float*)d_out; p.ws = (unsigned char*)d_ws;
    const int dils[3] = {1, 4, 16};
    for (int br = 0; br < 3; ++br) for (int j = 0; j <= 128; ++j) p.bucket[br][j] = (unsigned char)t5_bucket(dils[br] * j);
#if MK_MULTI
    for (int ph = 0; ph < NPH; ++ph) { p.ph_lo = ph; p.ph_hi = ph + 1; hipLaunchKernelGGL(mk_fwd, dim3(grid), dim3(NWAVES * 64), LDS_BYTES, stream, p); }
#else
    p.ph_lo = 0; p.ph_hi = NPH;
    void* args[] = {&p};
    hipError_t e = hipLaunchCooperativeKernel((const void*)mk_fwd, dim3(grid), dim3(NWAVES * 64), args, LDS_BYTES, stream);
    if (e != hipSuccess) fprintf(stderr, "cooperative launch failed: %s (grid %d)\n", hipGetErrorString(e), grid);
#endif
}
```

```cpp
#include <hip/hip_runtime.h>
#include <hip/hip_cooperative_groups.h>
#include <cstdio>
#include <cstdint>
#include <cmath>
namespace cg = cooperative_groups;

#ifndef MK_CGSYNC
#define MK_CGSYNC 0
#endif
#ifndef MK_MULTI
#define MK_MULTI 0
#endif

namespace pg8 {
#define PG8_LAS __attribute__((address_space(3)))
typedef unsigned short bf16_t;
typedef short bf16x8 __attribute__((ext_vector_type(8)));
typedef float f32x4 __attribute__((ext_vector_type(4)));
typedef unsigned u32x4 __attribute__((ext_vector_type(4)));
constexpr int BM = 256, BK = 64, HALF = 128, HTB = HALF * BK * 2, STAGE_BYTES = 8 * HTB, NXCD = 8, WGM = 8;

__host__ __device__ __forceinline__ int lds_byte(int r, int c) { const int st = (r >> 4) * 2 + (c >> 5), rr = r & 15, cc = c & 31, ob = rr * 64 + cc * 2; return st * 1024 + (ob ^ (((ob >> 9) & 1) << 5)); }
__host__ __device__ __forceinline__ void stage_rc(int b, int& R, int& C) { const int st = b / 1024, sb = b % 1024, swz = sb ^ (((sb >> 9) & 1) << 5); R = (st >> 1) * 16 + swz / 64; C = (st & 1) * 32 + (swz % 64) / 2; }
__host__ __device__ __forceinline__ int perm32(int rho) { const int n = rho >> 4, i = rho & 15; return 8 * (i >> 2) + 4 * n + (i & 3); }

struct Unit { int pm, pn; };
struct Gemm { const bf16_t* A; const bf16_t* Bt; int M, N, K; };

struct StaticOrder {
    int nM, nN, nwg, G, c;
    __host__ __device__ void init(int M, int N, int G_, int c_) { nM = M / BM; nN = N / BM; nwg = nM * nN; G = G_; c = c_; }
    __host__ __device__ bool next(int i, Unit& u) const {
        const long L = (long)i * G + c; if (L >= nwg) return false;
        int wgid = (int)L; { const int q = nwg / NXCD, r = nwg % NXCD, xcd = wgid % NXCD, off = wgid / NXCD; wgid = (xcd < r ? xcd * (q + 1) : r * (q + 1) + (xcd - r) * q) + off; }
        const int nig = WGM * nN, gid = wgid / nig, fm = gid * WGM, gsz = (nM - fm) < WGM ? (nM - fm) : WGM;
        u.pm = fm + ((wgid % nig) % gsz); u.pn = (wgid % nig) / gsz; return true;
    }
    __device__ __forceinline__ void a_ready(const Unit&) const {}
    __device__ __forceinline__ void done(const Unit&) const {}
};

__device__ __forceinline__ unsigned cvt_pk_bf16(float lo, float hi) { unsigned r; asm volatile("v_cvt_pk_bf16_f32 %0, %1, %2" : "=v"(r) : "v"(lo), "v"(hi)); return r; }

template <class Epi, class Sched, bool ALIGN_EPI = false, bool SP2 = false>
__device__ __forceinline__ void gemm_phase(PG8_LAS unsigned char* lds, const Gemm g, const Sched& S, const Epi& E) {
    const int tid = threadIdx.x, wid = __builtin_amdgcn_readfirstlane(tid >> 6), lane = tid & 63, wr = wid >> 2, wc = wid & 3, fr = lane & 15, fq = lane >> 4;
    const int K = g.K, nt = K / BK;
    unsigned voffA[2], voffB[2];
#pragma unroll
    for (int i = 0; i < 2; ++i) { int R, C; stage_rc(tid * 16 + i * 8192, R, C); const int Rb = Epi::PERM ? ((R & ~31) + perm32(R & 31)) : R;
        voffA[i] = (unsigned)(R * K + C) * 2u; voffB[i] = (unsigned)(Rb * K + C) * 2u; }
    const size_t kstep = (size_t)(BK * 2);
    const size_t hstep = (size_t)HALF * K * 2;
    const size_t tstep = 2 * hstep;
    const unsigned ldsw = (unsigned)wid * 1024u;
    const int aoff = lds_byte(wr * 64 + fr, fq * 8), boff = lds_byte(wc * 32 + fr, fq * 8);
#define PG8_SA(b, h) (((b) * 2 + (h)) * HTB)
#define PG8_SB(b, h) ((4 + (b) * 2 + (h)) * HTB)
#define PG8_STAGE(bufoff, gbase, voff) do { _Pragma("unroll") for (int _i = 0; _i < 2; ++_i) \
        __builtin_amdgcn_global_load_lds((const unsigned*)((const char*)(gbase) + (voff)[_i]), (PG8_LAS unsigned*)(lds + (bufoff) + ldsw + _i * 8192), 16, 0, 0); } while (0)
#define PG8_LDA(dst, b, h) do { _Pragma("unroll") for (int m = 0; m < 4; ++m) _Pragma("unroll") for (int k = 0; k < 2; ++k) dst[m][k] = *(const PG8_LAS bf16x8*)(lds + PG8_SA(b, h) + aoff + m * 2048 + k * 1024); } while (0)
#define PG8_LDB(dst, b, h) do { _Pragma("unroll") for (int n = 0; n < 2; ++n) _Pragma("unroll") for (int k = 0; k < 2; ++k) dst[n][k] = *(const PG8_LAS bf16x8*)(lds + PG8_SB(b, h) + boff + n * 2048 + k * 1024); } while (0)
#define PG8_MMA(ai, bj, At, Bt) do { __builtin_amdgcn_s_setprio(1); _Pragma("unroll") for (int m = 0; m < 4; ++m) _Pragma("unroll") for (int n = 0; n < 2; ++n) _Pragma("unroll") for (int k = 0; k < 2; ++k) \
        acc[ai][bj][m][n] = __builtin_amdgcn_mfma_f32_16x16x32_bf16(Bt[n][k], At[m][k], acc[ai][bj][m][n], 0, 0, 0); __builtin_amdgcn_s_setprio(0); } while (0)
#define PG8_WAIT_V(n) asm volatile("s_waitcnt vmcnt(" #n ")" ::: "memory")
#define PG8_WAIT_L(n) asm volatile("s_waitcnt lgkmcnt(" #n ")" ::: "memory")
#define PG8_BAR __builtin_amdgcn_s_barrier()
#define PG8_SCHED __builtin_amdgcn_sched_barrier(0)
    Unit cur, nxt; int ui = 0;
    if (!S.next(0, cur)) return;
    f32x4 acc[2][2][4][2];
#pragma unroll
    for (int a = 0; a < 2; ++a)
#pragma unroll
        for (int b = 0; b < 2; ++b)
#pragma unroll
            for (int m = 0; m < 4; ++m)
#pragma unroll
                for (int n = 0; n < 2; ++n) acc[a][b][m][n] = (f32x4){0.f, 0.f, 0.f, 0.f};
    bf16x8 At[4][2], B0[2][2], B1[2][2];
    const char* cA = (const char*)g.A + (size_t)cur.pm * tstep; const char* cB = (const char*)g.Bt + (size_t)cur.pn * tstep;
    S.a_ready(cur);
    if constexpr (SP2) {
        PG8_STAGE(PG8_SB(0, 0), cB, voffB); PG8_STAGE(PG8_SB(0, 1), cB + hstep, voffB); PG8_STAGE(PG8_SA(0, 0), cA, voffA); PG8_STAGE(PG8_SA(0, 1), cA + hstep, voffA);
        if (wr == 1) PG8_BAR;
        PG8_WAIT_V(2); PG8_BAR;
        PG8_STAGE(PG8_SB(1, 0), cB + kstep, voffB); PG8_STAGE(PG8_SA(1, 0), cA + kstep, voffA); PG8_STAGE(PG8_SB(1, 1), cB + hstep + kstep, voffB);
        PG8_WAIT_V(6); PG8_BAR;
    } else {
        PG8_STAGE(PG8_SB(0, 0), cB, voffB); PG8_STAGE(PG8_SA(0, 0), cA, voffA); PG8_STAGE(PG8_SB(0, 1), cB + hstep, voffB); PG8_STAGE(PG8_SA(0, 1), cA + hstep, voffA);
        if (wr == 1) PG8_BAR;
        PG8_WAIT_V(4); PG8_BAR;
        PG8_STAGE(PG8_SB(1, 0), cB + kstep, voffB); PG8_STAGE(PG8_SA(1, 0), cA + kstep, voffA); PG8_STAGE(PG8_SB(1, 1), cB + hstep + kstep, voffB);
        PG8_WAIT_V(6); PG8_BAR;
    }
    for (;;) {
        const bool has_next = S.next(ui + 1, nxt);
        const char* nA = has_next ? (const char*)g.A + (size_t)nxt.pm * tstep : cA; const char* nB = has_next ? (const char*)g.Bt + (size_t)nxt.pn * tstep : cB;
        for (int t = 0; t < nt; t += 2) {
            const bool last = (t == nt - 2);
            const char* a1 = cA + (size_t)(t + 1) * kstep;
            const char* a2 = last ? nA : cA + (size_t)(t + 2) * kstep; const char* b2 = last ? nB : cB + (size_t)(t + 2) * kstep;
            const char* a3 = a2 + kstep; const char* b3 = b2 + kstep;
            if (last && has_next) S.a_ready(nxt);
            if constexpr (SP2) {
            PG8_LDB(B0, 0, 0); PG8_LDB(B1, 0, 1); PG8_SCHED; PG8_LDA(At, 0, 0); PG8_STAGE(PG8_SA(1, 1), a1 + hstep, voffA);
            PG8_WAIT_V(8); PG8_WAIT_L(0); PG8_BAR; PG8_MMA(0, 0, At, B0); PG8_MMA(0, 1, At, B1); PG8_BAR; PG8_SCHED;
            PG8_LDA(At, 0, 1); PG8_STAGE(PG8_SB(0, 0), b2, voffB); PG8_STAGE(PG8_SB(0, 1), b2 + hstep, voffB); PG8_STAGE(PG8_SA(0, 0), a2, voffA);
            PG8_WAIT_V(8); PG8_WAIT_L(0); PG8_BAR; PG8_MMA(1, 0, At, B0); PG8_MMA(1, 1, At, B1); PG8_BAR; PG8_SCHED;
            PG8_LDB(B0, 1, 0); PG8_LDB(B1, 1, 1); PG8_SCHED; PG8_LDA(At, 1, 0); PG8_STAGE(PG8_SA(0, 1), a2 + hstep, voffA);
            PG8_WAIT_V(8); PG8_WAIT_L(0); PG8_BAR; PG8_MMA(0, 0, At, B0); PG8_MMA(0, 1, At, B1); PG8_BAR; PG8_SCHED;
            PG8_LDA(At, 1, 1); PG8_STAGE(PG8_SB(1, 0), b3, voffB); PG8_STAGE(PG8_SB(1, 1), b3 + hstep, voffB); PG8_STAGE(PG8_SA(1, 0), a3, voffA);
            PG8_WAIT_V(8); PG8_WAIT_L(0); PG8_BAR; PG8_MMA(1, 0, At, B0); PG8_MMA(1, 1, At, B1); PG8_BAR; PG8_SCHED;
            } else {
            PG8_LDB(B0, 0, 0); PG8_SCHED; PG8_LDA(At, 0, 0); PG8_STAGE(PG8_SA(1, 1), a1 + hstep, voffA);
            PG8_WAIT_L(8); PG8_BAR; PG8_WAIT_L(0); PG8_MMA(0, 0, At, B0); PG8_BAR; PG8_SCHED;
            PG8_LDB(B1, 0, 1); PG8_STAGE(PG8_SB(0, 0), b2, voffB);
            PG8_BAR; PG8_WAIT_L(0); PG8_MMA(0, 1, At, B1); PG8_BAR;
            PG8_LDA(At, 0, 1); PG8_STAGE(PG8_SA(0, 0), a2, voffA);
            PG8_BAR; PG8_WAIT_L(0); PG8_MMA(1, 0, At, B0); PG8_BAR; PG8_SCHED;
            PG8_STAGE(PG8_SB(0, 1), b2 + hstep, voffB);
            PG8_WAIT_V(6); PG8_BAR; PG8_MMA(1, 1, At, B1); PG8_BAR;
            PG8_LDB(B0, 1, 0); PG8_SCHED; PG8_LDA(At, 1, 0); PG8_STAGE(PG8_SA(0, 1), a2 + hstep, voffA);
            PG8_WAIT_L(8); PG8_BAR; PG8_WAIT_L(0); PG8_MMA(0, 0, At, B0); PG8_BAR; PG8_SCHED;
            PG8_LDB(B1, 1, 1); PG8_STAGE(PG8_SB(1, 0), b3, voffB);
            PG8_BAR; PG8_WAIT_L(0); PG8_MMA(0, 1, At, B1); PG8_BAR;
            PG8_LDA(At, 1, 1); PG8_STAGE(PG8_SA(1, 0), a3, voffA);
            PG8_BAR; PG8_WAIT_L(0); PG8_MMA(1, 0, At, B0); PG8_BAR; PG8_SCHED;
            PG8_STAGE(PG8_SB(1, 1), b3 + hstep, voffB);
            PG8_WAIT_V(6); PG8_BAR; PG8_MMA(1, 1, At, B1); PG8_BAR;
            }
        }
        if constexpr (ALIGN_EPI) { if (wr == 0) PG8_BAR; }
        E(acc, cur, wr, wc, fr, fq);
        if (!has_next) break;
#pragma unroll
        for (int a = 0; a < 2; ++a)
#pragma unroll
            for (int b = 0; b < 2; ++b)
#pragma unroll
                for (int m = 0; m < 4; ++m)
#pragma unroll
                    for (int n = 0; n < 2; ++n) acc[a][b][m][n] = (f32x4){0.f, 0.f, 0.f, 0.f};
        cur = nxt; cA = nA; cB = nB; ++ui;
        if constexpr (ALIGN_EPI) { if (wr == 1) PG8_BAR; }
    }
    PG8_WAIT_V(0);
    if constexpr (!ALIGN_EPI) { if (wr == 0) PG8_BAR; }
    PG8_BAR;
#undef PG8_SA
#undef PG8_SB
#undef PG8_STAGE
#undef PG8_LDA
#undef PG8_LDB
#undef PG8_MMA
#undef PG8_WAIT_V
#undef PG8_WAIT_L
#undef PG8_BAR
#undef PG8_SCHED
}
}

#define LAS __attribute__((address_space(3)))
#define DI __device__ __forceinline__
typedef unsigned short bf16;
typedef short bf16x8 __attribute__((ext_vector_type(8)));
typedef short s16x4 __attribute__((ext_vector_type(4)));
typedef float f32x16 __attribute__((ext_vector_type(16)));
typedef float f32x4 __attribute__((ext_vector_type(4)));
typedef float f32x2 __attribute__((ext_vector_type(2)));
typedef unsigned u32x4 __attribute__((ext_vector_type(4)));
typedef unsigned u32x2 __attribute__((ext_vector_type(2)));
typedef __bf16 bf16x2_t __attribute__((ext_vector_type(2)));
typedef short v4i16_t __attribute__((ext_vector_type(4)));

constexpr int D = 1024, SEQ = 4096, NB = 4, MP = NB * SEQ, SB = 32, STK = 4, MS = SB * STK, MT = MP + MS, MPAD = 16640;
constexpr int NZ = 3840, FF = 4096, NWAVES = 8, NCHUNK = 64, WB = 2048;
constexpr int ZQ = 0, ZK = 512, ZV = 1024, ZMQ = 1536, ZMK = 1792, ZMV = 2048, ZMO = 2304, ZHQ = 2560, ZHF = 2816, ZHI = 3072, ZHG = 3328, ZG = 3584;
constexpr float EPS = 1e-6f;
constexpr float LOG2E = 1.4426950408889634f;

constexpr size_t O_YP = 0, O_YS = O_YP + (size_t)MP * D, O_PK = O_YS + (size_t)MS * D, O_PV = O_PK + (size_t)2 * NB * WB * 512, O_PCONV = O_PV + (size_t)2 * NB * WB * 512,
    O_PC = O_PCONV + 2 * NB * 3 * 512, O_PN = O_PC + 2 * NB * 4 * 4096, O_PM = O_PN + 2 * NB * 4 * 64, O_PS = O_PM + 2 * NB * 4, O_SK = O_PS + 2 * NB * 4 * 4096,
    O_SV = O_SK + (size_t)2 * SB * STK * 512, O_SCONV = O_SV + (size_t)2 * SB * STK * 512, O_SC = O_SCONV + 2 * SB * 3 * 512, O_SN = O_SC + (size_t)2 * SB * 4 * 4096,
    O_SM = O_SN + 2 * SB * 4 * 64, O_SS = O_SM + 2 * SB * 4, O_END = O_SS + (size_t)2 * SB * 4 * 4096;

constexpr size_t al256(size_t x) { return (x + 255) & ~(size_t)255; }
constexpr size_t WS_WIN = 0;
constexpr size_t WS_WOUT = WS_WIN + (size_t)2 * NZ * D * 2;
constexpr size_t WS_WUP = WS_WOUT + (size_t)2 * D * D * 2;
constexpr size_t WS_WDN = WS_WUP + (size_t)2 * FF * D * 2;
constexpr size_t WS_H = WS_WDN + (size_t)2 * D * FF * 2;
constexpr size_t WS_HB = WS_H + (size_t)MPAD * D * 4;
constexpr size_t WS_SSQ = WS_HB + (size_t)MPAD * D * 2;
constexpr size_t WS_Z = al256(WS_SSQ + (size_t)5 * MPAD * 4);
constexpr size_t WS_GATE = WS_Z + (size_t)MPAD * NZ * 2;
constexpr size_t WS_MIX = WS_GATE + (size_t)MPAD * 8 * 4;
constexpr size_t WS_ACT = WS_MIX + (size_t)MPAD * D * 2;
constexpr size_t WS_PO = WS_ACT + (size_t)MPAD * FF * 2;
constexpr size_t WS_PLSE = WS_PO + (size_t)2 * MP * 512 * 2;
constexpr size_t WS_BIAST = WS_PLSE + (size_t)2 * MP * 8 * 4;
constexpr size_t WS_LBV = al256(WS_BIAST + 3 * 8 * 132 * 4);
constexpr size_t WS_MLQC = WS_LBV + 2 * 256 * 4;
constexpr size_t WS_MLKC = WS_MLQC + (size_t)MP * 256 * 2;
constexpr size_t WS_MLB = WS_MLKC + (size_t)MP * 256 * 2;
constexpr size_t WS_MLU = WS_MLB + (size_t)16 * SEQ * 4;
constexpr size_t WS_MLA = WS_MLU + (size_t)16 * SEQ * 4;
constexpr size_t WS_MLBL = WS_MLA + 16 * 64 * 4;
constexpr size_t WS_MLMC = WS_MLBL + 16 * 64 * 4;
constexpr size_t WS_MLKVT = WS_MLMC + 16 * 64 * 4;
constexpr size_t WS_MLKN = WS_MLKVT + (size_t)16 * 64 * 4096 * 4;
constexpr size_t WS_MLCT = WS_MLKN + (size_t)16 * 64 * 64 * 4;
constexpr size_t WS_MLNC = WS_MLCT + (size_t)16 * 64 * 4096 * 2;
constexpr size_t WS_HGQT = WS_MLNC + (size_t)16 * 64 * 64 * 4;
constexpr size_t WS_HGKT = WS_HGQT + (size_t)MP * 256 * 2;
constexpr size_t WS_HGQB = WS_HGKT + (size_t)MP * 256 * 2;
constexpr size_t WS_HGGT = WS_HGQB + (size_t)MP * 256 * 2;
constexpr size_t WS_HGDL = WS_HGGT + (size_t)16 * 64 * 4096 * 4;
constexpr size_t WS_HGST = WS_HGDL + (size_t)16 * 64 * 64 * 4;
constexpr size_t WS_BAR = WS_HGST + (size_t)16 * 64 * 4096 * 2;
constexpr size_t WS_END = WS_BAR + 16384;

constexpr int LDS_BYTES = 147456 + 256;
constexpr int LDS_CTL = 147456;
constexpr int WLDS = 18432;
constexpr int VSTR = 144;

struct Params {
    const float* in[22];
    float* out;
    unsigned char* ws;
    int ph_lo, ph_hi;
    unsigned char bucket[3][136];
};

DI float bf2f(bf16 v) { return __builtin_bit_cast(float, (unsigned)v << 16); }
DI unsigned pk2(float lo, float hi) { f32x2 v = {lo, hi}; bf16x2_t b = __builtin_convertvector(v, bf16x2_t); return __builtin_bit_cast(unsigned, b); }
DI bf16 f2bf(float x) { return (bf16)(pk2(x, 0.f) & 0xffffu); }
DI float lo16(unsigned w) { return __builtin_bit_cast(float, w << 16); }
DI float hi16(unsigned w) { return __builtin_bit_cast(float, w & 0xffff0000u); }
DI int crow(int reg, int hh) { return (reg & 3) + 8 * (reg >> 2) + 4 * hh; }
DI bf16x8 ldg8(const bf16* p) { return *(const bf16x8*)p; }
DI float fexp(float x) { return __builtin_amdgcn_exp2f(x * LOG2E); }
DI float flog(float x) { return __builtin_amdgcn_logf(x) * 0.6931471805599453f; }
DI float sigm(float x) { return 1.0f / (1.0f + fexp(-x)); }
DI float silu(float x) { return x * sigm(x); }
DI float logsig(float x) { return fminf(x, 0.f) - flog(1.0f + fexp(-fabsf(x))); }
DI float wave_sum(float v) {
#pragma unroll
    for (int o = 1; o < 64; o <<= 1) v += __shfl_xor(v, o);
    return v; }
DI float wave_max(float v) {
#pragma unroll
    for (int o = 1; o < 64; o <<= 1) v = fmaxf(v, __shfl_xor(v, o));
    return v; }
#define MFMA32(a, b, c) __builtin_amdgcn_mfma_f32_32x32x16_bf16((a), (b), (c), 0, 0, 0)
DI bf16x8 pack8(const f32x16& x, int s) {
    u32x4 p; p.x = pk2(x[8 * s], x[8 * s + 1]); p.y = pk2(x[8 * s + 2], x[8 * s + 3]); p.z = pk2(x[8 * s + 4], x[8 * s + 5]); p.w = pk2(x[8 * s + 6], x[8 * s + 7]);
    return __builtin_bit_cast(bf16x8, p); }
DI s16x4 vtr(LAS const unsigned char* p) { return __builtin_bit_cast(s16x4, __builtin_amdgcn_ds_read_tr16_b64_v4i16((LAS v4i16_t*)p)); }
template <bool PERMK> DI bf16x8 tr_frag(LAS const unsigned char* tile, int k0, int n0, int lane) {
    const int hh = lane >> 5, q = (lane & 15) >> 2, col = n0 + 16 * ((lane >> 4) & 1) + 4 * (lane & 3);
    const int r1 = k0 + (PERMK ? 4 * hh : 8 * hh) + q, r2 = r1 + (PERMK ? 8 : 4);
    const s16x4 lo = vtr(tile + r1 * VSTR + col * 2), hi = vtr(tile + r2 * VSTR + col * 2);
    return __builtin_shufflevector(lo, hi, 0, 1, 2, 3, 4, 5, 6, 7); }
DI f32x16 zero16() { f32x16 z; for (int i = 0; i < 16; ++i) z[i] = 0.f; return z; }

struct XcdBarrier { unsigned* bar; unsigned x; volatile LAS unsigned* st; };
struct Ctx {
    const Params* P; LAS unsigned char* lds; LAS unsigned char* wl; int tid, lane, wave, vcu, G, gw, NGW;
    unsigned char* ws; float* out; XcdBarrier xb;
};

struct EpiZ {
    static constexpr bool PERM = true;
    bf16* Z; const float* ssq; float* gate;
    DI void operator()(const f32x4 (&acc)[2][2][4][2], const pg8::Unit& u, int wr, int wc, int fr, int fq) const {
        const int row0 = u.pm * 256 + wr * 64 + fr, col0 = u.pn * 256 + wc * 32 + 8 * fq;
#pragma unroll
        for (int ai = 0; ai < 2; ++ai)
#pragma unroll
            for (int m = 0; m < 4; ++m) { const int row = row0 + ai * 128 + m * 16; const float rs = __builtin_amdgcn_rsqf(ssq[row] * (1.0f / D) + EPS);
                bf16* rowp = Z + (size_t)row * NZ + col0;
#pragma unroll
                for (int bj = 0; bj < 2; ++bj) { const f32x4 v0 = acc[ai][bj][m][0] * rs, v1 = acc[ai][bj][m][1] * rs;
                    u32x4 w; w.x = pk2(v0[0], v0[1]); w.y = pk2(v0[2], v0[3]); w.z = pk2(v1[0], v1[1]); w.w = pk2(v1[2], v1[3]);
                    *(u32x4*)(rowp + bj * 128) = w;
                    if (u.pn == 14 && bj == 0 && col0 == ZG) { *(f32x4*)(gate + (size_t)row * 8) = v0; *(f32x4*)(gate + (size_t)row * 8 + 4) = v1; } } }
    }
};
struct EpiAct {
    static constexpr bool PERM = true;
    bf16* O; const float* ssq;
    DI void operator()(const f32x4 (&acc)[2][2][4][2], const pg8::Unit& u, int wr, int wc, int fr, int fq) const {
        const int row0 = u.pm * 256 + wr * 64 + fr, col0 = u.pn * 256 + wc * 32 + 8 * fq;
#pragma unroll
        for (int ai = 0; ai < 2; ++ai)
#pragma unroll
            for (int m = 0; m < 4; ++m) { const int row = row0 + ai * 128 + m * 16; const float rs = __builtin_amdgcn_rsqf(ssq[row] * (1.0f / D) + EPS);
                bf16* rowp = O + (size_t)row * FF + col0;
#pragma unroll
                for (int bj = 0; bj < 2; ++bj) { f32x4 v0 = acc[ai][bj][m][0] * rs, v1 = acc[ai][bj][m][1] * rs;
#pragma unroll
                    for (int j = 0; j < 4; ++j) { const float a = fmaxf(v0[j], 0.f), b = fmaxf(v1[j], 0.f); v0[j] = a * a; v1[j] = b * b; }
                    u32x4 w; w.x = pk2(v0[0], v0[1]); w.y = pk2(v0[2], v0[3]); w.z = pk2(v1[0], v1[1]); w.w = pk2(v1[2], v1[3]);
                    *(u32x4*)(rowp + bj * 128) = w; } }
    }
};
struct EpiRes {
    static constexpr bool PERM = false;
    float* H; bf16* HB; float* ssq;
    DI void operator()(const f32x4 (&acc)[2][2][4][2], const pg8::Unit& u, int wr, int wc, int fr, int fq) const {
        const int row0 = u.pm * 256 + wr * 64 + fr, col0 = u.pn * 256 + wc * 32 + 4 * fq;
#pragma unroll
        for (int ai = 0; ai < 2; ++ai)
#pragma unroll
            for (int m = 0; m < 4; ++m) { const int row = row0 + ai * 128 + m * 16; float* hp = H + (size_t)row * D + col0; bf16* bp = HB + (size_t)row * D + col0; float s = 0.f;
#pragma unroll
                for (int bj = 0; bj < 2; ++bj)
#pragma unroll
                    for (int n = 0; n < 2; ++n) { const f32x4 x = *(const f32x4*)(hp + bj * 128 + n * 16) + acc[ai][bj][m][n];
                        *(f32x4*)(hp + bj * 128 + n * 16) = x; u32x2 w; w.x = pk2(x[0], x[1]); w.y = pk2(x[2], x[3]); *(u32x2*)(bp + bj * 128 + n * 16) = w;
                        s += (x[0] * x[0] + x[1] * x[1]) + (x[2] * x[2] + x[3] * x[3]); }
                s += __shfl_xor(s, 16); s += __shfl_xor(s, 32);
                if (fq == 0) atomicAdd(ssq + row, s); }
    }
};

DI void transpose_item(const float* __restrict__ W, int K, int Nsrc, int src_c0, int nvalid, const float* __restrict__ gs, bf16* __restrict__ WT, int dst_row0, int k0, LAS float* scr, int lane) {
#pragma unroll 8
    for (int i = 0; i < 32; ++i) { const int kk = 2 * i + (lane >> 5), n = lane & 31;
        float v = 0.f; if (n < nvalid) { v = W[(size_t)(k0 + kk) * Nsrc + src_c0 + n]; if (gs) v *= gs[k0 + kk]; }
        scr[kk * 33 + n] = v; }
    asm volatile("s_waitcnt lgkmcnt(0)" ::: "memory");
    const int c = lane & 7;
#pragma unroll
    for (int j = 0; j < 4; ++j) { const int n = (lane >> 3) + 8 * j; const LAS float* s = scr + (8 * c) * 33 + n;
        u32x4 o; o.x = pk2(s[0 * 33], s[1 * 33]); o.y = pk2(s[2 * 33], s[3 * 33]); o.z = pk2(s[4 * 33], s[5 * 33]); o.w = pk2(s[6 * 33], s[7 * 33]);
        *(u32x4*)(WT + (size_t)(dst_row0 + n) * K + k0 + 8 * c) = o; }
    asm volatile("s_waitcnt lgkmcnt(0)" ::: "memory");
}
DI void ph_prologue(const Ctx& C) {
    const Params& P = *C.P; const int lane = C.lane;
    LAS float* scr = (LAS float*)C.wl;
    constexpr int I_IN = 16 * (NZ / 32), I_OUT = 16 * (D / 32), I_UP = 16 * (FF / 32), I_DN = 64 * (D / 32), I_L = I_IN + I_OUT + I_UP + I_DN;
    for (int it = C.gw; it < 2 * I_L; it += C.NGW) {
        const int l = it / I_L; int r = it % I_L;
        if (r < I_IN) { const int nb = r % (NZ / 32), kb = r / (NZ / 32), n0 = nb * 32;
            int c0, nv;
            if (n0 < 2560) { c0 = n0; nv = 32; } else if (n0 < ZG) { c0 = n0 + 8; nv = 32; } else if (n0 == ZG) { c0 = 2560; nv = 8; } else { c0 = 0; nv = 0; }
            transpose_item(P.in[11] + (size_t)l * D * 3592, D, 3592, c0, nv, P.in[10] + l * D, (bf16*)(C.ws + WS_WIN) + (size_t)l * NZ * D, n0, kb * 64, scr, lane); continue; }
        r -= I_IN;
        if (r < I_OUT) { const int nb = r % (D / 32), kb = r / (D / 32);
            transpose_item(P.in[17] + (size_t)l * D * D, D, D, nb * 32, 32, nullptr, (bf16*)(C.ws + WS_WOUT) + (size_t)l * D * D, nb * 32, kb * 64, scr, lane); continue; }
        r -= I_OUT;
        if (r < I_UP) { const int nb = r % (FF / 32), kb = r / (FF / 32);
            transpose_item(P.in[19] + (size_t)l * D * FF, D, FF, nb * 32, 32, P.in[18] + l * D, (bf16*)(C.ws + WS_WUP) + (size_t)l * FF * D, nb * 32, kb * 64, scr, lane); continue; }
        r -= I_UP;
        { const int nb = r % (D / 32), kb = r / (D / 32);
            transpose_item(P.in[20] + (size_t)l * FF * D, FF, D, nb * 32, 32, nullptr, (bf16*)(C.ws + WS_WDN) + (size_t)l * D * FF, nb * 32, kb * 64, scr, lane); }
    }
    float* H = (float*)(C.ws + WS_H); bf16* HB = (bf16*)(C.ws + WS_HB); float* SSQ = (float*)(C.ws + WS_SSQ);
    for (int m = C.gw; m < MPAD; m += C.NGW) {
        f32x4 v[4]; float s = 0.f;
        if (m < MT) { const float* xr = (m < MP) ? P.in[0] + (size_t)m * D : P.in[1] + (size_t)(m - MP) * D;
#pragma unroll
            for (int j = 0; j < 4; ++j) { v[j] = *(const f32x4*)(xr + 4 * lane + 256 * j); s += (v[j].x * v[j].x + v[j].y * v[j].y) + (v[j].z * v[j].z + v[j].w * v[j].w); }
        } else {
#pragma unroll
            for (int j = 0; j < 4; ++j) v[j] = (f32x4){0.f, 0.f, 0.f, 0.f}; }
        s = wave_sum(s);
#pragma unroll
        for (int j = 0; j < 4; ++j) { *(f32x4*)(H + (size_t)m * D + 4 * lane + 256 * j) = v[j]; u32x2 w; w.x = pk2(v[j].x, v[j].y); w.y = pk2(v[j].z, v[j].w); *(u32x2*)(HB + (size_t)m * D + 4 * lane + 256 * j) = w; }
        if (lane == 0) SSQ[m] = s;
    }
    for (int i = C.gw * 64 + lane; i < 4 * MPAD; i += C.NGW * 64) SSQ[MPAD + i] = 0.f;
    float* BT = (float*)(C.ws + WS_BIAST);
    for (int i = C.gw * 64 + lane; i < 3 * 8 * 132; i += C.NGW * 64) { const int br = i / (8 * 132), h = (i / 132) % 8, j = i % 132; BT[i] = (j <= 128) ? P.in[9][(int)P.bucket[br][j] * 8 + h] : 0.f; }
    float* LBV = (float*)(C.ws + WS_LBV);
    for (int i = C.gw * 64 + lane; i < 512; i += C.NGW * 64) { const int c = i & 255; LBV[i] = (i < 256) ? 0.f : sigm(P.in[15][256 + c] - P.in[15][c]); }
}

template <int br> DI void attn_unit(const Ctx& C, int l, int u) {
    const int lane = C.lane, t = lane & 31, hh = lane >> 5;
    constexpr int dil = br == 0 ? 1 : (br == 1 ? 4 : 16), nblk = 128 / dil;
    const int bh = u >> 7, rem = u & 127, r = rem / nblk, blk = rem % nblk, b = bh >> 3, h = bh & 7, i0 = blk * 32;
    const bf16* zb = (const bf16*)(C.ws + WS_Z) + (size_t)(b * SEQ) * NZ;
    const float* BT = (const float*)(C.ws + WS_BIAST) + (br * 8 + h) * 132;
    const int pq = (i0 + t) * dil + r;
    bf16x8 qf[4];
#pragma unroll
    for (int s = 0; s < 4; ++s) qf[s] = ldg8(zb + (size_t)pq * NZ + ZQ + h * 64 + 16 * s + 8 * hh);
    const int kt0 = blk < 4 ? 4 - blk : 0;
    const ptrdiff_t tile_step = (ptrdiff_t)32 * dil * NZ;
    const bf16* kp = zb + ((ptrdiff_t)(i0 - 128 + t) * dil + r) * NZ + ZK + h * 64 + 8 * hh + kt0 * tile_step;
    const bf16* vp = zb + ((ptrdiff_t)(i0 - 128 + (lane >> 3)) * dil + r) * NZ + ZV + h * 64 + 8 * (lane & 7) + kt0 * tile_step;
    f32x16 O[2]; O[0] = zero16(); O[1] = zero16();
    float mx = -1e30f, lsum = 0.f;
#pragma unroll 1
    for (int kt = kt0; kt < 5; ++kt, kp += tile_step, vp += tile_step) {
        f32x16 S = zero16();
#pragma unroll
        for (int s = 0; s < 4; ++s) S = MFMA32(ldg8(kp + 16 * s), qf[s], S);
        LAS unsigned char* vt = C.wl + (kt & 1) * (32 * VSTR);
#pragma unroll
        for (int i = 0; i < 4; ++i) *(LAS bf16x8*)(vt + ((lane >> 3) + 8 * i) * VSTR + (lane & 7) * 16) = ldg8(vp + (ptrdiff_t)(8 * i) * dil * NZ);
        float tm = -1e30f;
        const int jb = 128 + t - 32 * kt;
#pragma unroll
        for (int reg = 0; reg < 16; ++reg) { const int j = jb - crow(reg, hh); const bool ok = (j >= 0) && (j <= 128);
            const float sc = ok ? S[reg] * 0.125f + BT[ok ? j : 0] : -1e30f; S[reg] = sc; tm = fmaxf(tm, sc); }
        tm = fmaxf(tm, __shfl_xor(tm, 32));
        const float mn = fmaxf(mx, tm), alpha = fexp(mx - mn); mx = mn;
        float ps = 0.f;
#pragma unroll
        for (int reg = 0; reg < 16; ++reg) { const float p = fexp(S[reg] - mn); S[reg] = p; ps += p; }
        lsum = lsum * alpha + ps;
#pragma unroll
        for (int reg = 0; reg < 16; ++reg) { O[0][reg] *= alpha; O[1][reg] *= alpha; }
#pragma unroll
        for (int ks = 0; ks < 2; ++ks) { const bf16x8 pf = pack8(S, ks);
#pragma unroll
            for (int db = 0; db < 2; ++db) O[db] = MFMA32(tr_frag<true>(vt, 16 * ks, 32 * db, lane), pf, O[db]); }
    }
    lsum += __shfl_xor(lsum, 32);
    const float inv = 1.0f / lsum, lse = mx + flog(lsum);
    const size_t row = (size_t)b * SEQ + pq;
    if (br != 0) {
        bf16* po = (bf16*)(C.ws + WS_PO) + (size_t)(br - 1) * MP * 512 + row * 512 + h * 64;
#pragma unroll
        for (int db = 0; db < 2; ++db)
#pragma unroll
            for (int g = 0; g < 4; ++g) { u32x2 w; w.x = pk2(O[db][4 * g] * inv, O[db][4 * g + 1] * inv); w.y = pk2(O[db][4 * g + 2] * inv, O[db][4 * g + 3] * inv);
                *(u32x2*)(po + 32 * db + 8 * g + 4 * hh) = w; }
        if (hh == 0) ((float*)(C.ws + WS_PLSE))[(size_t)(br - 1) * MP * 8 + row * 8 + h] = lse;
    } else {
        const float l1 = ((const float*)(C.ws + WS_PLSE))[row * 8 + h], l2 = ((const float*)(C.ws + WS_PLSE))[(size_t)MP * 8 + row * 8 + h];
        const float M = fmaxf(lse, fmaxf(l1, l2)), w0 = fexp(lse - M), w1 = fexp(l1 - M), w2 = fexp(l2 - M), iw = 1.0f / (w0 + w1 + w2);
        const float c0 = w0 * iw * inv, c1 = w1 * iw, c2 = w2 * iw;
        const bf16* p1 = (const bf16*)(C.ws + WS_PO) + row * 512 + h * 64; const bf16* p2 = p1 + (size_t)MP * 512;
        bf16* mx_ = (bf16*)(C.ws + WS_MIX) + row * D + h * 64;
#pragma unroll
        for (int db = 0; db < 2; ++db)
#pragma unroll
            for (int g = 0; g < 4; ++g) { const int d0 = 32 * db + 8 * g + 4 * hh; const u32x2 a = *(const u32x2*)(p1 + d0), bq = *(const u32x2*)(p2 + d0);
                const float y0 = c0 * O[db][4 * g] + c1 * lo16(a.x) + c2 * lo16(bq.x), y1 = c0 * O[db][4 * g + 1] + c1 * hi16(a.x) + c2 * hi16(bq.x);
                const float y2 = c0 * O[db][4 * g + 2] + c1 * lo16(a.y) + c2 * lo16(bq.y), y3 = c0 * O[db][4 * g + 3] + c1 * hi16(a.y) + c2 * hi16(bq.y);
                u32x2 w; w.x = pk2(y0, y1); w.y = pk2(y2, y3); *(u32x2*)(mx_ + d0) = w; }
    }
}

DI void attn_sample_item(const Ctx& C, int l, int it) {
    const Params& P = *C.P; const int lane = C.lane, g = lane >> 4, i = lane & 15;
    const int b = it >> 5, t = (it >> 3) & 3, h = it & 7, srow = MP + b * 4 + t;
    const bf16* z = (const bf16*)(C.ws + WS_Z);
    LAS float* sc = (LAS float*)C.wl;
    const float* BT = (const float*)(C.ws + WS_BIAST);
    const u32x2 qw = *(const u32x2*)(z + (size_t)srow * NZ + ZQ + h * 64 + 4 * i);
    const float q0 = lo16(qw.x), q1 = hi16(qw.x), q2 = lo16(qw.y), q3 = hi16(qw.y);
    const float* ck = P.in[2] + ((size_t)(l * SB + b) * WB) * 512 + h * 64 + 4 * i;
    const float* cv = P.in[3] + ((size_t)(l * SB + b) * WB) * 512 + h * 64 + 4 * i;
    for (int n0 = 0; n0 < 388; n0 += 4) { const int n = n0 + g; float s = 0.f;
        if (n < 387) { const int br = n / 129, j = n - br * 129, dil = br == 0 ? 1 : (br == 1 ? 4 : 16), idx = WB + t - dil * j;
            f32x4 k;
            if (idx >= WB) { const u32x2 w = *(const u32x2*)(z + (size_t)(MP + b * 4 + idx - WB) * NZ + ZK + h * 64 + 4 * i); k = (f32x4){lo16(w.x), hi16(w.x), lo16(w.y), hi16(w.y)}; }
            else k = *(const f32x4*)(ck + (size_t)idx * 512);
            s = q0 * k.x + q1 * k.y + q2 * k.z + q3 * k.w; }
        s += __shfl_xor(s, 1); s += __shfl_xor(s, 2); s += __shfl_xor(s, 4); s += __shfl_xor(s, 8);
        if (n < 387 && i == 0) { const int br = n / 129, j = n - br * 129; sc[n] = s * 0.125f + BT[(br * 8 + h) * 132 + j]; } }
    float mx = -1e30f;
    for (int n = lane; n < 387; n += 64) mx = fmaxf(mx, sc[n]);
    mx = wave_max(mx);
    float ls = 0.f;
    for (int n = lane; n < 387; n += 64) { const float p = fexp(sc[n] - mx); sc[n] = p; ls += p; }
    ls = wave_sum(ls);
    f32x4 acc = (f32x4){0.f, 0.f, 0.f, 0.f};
    for (int n0 = 0; n0 < 388; n0 += 4) { const int n = n0 + g;
        if (n < 387) { const int br = n / 129, j = n - br * 129, dil = br == 0 ? 1 : (br == 1 ? 4 : 16), idx = WB + t - dil * j; const float p = sc[n];
            f32x4 v;
            if (idx >= WB) { const u32x2 w = *(const u32x2*)(z + (size_t)(MP + b * 4 + idx - WB) * NZ + ZV + h * 64 + 4 * i); v = (f32x4){lo16(w.x), hi16(w.x), lo16(w.y), hi16(w.y)}; }
            else v = *(const f32x4*)(cv + (size_t)idx * 512);
            acc += v * p; } }
#pragma unroll
    for (int c = 0; c < 4; ++c) { acc[c] += __shfl_xor(acc[c], 16); acc[c] += __shfl_xor(acc[c], 32); }
    if (g == 0) { const float inv = 1.0f / ls; u32x2 w; w.x = pk2(acc.x * inv, acc.y * inv); w.y = pk2(acc.z * inv, acc.w * inv);
        *(u32x2*)((bf16*)(C.ws + WS_MIX) + (size_t)srow * D + h * 64 + 4 * i) = w; }
}

DI float scan_add(float x, int lane) {
#pragma unroll
    for (int o = 1; o < 64; o <<= 1) { const float v = __shfl_up(x, o); if (lane >= o) x += v; }
    return x; }
DI float scan_max(float x, int lane) {
#pragma unroll
    for (int o = 1; o < 64; o <<= 1) { const float v = __shfl_up(x, o); if (lane >= o) x = fmaxf(x, v); }
    return x; }

DI void conv8(const bf16* zcol, int ts, const float* w, float scale, float (&y)[8]) {
#pragma unroll
    for (int e = 0; e < 8; ++e) y[e] = 0.f;
#pragma unroll
    for (int j = 0; j < 4; ++j) { const int tj = ts - 3 + j;
        if (tj >= 0) { const bf16x8 x = ldg8(zcol + (ptrdiff_t)(j - 3) * NZ); const f32x4 w0 = *(const f32x4*)(w + j * 512), w1 = *(const f32x4*)(w + j * 512 + 4);
            const u32x4 xw = __builtin_bit_cast(u32x4, x);
            y[0] += w0.x * lo16(xw.x); y[1] += w0.y * hi16(xw.x); y[2] += w0.z * lo16(xw.y); y[3] += w0.w * hi16(xw.y);
            y[4] += w1.x * lo16(xw.z); y[5] += w1.y * hi16(xw.z); y[6] += w1.z * lo16(xw.w); y[7] += w1.w * hi16(xw.w); } }
#pragma unroll
    for (int e = 0; e < 8; ++e) y[e] = silu(y[e]) * scale;
}

DI void mlstm_m1_item(const Ctx& C, int l, int it) {
    const Params& P = *C.P; const int lane = C.lane, hh = lane >> 5;
    const int bh = it >> 6, c = it & 63, b = bh >> 2, h = bh & 3, row0 = b * SEQ + c * 64;
    const bf16* z = (const bf16*)(C.ws + WS_Z);
    const float* gate = (const float*)(C.ws + WS_GATE);
    LAS unsigned char* kt_ = C.wl; LAS unsigned char* vt_ = C.wl + 32 * VSTR; LAS float* dpr = (LAS float*)(C.wl + 64 * VSTR);
    const float ig = gate[(size_t)(row0 + lane) * 8 + h] + P.in[12][l * 8 + h];
    const float lf = logsig(gate[(size_t)(row0 + lane) * 8 + 4 + h] + P.in[12][l * 8 + 4 + h]);
    const float bc = scan_add(lf, lane), bL = __shfl(bc, 63), uu = ig - bc, umax = wave_max(uu);
    dpr[lane] = fexp(uu - umax);
    ((float*)(C.ws + WS_MLB))[bh * SEQ + c * 64 + lane] = bc; ((float*)(C.ws + WS_MLU))[bh * SEQ + c * 64 + lane] = uu;
    if (lane == 0) { ((float*)(C.ws + WS_MLA))[bh * 64 + c] = bL + umax; ((float*)(C.ws + WS_MLBL))[bh * 64 + c] = bL; }
    const float* cw = P.in[13] + (size_t)l * 4 * 512;
    bf16* QC = (bf16*)(C.ws + WS_MLQC); bf16* KC = (bf16*)(C.ws + WS_MLKC);
#pragma unroll 2
    for (int i = 0; i < 8; ++i) { const int id = lane + 64 * i, rr = id >> 3, cgp = id & 7, ch = h * 64 + 8 * cgp, ts = c * 64 + rr; float y[8];
        conv8(z + (size_t)(row0 + rr) * NZ + ZMQ + ch, ts, cw + ch, 1.0f, y);
        u32x4 w; w.x = pk2(y[0], y[1]); w.y = pk2(y[2], y[3]); w.z = pk2(y[4], y[5]); w.w = pk2(y[6], y[7]);
        *(u32x4*)(QC + (size_t)(row0 + rr) * 256 + ch) = w; }
    f32x16 acc[2][2]; acc[0][0] = zero16(); acc[0][1] = zero16(); acc[1][0] = zero16(); acc[1][1] = zero16();
    float kn = 0.f;
    for (int hf = 0; hf < 2; ++hf) {
#pragma unroll 2
        for (int i = 0; i < 4; ++i) { const int id = lane + 64 * i, rr = id >> 3, cgp = id & 7, ch = h * 64 + 8 * cgp, rs = 32 * hf + rr, ts = c * 64 + rs; float y[8];
            conv8(z + (size_t)(row0 + rs) * NZ + ZMK + ch, ts, cw + 256 + ch, 0.125f, y);
            u32x4 w; w.x = pk2(y[0], y[1]); w.y = pk2(y[2], y[3]); w.z = pk2(y[4], y[5]); w.w = pk2(y[6], y[7]);
            *(u32x4*)(KC + (size_t)(row0 + rs) * 256 + ch) = w;
            *(LAS u32x4*)(kt_ + rr * VSTR + cgp * 16) = w;
            const float dp = dpr[rs];
            const u32x4 vw = __builtin_bit_cast(u32x4, ldg8(z + (size_t)(row0 + rs) * NZ + ZMV + ch));
            u32x4 vo; vo.x = pk2(lo16(vw.x) * dp, hi16(vw.x) * dp); vo.y = pk2(lo16(vw.y) * dp, hi16(vw.y) * dp); vo.z = pk2(lo16(vw.z) * dp, hi16(vw.z) * dp); vo.w = pk2(lo16(vw.w) * dp, hi16(vw.w) * dp);
            *(LAS u32x4*)(vt_ + rr * VSTR + cgp * 16) = vo; }
#pragma unroll
        for (int ks = 0; ks < 2; ++ks) { bf16x8 A[2], B[2];
#pragma unroll
            for (int x = 0; x < 2; ++x) { A[x] = tr_frag<false>(vt_, 16 * ks, 32 * x, lane); B[x] = tr_frag<false>(kt_, 16 * ks, 32 * x, lane); }
#pragma unroll
            for (int fb = 0; fb < 2; ++fb)
#pragma unroll
                for (int eb = 0; eb < 2; ++eb) acc[fb][eb] = MFMA32(A[fb], B[eb], acc[fb][eb]); }
        for (int s = 0; s < 32; ++s) kn += dpr[32 * hf + s] * bf2f(*(LAS const bf16*)(kt_ + s * VSTR + lane * 2));
    }
    float* KVT = (float*)(C.ws + WS_MLKVT) + (size_t)(bh * 64 + c) * 4096;
#pragma unroll
    for (int fb = 0; fb < 2; ++fb)
#pragma unroll
        for (int eb = 0; eb < 2; ++eb)
#pragma unroll
            for (int reg = 0; reg < 16; ++reg) KVT[(32 * fb + crow(reg, hh)) * 64 + 32 * eb + (lane & 31)] = acc[fb][eb][reg];
    ((float*)(C.ws + WS_MLKN))[(size_t)(bh * 64 + c) * 64 + lane] = kn;
}

DI void mlstm_m2_item(const Ctx& C, int l, int it) {
    const int lane = C.lane, bh = it >> 6, f = it & 63, b = bh >> 2, h = bh & 3;
    const float* __restrict__ MA = (const float*)(C.ws + WS_MLA) + bh * 64; const float* __restrict__ MBL = (const float*)(C.ws + WS_MLBL) + bh * 64;
    const float* __restrict__ KVT = (const float*)(C.ws + WS_MLKVT) + (size_t)bh * 64 * 4096 + f * 64 + lane;
    const float* __restrict__ KN = (const float*)(C.ws + WS_MLKN) + (size_t)bh * 64 * 64 + lane;
    bf16* __restrict__ CT = (bf16*)(C.ws + WS_MLCT) + (size_t)bh * 64 * 4096 + f * 64 + lane;
    float* __restrict__ NC = (float*)(C.ws + WS_MLNC) + (size_t)bh * 64 * 64 + lane;
    float* __restrict__ MC = (float*)(C.ws + WS_MLMC) + bh * 64;
    float m = 0.f, Cv = 0.f, nv = 0.f;
#pragma unroll 8
    for (int c = 0; c < 64; ++c) {
        const float a = MA[c], bL = MBL[c], mn = fmaxf(bL + m, a), gL = fexp(bL + m - mn), sc = fexp(a - mn);
        CT[(size_t)c * 4096] = f2bf(Cv);
        Cv = gL * Cv + sc * KVT[(size_t)c * 4096];
        if (f == 0) { NC[c * 64] = nv; nv = gL * nv + sc * KN[c * 64]; if (lane == 0) MC[c] = m; }
        m = mn;
    }
    C.out[O_PC + ((size_t)((l * NB + b) * 4 + h) * 64 + lane) * 64 + f] = Cv;
    if (f == 0) { C.out[O_PN + (size_t)((l * NB + b) * 4 + h) * 64 + lane] = nv; if (lane == 0) C.out[O_PM + (l * NB + b) * 4 + h] = m; }
}

DI void mlstm_m3_item(const Ctx& C, int l, int it) {
    const Params& P = *C.P; const int lane = C.lane, t = lane & 31, hh = lane >> 5;
    const int half = it & 1, c = (it >> 1) & 63, bh = it >> 7, b = bh >> 2, h = bh & 3, row0 = b * SEQ + c * 64, tok = 32 * half + t, row = row0 + tok;
    const bf16* z = (const bf16*)(C.ws + WS_Z);
    const bf16* QC = (const bf16*)(C.ws + WS_MLQC); const bf16* KC = (const bf16*)(C.ws + WS_MLKC);
    LAS float* us = (LAS float*)(C.wl + 64 * VSTR);
    bf16x8 qf[4];
#pragma unroll
    for (int s = 0; s < 4; ++s) qf[s] = ldg8(QC + (size_t)row * 256 + h * 64 + 16 * s + 8 * hh);
    const float u_l = ((const float*)(C.ws + WS_MLU))[bh * SEQ + c * 64 + lane], b_l = ((const float*)(C.ws + WS_MLB))[bh * SEQ + c * 64 + lane];
    const float m_c = ((const float*)(C.ws + WS_MLMC))[bh * 64 + c];
    const float cm = scan_max(u_l, lane), mt_l = b_l + fmaxf(m_c, cm);
    us[lane] = u_l;
    const float b_t = __shfl(b_l, tok), mt_t = __shfl(mt_l, tok), g_t = fexp(b_t + m_c - mt_t);
    f32x16 O[2]; O[0] = zero16(); O[1] = zero16();
    float den = 0.f;
    for (int kt = 0; kt <= half; ++kt) {
        const bf16* kp = KC + (size_t)(row0 + 32 * kt + t) * 256 + h * 64 + 8 * hh;
        f32x16 S = zero16();
#pragma unroll
        for (int s = 0; s < 4; ++s) S = MFMA32(ldg8(kp + 16 * s), qf[s], S);
#pragma unroll
        for (int reg = 0; reg < 16; ++reg) { const int sidx = 32 * kt + crow(reg, hh);
            const float w = (sidx <= tok) ? fexp(b_t + us[sidx] - mt_t) * S[reg] : 0.f; S[reg] = w; den += w; }
        LAS unsigned char* vt = C.wl + (kt & 1) * (32 * VSTR);
#pragma unroll
        for (int i = 0; i < 4; ++i) { const int id = lane + 64 * i, rr = id >> 3, cgp = id & 7;
            *(LAS bf16x8*)(vt + rr * VSTR + cgp * 16) = ldg8(z + (size_t)(row0 + 32 * kt + rr) * NZ + ZMV + h * 64 + 8 * cgp); }
#pragma unroll
        for (int ks = 0; ks < 2; ++ks) { const bf16x8 pf = pack8(S, ks);
#pragma unroll
            for (int fb = 0; fb < 2; ++fb) O[fb] = MFMA32(tr_frag<true>(vt, 16 * ks, 32 * fb, lane), pf, O[fb]); }
    }
    const bf16* CT = (const bf16*)(C.ws + WS_MLCT) + (size_t)(bh * 64 + c) * 4096;
    f32x16 X[2]; X[0] = zero16(); X[1] = zero16();
#pragma unroll
    for (int fb = 0; fb < 2; ++fb)
#pragma unroll
        for (int s = 0; s < 4; ++s) X[fb] = MFMA32(ldg8(CT + (32 * fb + t) * 64 + 16 * s + 8 * hh), qf[s], X[fb]);
    const float* NCp = (const float*)(C.ws + WS_MLNC) + (size_t)(bh * 64 + c) * 64;
    float qn = 0.f;
#pragma unroll
    for (int s = 0; s < 4; ++s) { const u32x4 qw = __builtin_bit_cast(u32x4, qf[s]); const f32x4 n0 = *(const f32x4*)(NCp + 16 * s + 8 * hh), n1 = *(const f32x4*)(NCp + 16 * s + 8 * hh + 4);
        qn += lo16(qw.x) * n0.x + hi16(qw.x) * n0.y + lo16(qw.y) * n0.z + hi16(qw.y) * n0.w + lo16(qw.z) * n1.x + hi16(qw.z) * n1.y + lo16(qw.w) * n1.z + hi16(qw.w) * n1.w; }
    qn += __shfl_xor(qn, 32); den += __shfl_xor(den, 32);
    den += g_t * qn;
    const float idn = 1.0f / fmaxf(fabsf(den), fexp(-mt_t));
    float ssq = 0.f;
#pragma unroll
    for (int fb = 0; fb < 2; ++fb)
#pragma unroll
        for (int reg = 0; reg < 16; ++reg) { const float hv = (O[fb][reg] + g_t * X[fb][reg]) * idn; O[fb][reg] = hv; ssq += hv * hv; }
    ssq += __shfl_xor(ssq, 32);
    const float rs = __builtin_amdgcn_rsqf(ssq * (1.0f / 64) + EPS);
    const float* gn = P.in[14] + l * 256 + h * 64;
    bf16* mxp = (bf16*)(C.ws + WS_MIX) + (size_t)row * D + 512 + h * 64;
    const bf16* og = z + (size_t)row * NZ + ZMO + h * 64;
#pragma unroll
    for (int fb = 0; fb < 2; ++fb)
#pragma unroll
        for (int g = 0; g < 4; ++g) { const int f0 = 32 * fb + 8 * g + 4 * hh; const u32x2 ow = *(const u32x2*)(og + f0); const f32x4 gv = *(const f32x4*)(gn + f0);
            u32x2 w; w.x = pk2(O[fb][4 * g] * rs * gv.x * sigm(lo16(ow.x)), O[fb][4 * g + 1] * rs * gv.y * sigm(hi16(ow.x)));
            w.y = pk2(O[fb][4 * g + 2] * rs * gv.z * sigm(lo16(ow.y)), O[fb][4 * g + 3] * rs * gv.w * sigm(hi16(ow.y)));
            *(u32x2*)(mxp + f0) = w; }
}

DI float rdlane(float x, int l) { return __builtin_bit_cast(float, __builtin_amdgcn_readlane(__builtin_bit_cast(int, x), l)); }
DI void mlstm_sample_item(const Ctx& C, int l, int it) {
    const Params& P = *C.P; const int lane = C.lane, b = it >> 2, h = it & 3;
    const bf16* z = (const bf16*)(C.ws + WS_Z); const float* gate = (const float*)(C.ws + WS_GATE);
    const size_t sb = (size_t)(l * SB + b) * 4 + h;
    const float* C0 = P.in[5] + sb * 4096;
    LAS float* Cs = (LAS float*)C.wl;
#pragma unroll 8
    for (int e = 0; e < 64; ++e) Cs[e * 64 + lane] = C0[e * 64 + lane];
    float nv = P.in[6][sb * 64 + lane], m = P.in[7][sb];
    const float* cw = P.in[13] + (size_t)l * 4 * 512; const float* cb = P.in[4] + (size_t)(l * SB + b) * 3 * 512;
    float xq[7], xk[7];
#pragma unroll
    for (int j = 0; j < 3; ++j) { xq[j] = cb[j * 512 + h * 64 + lane]; xk[j] = cb[j * 512 + 256 + h * 64 + lane]; }
#pragma unroll
    for (int j = 0; j < 4; ++j) { xq[3 + j] = bf2f(z[(size_t)(MP + b * 4 + j) * NZ + ZMQ + h * 64 + lane]); xk[3 + j] = bf2f(z[(size_t)(MP + b * 4 + j) * NZ + ZMK + h * 64 + lane]); }
    float wq[4], wk[4];
#pragma unroll
    for (int j = 0; j < 4; ++j) { wq[j] = cw[j * 512 + h * 64 + lane]; wk[j] = cw[j * 512 + 256 + h * 64 + lane]; }
    const float gnv = P.in[14][l * 256 + h * 64 + lane];
#pragma unroll
    for (int t = 0; t < 4; ++t) { const int row = MP + b * 4 + t;
        float qc = 0.f, kc = 0.f;
#pragma unroll
        for (int j = 0; j < 4; ++j) { qc += wq[j] * xq[t + j]; kc += wk[j] * xk[t + j]; }
        qc = silu(qc); kc = silu(kc) * 0.125f;
        const float ig = gate[(size_t)row * 8 + h] + P.in[12][l * 8 + h], lf = logsig(gate[(size_t)row * 8 + 4 + h] + P.in[12][l * 8 + 4 + h]);
        const float mn = fmaxf(lf + m, ig), fp = fexp(lf + m - mn), ip = fexp(ig - mn);
        const float vf = bf2f(z[(size_t)row * NZ + ZMV + h * 64 + lane]) * ip;
        float num = 0.f;
#pragma unroll 4
        for (int e = 0; e < 64; ++e) { const float ke = rdlane(kc, e), qe = rdlane(qc, e); const float cv = fp * Cs[e * 64 + lane] + ke * vf; Cs[e * 64 + lane] = cv; num += qe * cv; }
        nv = fp * nv + ip * kc;
        const float qn = wave_sum(qc * nv);
        const float hv = num / fmaxf(fabsf(qn), fexp(-mn));
        const float ssq = wave_sum(hv * hv), rs = __builtin_amdgcn_rsqf(ssq * (1.0f / 64) + EPS);
        const float og = bf2f(z[(size_t)row * NZ + ZMO + h * 64 + lane]);
        ((bf16*)(C.ws + WS_MIX))[(size_t)row * D + 512 + h * 64 + lane] = f2bf(hv * rs * gnv * sigm(og));
        m = mn; }
    float* oc = C.out + O_SC + sb * 4096;
#pragma unroll 8
    for (int e = 0; e < 64; ++e) oc[e * 64 + lane] = Cs[e * 64 + lane];
    C.out[O_SN + sb * 64 + lane] = nv; if (lane == 0) C.out[O_SM + sb] = m;
}

DI void hgrn_m1_item(const Ctx& C, int l, int it) {
    const int lane = C.lane, hh = lane >> 5;
    const int bh = it >> 6, c = it & 63, b = bh >> 2, h = bh & 3, row0 = b * SEQ + c * 64;
    const bf16* z = (const bf16*)(C.ws + WS_Z);
    LAS unsigned char* kt_ = C.wl; LAS unsigned char* vt_ = C.wl + 32 * VSTR;
    const float lb = ((const float*)(C.ws + WS_LBV))[l * 256 + h * 64 + lane];
    float ba = 0.f, r = 0.f;
#pragma unroll 4
    for (int t = 0; t < 64; ++t) { const float x = bf2f(z[(size_t)(row0 + t) * NZ + ZHF + h * 64 + lane]); const float fg = lb + (1.0f - lb) * sigm(x); ba += flog(fg); if (t == 31) r = ba; }
    const float bL = ba;
    bf16* QT = (bf16*)(C.ws + WS_HGQT); bf16* KT = (bf16*)(C.ws + WS_HGKT); bf16* QB = (bf16*)(C.ws + WS_HGQB);
    f32x16 acc[2][2]; acc[0][0] = zero16(); acc[0][1] = zero16(); acc[1][0] = zero16(); acc[1][1] = zero16();
    ba = 0.f;
    for (int hf = 0; hf < 2; ++hf) {
#pragma unroll 4
        for (int tt = 0; tt < 32; ++tt) { const int t = 32 * hf + tt; const size_t zr = (size_t)(row0 + t) * NZ;
            const float x = bf2f(z[zr + ZHF + h * 64 + lane]); const float fg = lb + (1.0f - lb) * sigm(x), kk = 1.0f - fg;
            ba += flog(fg);
            const float q = silu(bf2f(z[zr + ZHQ + h * 64 + lane]));
            const size_t o = (size_t)(row0 + t) * 256 + h * 64 + lane;
            QT[o] = f2bf(q * fexp(ba - r)); KT[o] = f2bf(kk * fexp(r - ba)); QB[o] = f2bf(q * fexp(ba));
            *(LAS bf16*)(kt_ + tt * VSTR + lane * 2) = f2bf(kk * fexp(bL - ba)); }
#pragma unroll
        for (int i = 0; i < 4; ++i) { const int id = lane + 64 * i, rr = id >> 3, cgp = id & 7;
            *(LAS bf16x8*)(vt_ + rr * VSTR + cgp * 16) = ldg8(z + (size_t)(row0 + 32 * hf + rr) * NZ + ZHI + h * 64 + 8 * cgp); }
#pragma unroll
        for (int ks = 0; ks < 2; ++ks) { bf16x8 A[2], B[2];
#pragma unroll
            for (int x = 0; x < 2; ++x) { A[x] = tr_frag<false>(vt_, 16 * ks, 32 * x, lane); B[x] = tr_frag<false>(kt_, 16 * ks, 32 * x, lane); }
#pragma unroll
            for (int vb = 0; vb < 2; ++vb)
#pragma unroll
                for (int kb = 0; kb < 2; ++kb) acc[vb][kb] = MFMA32(A[vb], B[kb], acc[vb][kb]); }
    }
    float* GT = (float*)(C.ws + WS_HGGT) + (size_t)(bh * 64 + c) * 4096;
#pragma unroll
    for (int vb = 0; vb < 2; ++vb)
#pragma unroll
        for (int kb = 0; kb < 2; ++kb)
#pragma unroll
            for (int reg = 0; reg < 16; ++reg) GT[(32 * vb + crow(reg, hh)) * 64 + 32 * kb + (lane & 31)] = acc[vb][kb][reg];
    ((float*)(C.ws + WS_HGDL))[(size_t)(bh * 64 + c) * 64 + lane] = fexp(bL);
}
DI void hgrn_m2_item(const Ctx& C, int l, int it) {
    const int lane = C.lane, bh = it >> 6, v = it & 63, b = bh >> 2, h = bh & 3;
    const float* __restrict__ GT = (const float*)(C.ws + WS_HGGT) + (size_t)bh * 64 * 4096 + v * 64 + lane;
    const float* __restrict__ DL = (const float*)(C.ws + WS_HGDL) + (size_t)bh * 64 * 64 + lane;
    bf16* __restrict__ ST = (bf16*)(C.ws + WS_HGST) + (size_t)bh * 64 * 4096 + v * 64 + lane;
    float S = 0.f;
#pragma unroll 8
    for (int c = 0; c < 64; ++c) { ST[(size_t)c * 4096] = f2bf(S); S = DL[c * 64] * S + GT[(size_t)c * 4096]; }
    C.out[O_PS + ((size_t)((l * NB + b) * 4 + h) * 64 + lane) * 64 + v] = S;
}
DI void hgrn_m3_item(const Ctx& C, int l, int it) {
    const Params& P = *C.P; const int lane = C.lane, t = lane & 31, hh = lane >> 5;
    const int half = it & 1, c = (it >> 1) & 63, bh = it >> 7, b = bh >> 2, h = bh & 3, row0 = b * SEQ + c * 64, tok = 32 * half + t, row = row0 + tok;
    const bf16* z = (const bf16*)(C.ws + WS_Z);
    const bf16* QT = (const bf16*)(C.ws + WS_HGQT); const bf16* KT = (const bf16*)(C.ws + WS_HGKT); const bf16* QB = (const bf16*)(C.ws + WS_HGQB);
    bf16x8 qf[4];
#pragma unroll
    for (int s = 0; s < 4; ++s) qf[s] = ldg8(QT + (size_t)row * 256 + h * 64 + 16 * s + 8 * hh);
    f32x16 O[2]; O[0] = zero16(); O[1] = zero16();
    for (int kt = 0; kt <= half; ++kt) {
        const bf16* kp = KT + (size_t)(row0 + 32 * kt + t) * 256 + h * 64 + 8 * hh;
        f32x16 S = zero16();
#pragma unroll
        for (int s = 0; s < 4; ++s) S = MFMA32(ldg8(kp + 16 * s), qf[s], S);
#pragma unroll
        for (int reg = 0; reg < 16; ++reg) { const int sidx = 32 * kt + crow(reg, hh); S[reg] = (sidx <= tok) ? S[reg] : 0.f; }
        LAS unsigned char* vt = C.wl + (kt & 1) * (32 * VSTR);
#pragma unroll
        for (int i = 0; i < 4; ++i) { const int id = lane + 64 * i, rr = id >> 3, cgp = id & 7;
            *(LAS bf16x8*)(vt + rr * VSTR + cgp * 16) = ldg8(z + (size_t)(row0 + 32 * kt + rr) * NZ + ZHI + h * 64 + 8 * cgp); }
#pragma unroll
        for (int ks = 0; ks < 2; ++ks) { const bf16x8 pf = pack8(S, ks);
#pragma unroll
            for (int vb = 0; vb < 2; ++vb) O[vb] = MFMA32(tr_frag<true>(vt, 16 * ks, 32 * vb, lane), pf, O[vb]); }
    }
    const bf16* ST = (const bf16*)(C.ws + WS_HGST) + (size_t)(bh * 64 + c) * 4096;
#pragma unroll
    for (int s = 0; s < 4; ++s) { const bf16x8 qb = ldg8(QB + (size_t)row * 256 + h * 64 + 16 * s + 8 * hh);
#pragma unroll
        for (int vb = 0; vb < 2; ++vb) O[vb] = MFMA32(ldg8(ST + (32 * vb + t) * 64 + 16 * s + 8 * hh), qb, O[vb]); }
    float ssq = 0.f;
#pragma unroll
    for (int vb = 0; vb < 2; ++vb)
#pragma unroll
        for (int reg = 0; reg < 16; ++reg) ssq += O[vb][reg] * O[vb][reg];
    ssq += __shfl_xor(ssq, 32);
    const float rs = __builtin_amdgcn_rsqf(ssq * (1.0f / 64) + EPS);
    const float* gn = P.in[16] + l * 256 + h * 64;
    bf16* mxp = (bf16*)(C.ws + WS_MIX) + (size_t)row * D + 768 + h * 64;
    const bf16* og = z + (size_t)row * NZ + ZHG + h * 64;
#pragma unroll
    for (int vb = 0; vb < 2; ++vb)
#pragma unroll
        for (int g = 0; g < 4; ++g) { const int f0 = 32 * vb + 8 * g + 4 * hh; const u32x2 ow = *(const u32x2*)(og + f0); const f32x4 gv = *(const f32x4*)(gn + f0);
            u32x2 w; w.x = pk2(O[vb][4 * g] * rs * gv.x * sigm(lo16(ow.x)), O[vb][4 * g + 1] * rs * gv.y * sigm(hi16(ow.x)));
            w.y = pk2(O[vb][4 * g + 2] * rs * gv.z * sigm(lo16(ow.y)), O[vb][4 * g + 3] * rs * gv.w * sigm(hi16(ow.y)));
            *(u32x2*)(mxp + f0) = w; }
}
DI void hgrn_sample_item(const Ctx& C, int l, int it) {
    const Params& P = *C.P; const int lane = C.lane, b = it >> 2, h = it & 3;
    const bf16* z = (const bf16*)(C.ws + WS_Z);
    const size_t sb = (size_t)(l * SB + b) * 4 + h;
    const float* S0 = P.in[8] + sb * 4096;
    LAS float* Ss = (LAS float*)C.wl;
#pragma unroll 8
    for (int k = 0; k < 64; ++k) Ss[k * 64 + lane] = S0[k * 64 + lane];
    const float lb = ((const float*)(C.ws + WS_LBV))[l * 256 + h * 64 + lane], gnv = P.in[16][l * 256 + h * 64 + lane];
#pragma unroll
    for (int t = 0; t < 4; ++t) { const size_t zr = (size_t)(MP + b * 4 + t) * NZ;
        const float fg = lb + (1.0f - lb) * sigm(bf2f(z[zr + ZHF + h * 64 + lane])), kk = 1.0f - fg, q = silu(bf2f(z[zr + ZHQ + h * 64 + lane]));
        const float iv = bf2f(z[zr + ZHI + h * 64 + lane]);
        float o = 0.f;
#pragma unroll 4
        for (int k = 0; k < 64; ++k) { const float sv = rdlane(fg, k) * Ss[k * 64 + lane] + rdlane(kk, k) * iv; Ss[k * 64 + lane] = sv; o += rdlane(q, k) * sv; }
        const float ssq = wave_sum(o * o), rs = __builtin_amdgcn_rsqf(ssq * (1.0f / 64) + EPS);
        const float og = bf2f(z[zr + ZHG + h * 64 + lane]);
        ((bf16*)(C.ws + WS_MIX))[(size_t)(MP + b * 4 + t) * D + 768 + h * 64 + lane] = f2bf(o * rs * gnv * sigm(og)); }
    float* os = C.out + O_SS + sb * 4096;
#pragma unroll 8
    for (int k = 0; k < 64; ++k) os[k * 64 + lane] = Ss[k * 64 + lane];
}

DI void copy_row(const bf16* src, float* dst, int lane) {
    const u32x4 w = __builtin_bit_cast(u32x4, ldg8(src + 8 * lane));
    *(f32x4*)(dst + 8 * lane) = (f32x4){lo16(w.x), hi16(w.x), lo16(w.y), hi16(w.y)};
    *(f32x4*)(dst + 8 * lane + 4) = (f32x4){lo16(w.z), hi16(w.z), lo16(w.w), hi16(w.w)}; }
constexpr int CO_PKV = 2 * NB * WB, CO_SKV = 2 * MS, CO_PCV = NB * 3, CO_SCV = SB * 3, CO_ALL = CO_PKV + CO_SKV + CO_PCV + CO_SCV;
DI void copyout_item(const Ctx& C, int l, int it) {
    const bf16* z = (const bf16*)(C.ws + WS_Z); const int lane = C.lane;
    if (it < CO_PKV) { const int which = it / (NB * WB), r = it % (NB * WB), b = r / WB, j = r % WB;
        copy_row(z + (size_t)(b * SEQ + (SEQ - WB) + j) * NZ + (which ? ZV : ZK), C.out + (which ? O_PV : O_PK) + ((size_t)(l * NB + b) * WB + j) * 512, lane); return; }
    it -= CO_PKV;
    if (it < CO_SKV) { const int which = it / MS, r = it % MS;
        copy_row(z + (size_t)(MP + r) * NZ + (which ? ZV : ZK), C.out + (which ? O_SV : O_SK) + ((size_t)l * MS + r) * 512, lane); return; }
    it -= CO_SKV;
    if (it < CO_PCV) { const int b = it / 3, j = it % 3;
        copy_row(z + (size_t)(b * SEQ + SEQ - 3 + j) * NZ + ZMQ, C.out + O_PCONV + ((size_t)(l * NB + b) * 3 + j) * 512, lane); return; }
    it -= CO_PCV;
    { const int b = it / 3, j = it % 3;
        copy_row(z + (size_t)(MP + b * 4 + 1 + j) * NZ + ZMQ, C.out + O_SCONV + ((size_t)(l * SB + b) * 3 + j) * 512, lane); }
}

#define ITEM_LOOP(N, rot, call) do { for (int it = (C.gw + C.NGW - ((rot) % C.NGW)) % C.NGW; it < (N); it += C.NGW) { call; } } while (0)
template <int l> DI void ph_m1(const Ctx& C) {
    ITEM_LOOP(4096, 0, attn_unit<1>(C, l, it));
    ITEM_LOOP(4096, 0, attn_unit<2>(C, l, it));
    ITEM_LOOP(1024, 0, mlstm_m1_item(C, l, it));
    ITEM_LOOP(1024, 1024, hgrn_m1_item(C, l, it));
    ITEM_LOOP(1024, 0, attn_sample_item(C, l, it));
    ITEM_LOOP(128, 1024, mlstm_sample_item(C, l, it));
    ITEM_LOOP(128, 1152, hgrn_sample_item(C, l, it));
}
template <int l> DI void ph_m2(const Ctx& C) {
    ITEM_LOOP(1024, 0, mlstm_m2_item(C, l, it));
    ITEM_LOOP(1024, 1024, hgrn_m2_item(C, l, it));
    ITEM_LOOP(CO_ALL, 0, copyout_item(C, l, it));
}
template <int l> DI void ph_m3(const Ctx& C) {
    ITEM_LOOP(4096, 0, attn_unit<0>(C, l, it));
    ITEM_LOOP(2048, 0, mlstm_m3_item(C, l, it));
    ITEM_LOOP(2048, 0, hgrn_m3_item(C, l, it));
}
DI void ph_final(const Ctx& C) {
    const Params& P = *C.P; const int lane = C.lane;
    const float* H = (const float*)(C.ws + WS_H); const float* SSQ = (const float*)(C.ws + WS_SSQ) + 4 * MPAD;
    for (int m = C.gw; m < MT; m += C.NGW) {
        const float rs = __builtin_amdgcn_rsqf(SSQ[m] * (1.0f / D) + EPS);
        float* o = (m < MP) ? C.out + O_YP + (size_t)m * D : C.out + O_YS + (size_t)(m - MP) * D;
#pragma unroll
        for (int j = 0; j < 4; ++j) { const f32x4 v = *(const f32x4*)(H + (size_t)m * D + 4 * lane + 256 * j), g = *(const f32x4*)(P.in[21] + 4 * lane + 256 * j);
            *(f32x4*)(o + 4 * lane + 256 * j) = v * rs * g; }
    }
}

#define XB_TMO      128
#define XB_XCNT(j)  (256  + 64 * (j))
#define XB_XSUB(j)  (1280 + 64 * (j))
#define XB_XGEN(j)  (2304 + 64 * (j))
#define XB_TOP      3328
#define XB_TOPGEN   3392
#define XCD_BAR_WORDS 3456
#define XB_SPIN_CAP (1u << 18)

__device__ __forceinline__ unsigned xb_ld(unsigned* p)              { return __hip_atomic_load(p, __ATOMIC_RELAXED, __HIP_MEMORY_SCOPE_AGENT); }
__device__ __forceinline__ unsigned xb_add(unsigned* p, unsigned v) { return __hip_atomic_fetch_add(p, v, __ATOMIC_RELAXED, __HIP_MEMORY_SCOPE_AGENT); }
__device__ __forceinline__ unsigned xb_xcc_id() { return (unsigned)__builtin_amdgcn_s_getreg((3 << 11) | 20) & 0xFu; }
#define XB_SPIN(cond, bar) do { unsigned _sp = 0; while (cond) { __builtin_amdgcn_s_sleep(1); \
    if ((++_sp & 255u) == 0u) { if (xb_ld(&(bar)[XB_TMO])) break; if (_sp > XB_SPIN_CAP) { atomicAdd(&(bar)[XB_TMO], 1u); break; } } } } while (0)


__device__ __forceinline__ XcdBarrier xcd_barrier_post(unsigned* bar, volatile LAS unsigned* st) {
    XcdBarrier b; b.bar = bar; b.x = xb_xcc_id(); b.st = st;
    if (threadIdx.x == 0) (void)xb_add(&bar[XB_XCNT(b.x)], 1u);
    return b;
}
__device__ __forceinline__ void xcd_barrier_complete(unsigned* bar, unsigned x, unsigned& nloc, unsigned& nx) {
    const unsigned G = gridDim.x * gridDim.y * gridDim.z;
    unsigned sum, cnt, mine, sp = 0u;
    for (;;) {
        sum = 0u; cnt = 0u; mine = 0u;
#pragma unroll
        for (unsigned j = 0; j < 16; ++j) { const unsigned c = xb_ld(&bar[XB_XCNT(j)]); sum += c; cnt += (c > 0u) ? 1u : 0u; mine = (j == x) ? c : mine; }
        if (sum == G) break;
        __builtin_amdgcn_s_sleep(1);
        if ((++sp & 255u) == 0u) { if (xb_ld(&bar[XB_TMO])) break; if (sp > XB_SPIN_CAP) { atomicAdd(&bar[XB_TMO], 1u); break; } }
    }
    nloc = mine > 0u ? mine : 1u; nx = cnt > 0u ? cnt : 1u;
}

__device__ __forceinline__ void xcd_barrier(const XcdBarrier& b) {
    asm volatile("s_waitcnt vmcnt(0)" ::: "memory");
    __syncthreads();
    if (threadIdx.x == 0) {
        unsigned* bar = b.bar;
        __builtin_amdgcn_s_waitcnt(0);
        unsigned nloc = b.st[0], nx = b.st[1];
        if (nloc == 0u) { xcd_barrier_complete(bar, b.x, nloc, nx); b.st[0] = nloc; b.st[1] = nx; }
        const unsigned old = xb_add(&bar[XB_XSUB(b.x)], 1u);
        const unsigned gen = old / nloc;
        if (old + 1u == (gen + 1u) * nloc) {
            __builtin_amdgcn_fence(__ATOMIC_RELEASE, "agent");
            asm volatile("s_waitcnt vmcnt(0)" ::: "memory");
            const unsigned og = xb_add(&bar[XB_TOP], 1u);
            const unsigned tg = og / nx;
            if (og + 1u == (tg + 1u) * nx) xb_add(&bar[XB_TOPGEN], 1u);
            else XB_SPIN(xb_ld(&bar[XB_TOPGEN]) == tg, bar);
            __builtin_amdgcn_fence(__ATOMIC_ACQUIRE, "agent");
            xb_add(&bar[XB_XGEN(b.x)], 1u);
            asm volatile("s_waitcnt vmcnt(0)" ::: "memory");
        } else {
            XB_SPIN(xb_ld(&bar[XB_XGEN(b.x)]) == gen, bar);
            __builtin_amdgcn_fence(__ATOMIC_ACQUIRE, "agent");
            asm volatile("s_waitcnt vmcnt(0)" ::: "memory");
        }
    }
    __syncthreads();
}


constexpr int NPH = 16;
#if MK_CGSYNC
#define GRID_SYNC() cg::this_grid().sync()
#else
#define GRID_SYNC() xcd_barrier(C.xb)
#endif
template <int l> DI void layer_phases(const Ctx& C, const Params& P) {
    float* SSQ = (float*)(C.ws + WS_SSQ);
#define IN(k) (P.ph_lo <= (1 + 7 * l + (k)) && (1 + 7 * l + (k)) < P.ph_hi)
#define SEAM(k) do { if (IN(k) && (1 + 7 * l + (k)) + 1 < P.ph_hi) GRID_SYNC(); } while (0)
    if (IN(0)) { pg8::Gemm g{(const bf16*)(C.ws + WS_HB), (const bf16*)(C.ws + WS_WIN) + (size_t)l * NZ * D, MPAD, NZ, D}; pg8::StaticOrder S; S.init(MPAD, NZ, C.G, (int)blockIdx.x);
        EpiZ E{(bf16*)(C.ws + WS_Z), SSQ + (2 * l) * MPAD, (float*)(C.ws + WS_GATE)};
        pg8::gemm_phase<EpiZ, pg8::StaticOrder, true, true>(C.lds, g, S, E); }
    SEAM(0);
    if (IN(1)) ph_m1<l>(C);
    SEAM(1);
    if (IN(2)) ph_m2<l>(C);
    SEAM(2);
    if (IN(3)) ph_m3<l>(C);
    SEAM(3);
    if (IN(4)) { pg8::Gemm g{(const bf16*)(C.ws + WS_MIX), (const bf16*)(C.ws + WS_WOUT) + (size_t)l * D * D, MPAD, D, D}; pg8::StaticOrder S; S.init(MPAD, D, C.G, (int)blockIdx.x);
        EpiRes E{(float*)(C.ws + WS_H), (bf16*)(C.ws + WS_HB), SSQ + (2 * l + 1) * MPAD};
        pg8::gemm_phase<EpiRes, pg8::StaticOrder, true, true>(C.lds, g, S, E); }
    SEAM(4);
    if (IN(5)) { pg8::Gemm g{(const bf16*)(C.ws + WS_HB), (const bf16*)(C.ws + WS_WUP) + (size_t)l * FF * D, MPAD, FF, D}; pg8::StaticOrder S; S.init(MPAD, FF, C.G, (int)blockIdx.x);
        EpiAct E{(bf16*)(C.ws + WS_ACT), SSQ + (2 * l + 1) * MPAD};
        pg8::gemm_phase<EpiAct, pg8::StaticOrder, true, true>(C.lds, g, S, E); }
    SEAM(5);
    if (IN(6)) { pg8::Gemm g{(const bf16*)(C.ws + WS_ACT), (const bf16*)(C.ws + WS_WDN) + (size_t)l * D * FF, MPAD, D, FF}; pg8::StaticOrder S; S.init(MPAD, D, C.G, (int)blockIdx.x);
        EpiRes E{(float*)(C.ws + WS_H), (bf16*)(C.ws + WS_HB), SSQ + (2 * l + 2) * MPAD};
        pg8::gemm_phase<EpiRes, pg8::StaticOrder, true, true>(C.lds, g, S, E); }
    SEAM(6);
#undef IN
#undef SEAM
}
__global__ void __launch_bounds__(NWAVES * 64, 2) mk_fwd(Params P) {
    extern __shared__ __attribute__((aligned(16))) unsigned char smem[];
    Ctx C; C.P = &P; C.lds = (LAS unsigned char*)smem; C.tid = threadIdx.x; C.lane = C.tid & 63; C.wave = __builtin_amdgcn_readfirstlane(C.tid >> 6);
    C.wl = C.lds + C.wave * WLDS;
    C.G = gridDim.x; { const int bx = blockIdx.x; C.vcu = (C.G % 8 == 0) ? (bx % 8) * (C.G / 8) + bx / 8 : bx; }
    C.gw = C.vcu * NWAVES + C.wave; C.NGW = C.G * NWAVES; C.ws = P.ws; C.out = P.out;
    { volatile LAS unsigned* st = (volatile LAS unsigned*)(C.lds + LDS_CTL); if (C.tid < 2) st[C.tid] = 0u; __syncthreads();
      C.xb.bar = (unsigned*)(C.ws + WS_BAR); C.xb.x = 0; C.xb.st = st;
      if (!MK_CGSYNC && P.ph_hi - P.ph_lo > 1) C.xb = xcd_barrier_post((unsigned*)(C.ws + WS_BAR), st); }
    if (P.ph_lo <= 0 && 0 < P.ph_hi) { ph_prologue(C); if (1 < P.ph_hi) GRID_SYNC(); }
    layer_phases<0>(C, P);
    layer_phases<1>(C, P);
    if (P.ph_lo <= NPH - 1 && NPH - 1 < P.ph_hi) ph_final(C);
}

static int t5_bucket(int n) {
    const int max_exact = 16;
    if (n < max_exact) return n;
    const double scaled = std::log((double)(n < 1 ? 1 : n) / max_exact) / std::log(2048.0 / max_exact);
    int v = max_exact + (int)(scaled * (32 - max_exact));
    return v < 31 ? v : 31;
}

extern "C" void kernel_launch(void* const* d_in, const int* in_sizes, int n_in, void* d_out, int out_size, void* d_ws, size_t ws_size, hipStream_t stream) {
    static int grid = 0;
    if (grid == 0) {
        if (n_in != 22 || (size_t)out_size != O_END || ws_size < WS_END) { fprintf(stderr, "kernel_launch: unexpected shapes n_in %d out %d ws %zu (need %zu)\n", n_in, out_size, ws_size, (size_t)WS_END); grid = -1; return; }
        int dev = 0, cus = 0, per_cu = 0;
        hipGetDevice(&dev); hipDeviceGetAttribute(&cus, hipDeviceAttributeMultiprocessorCount, dev);
        hipFuncSetAttribute((const void*)mk_fwd, hipFuncAttributeMaxDynamicSharedMemorySize, LDS_BYTES);
        hipOccupancyMaxActiveBlocksPerMultiprocessor(&per_cu, (const void*)mk_fwd, NWAVES * 64, LDS_BYTES);
        if (per_cu < 1) { fprintf(stderr, "kernel_launch: occupancy query says %d blocks per CU\n", per_cu); per_cu = 1; }
        (void)hipGetLastError();
        grid = cus;
    }
    if (grid < 0) return;
    Params p{};
    for (int i = 0; i < 22; ++i) p.in[i] = (const float*)d_in[i];
    p.out = (float*)d_out; p.ws = (unsigned char*)d_ws;
    const int dils[3] = {1, 4, 16};
    for (int br = 0; br < 3; ++br) for (int j = 0; j <= 128; ++j) p.bucket[br][j] = (unsigned char)t5_bucket(dils[br] * j);
#if MK_MULTI
    for (int ph = 0; ph < NPH; ++ph) { p.ph_lo = ph; p.ph_hi = ph + 1; hipLaunchKernelGGL(mk_fwd, dim3(grid), dim3(NWAVES * 64), LDS_BYTES, stream, p); }
#else
    p.ph_lo = 0; p.ph_hi = NPH;
    if (hipMemsetAsync((char*)d_ws + WS_BAR, 0, 16384, stream) != hipSuccess) { fprintf(stderr, "kernel_launch: memset of the barrier words failed\n"); return; }
    void* args[] = {&p};
    hipError_t e = hipLaunchCooperativeKernel((const void*)mk_fwd, dim3(grid), dim3(NWAVES * 64), args, LDS_BYTES, stream);
    if (e != hipSuccess) fprintf(stderr, "cooperative launch failed: %s (grid %d)\n", hipGetErrorString(e), grid);
#endif
}
```

```cpp
#include <hip/hip_runtime.h>
#include <hip/hip_cooperative_groups.h>
#include <cstdio>
#include <cstdint>
#include <cmath>
namespace cg = cooperative_groups;

#ifndef MK_CGSYNC
#define MK_CGSYNC 0
#endif
#ifndef PROBE_DUP
#define PROBE_DUP 0
#endif
#ifndef MK_MULTI
#define MK_MULTI 0
#endif

namespace pg8 {
#define PG8_LAS __attribute__((address_space(3)))
typedef unsigned short bf16_t;
typedef short bf16x8 __attribute__((ext_vector_type(8)));
typedef float f32x4 __attribute__((ext_vector_type(4)));
typedef unsigned u32x4 __attribute__((ext_vector_type(4)));
constexpr int BM = 256, BK = 64, HALF = 128, HTB = HALF * BK * 2, STAGE_BYTES = 8 * HTB, NXCD = 8, WGM = 8;

__host__ __device__ __forceinline__ int lds_byte(int r, int c) { const int st = (r >> 4) * 2 + (c >> 5), rr = r & 15, cc = c & 31, ob = rr * 64 + cc * 2; return st * 1024 + (ob ^ (((ob >> 9) & 1) << 5)); }
__host__ __device__ __forceinline__ void stage_rc(int b, int& R, int& C) { const int st = b / 1024, sb = b % 1024, swz = sb ^ (((sb >> 9) & 1) << 5); R = (st >> 1) * 16 + swz / 64; C = (st & 1) * 32 + (swz % 64) / 2; }
__host__ __device__ __forceinline__ int perm32(int rho) { const int n = rho >> 4, i = rho & 15; return 8 * (i >> 2) + 4 * n + (i & 3); }

struct Unit { int pm, pn; };
struct Gemm { const bf16_t* A; const bf16_t* Bt; int M, N, K; };

struct StaticOrder {
    int nM, nN, nwg, G, c;
    __host__ __device__ void init(int M, int N, int G_, int c_) { nM = M / BM; nN = N / BM; nwg = nM * nN; G = G_; c = c_; }
    __host__ __device__ bool next(int i, Unit& u) const {
        const long L = (long)i * G + c; if (L >= nwg) return false;
        int wgid = (int)L; { const int q = nwg / NXCD, r = nwg % NXCD, xcd = wgid % NXCD, off = wgid / NXCD; wgid = (xcd < r ? xcd * (q + 1) : r * (q + 1) + (xcd - r) * q) + off; }
        const int nig = WGM * nN, gid = wgid / nig, fm = gid * WGM, gsz = (nM - fm) < WGM ? (nM - fm) : WGM;
        u.pm = fm + ((wgid % nig) % gsz); u.pn = (wgid % nig) / gsz; return true;
    }
    __device__ __forceinline__ void a_ready(const Unit&) const {}
    __device__ __forceinline__ void done(const Unit&) const {}
};

__device__ __forceinline__ unsigned cvt_pk_bf16(float lo, float hi) { unsigned r; asm volatile("v_cvt_pk_bf16_f32 %0, %1, %2" : "=v"(r) : "v"(lo), "v"(hi)); return r; }

template <class Epi, class Sched, bool ALIGN_EPI = false, bool SP2 = false>
__device__ __forceinline__ void gemm_phase(PG8_LAS unsigned char* lds, const Gemm g, const Sched& S, const Epi& E) {
    const int tid = threadIdx.x, wid = __builtin_amdgcn_readfirstlane(tid >> 6), lane = tid & 63, wr = wid >> 2, wc = wid & 3, fr = lane & 15, fq = lane >> 4;
    const int K = g.K, nt = K / BK;
    unsigned voffA[2], voffB[2];
#pragma unroll
    for (int i = 0; i < 2; ++i) { int R, C; stage_rc(tid * 16 + i * 8192, R, C); const int Rb = Epi::PERM ? ((R & ~31) + perm32(R & 31)) : R;
        voffA[i] = (unsigned)(R * K + C) * 2u; voffB[i] = (unsigned)(Rb * K + C) * 2u; }
    const size_t kstep = (size_t)(BK * 2);
    const size_t hstep = (size_t)HALF * K * 2;
    const size_t tstep = 2 * hstep;
    const unsigned ldsw = (unsigned)wid * 1024u;
    const int aoff = lds_byte(wr * 64 + fr, fq * 8), boff = lds_byte(wc * 32 + fr, fq * 8);
#define PG8_SA(b, h) (((b) * 2 + (h)) * HTB)
#define PG8_SB(b, h) ((4 + (b) * 2 + (h)) * HTB)
#define PG8_STAGE(bufoff, gbase, voff) do { _Pragma("unroll") for (int _i = 0; _i < 2; ++_i) \
        __builtin_amdgcn_global_load_lds((const unsigned*)((const char*)(gbase) + (voff)[_i]), (PG8_LAS unsigned*)(lds + (bufoff) + ldsw + _i * 8192), 16, 0, 0); } while (0)
#define PG8_LDA(dst, b, h) do { _Pragma("unroll") for (int m = 0; m < 4; ++m) _Pragma("unroll") for (int k = 0; k < 2; ++k) dst[m][k] = *(const PG8_LAS bf16x8*)(lds + PG8_SA(b, h) + aoff + m * 2048 + k * 1024); } while (0)
#define PG8_LDB(dst, b, h) do { _Pragma("unroll") for (int n = 0; n < 2; ++n) _Pragma("unroll") for (int k = 0; k < 2; ++k) dst[n][k] = *(const PG8_LAS bf16x8*)(lds + PG8_SB(b, h) + boff + n * 2048 + k * 1024); } while (0)
#define PG8_MMA(ai, bj, At, Bt) do { __builtin_amdgcn_s_setprio(1); _Pragma("unroll") for (int m = 0; m < 4; ++m) _Pragma("unroll") for (int n = 0; n < 2; ++n) _Pragma("unroll") for (int k = 0; k < 2; ++k) \
        acc[ai][bj][m][n] = __builtin_amdgcn_mfma_f32_16x16x32_bf16(Bt[n][k], At[m][k], acc[ai][bj][m][n], 0, 0, 0); __builtin_amdgcn_s_setprio(0); } while (0)
#define PG8_WAIT_V(n) asm volatile("s_waitcnt vmcnt(" #n ")" ::: "memory")
#define PG8_WAIT_L(n) asm volatile("s_waitcnt lgkmcnt(" #n ")" ::: "memory")
#define PG8_BAR __builtin_amdgcn_s_barrier()
#define PG8_SCHED __builtin_amdgcn_sched_barrier(0)
    Unit cur, nxt; int ui = 0;
    if (!S.next(0, cur)) return;
    f32x4 acc[2][2][4][2];
#pragma unroll
    for (int a = 0; a < 2; ++a)
#pragma unroll
        for (int b = 0; b < 2; ++b)
#pragma unroll
            for (int m = 0; m < 4; ++m)
#pragma unroll
                for (int n = 0; n < 2; ++n) acc[a][b][m][n] = (f32x4){0.f, 0.f, 0.f, 0.f};
    bf16x8 At[4][2], B0[2][2], B1[2][2];
    const char* cA = (const char*)g.A + (size_t)cur.pm * tstep; const char* cB = (const char*)g.Bt + (size_t)cur.pn * tstep;
    S.a_ready(cur);
    if constexpr (SP2) {
        PG8_STAGE(PG8_SB(0, 0), cB, voffB); PG8_STAGE(PG8_SB(0, 1), cB + hstep, voffB); PG8_STAGE(PG8_SA(0, 0), cA, voffA); PG8_STAGE(PG8_SA(0, 1), cA + hstep, voffA);
        if (wr == 1) PG8_BAR;
        PG8_WAIT_V(2); PG8_BAR;
        PG8_STAGE(PG8_SB(1, 0), cB + kstep, voffB); PG8_STAGE(PG8_SA(1, 0), cA + kstep, voffA); PG8_STAGE(PG8_SB(1, 1), cB + hstep + kstep, voffB);
        PG8_WAIT_V(6); PG8_BAR;
    } else {
        PG8_STAGE(PG8_SB(0, 0), cB, voffB); PG8_STAGE(PG8_SA(0, 0), cA, voffA); PG8_STAGE(PG8_SB(0, 1), cB + hstep, voffB); PG8_STAGE(PG8_SA(0, 1), cA + hstep, voffA);
        if (wr == 1) PG8_BAR;
        PG8_WAIT_V(4); PG8_BAR;
        PG8_STAGE(PG8_SB(1, 0), cB + kstep, voffB); PG8_STAGE(PG8_SA(1, 0), cA + kstep, voffA); PG8_STAGE(PG8_SB(1, 1), cB + hstep + kstep, voffB);
        PG8_WAIT_V(6); PG8_BAR;
    }
    for (;;) {
        const bool has_next = S.next(ui + 1, nxt);
        const char* nA = has_next ? (const char*)g.A + (size_t)nxt.pm * tstep : cA; const char* nB = has_next ? (const char*)g.Bt + (size_t)nxt.pn * tstep : cB;
        for (int t = 0; t < nt; t += 2) {
            const bool last = (t == nt - 2);
            const char* a1 = cA + (size_t)(t + 1) * kstep;
            const char* a2 = last ? nA : cA + (size_t)(t + 2) * kstep; const char* b2 = last ? nB : cB + (size_t)(t + 2) * kstep;
            const char* a3 = a2 + kstep; const char* b3 = b2 + kstep;
            if (last && has_next) S.a_ready(nxt);
            if constexpr (SP2) {
            PG8_LDB(B0, 0, 0); PG8_LDB(B1, 0, 1); PG8_SCHED; PG8_LDA(At, 0, 0); PG8_STAGE(PG8_SA(1, 1), a1 + hstep, voffA);
            PG8_WAIT_V(8); PG8_WAIT_L(0); PG8_BAR; PG8_MMA(0, 0, At, B0); PG8_MMA(0, 1, At, B1); PG8_BAR; PG8_SCHED;
            PG8_LDA(At, 0, 1); PG8_STAGE(PG8_SB(0, 0), b2, voffB); PG8_STAGE(PG8_SB(0, 1), b2 + hstep, voffB); PG8_STAGE(PG8_SA(0, 0), a2, voffA);
            PG8_WAIT_V(8); PG8_WAIT_L(0); PG8_BAR; PG8_MMA(1, 0, At, B0); PG8_MMA(1, 1, At, B1); PG8_BAR; PG8_SCHED;
            PG8_LDB(B0, 1, 0); PG8_LDB(B1, 1, 1); PG8_SCHED; PG8_LDA(At, 1, 0); PG8_STAGE(PG8_SA(0, 1), a2 + hstep, voffA);
            PG8_WAIT_V(8); PG8_WAIT_L(0); PG8_BAR; PG8_MMA(0, 0, At, B0); PG8_MMA(0, 1, At, B1); PG8_BAR; PG8_SCHED;
            PG8_LDA(At, 1, 1); PG8_STAGE(PG8_SB(1, 0), b3, voffB); PG8_STAGE(PG8_SB(1, 1), b3 + hstep, voffB); PG8_STAGE(PG8_SA(1, 0), a3, voffA);
            PG8_WAIT_V(8); PG8_WAIT_L(0); PG8_BAR; PG8_MMA(1, 0, At, B0); PG8_MMA(1, 1, At, B1); PG8_BAR; PG8_SCHED;
            } else {
            PG8_LDB(B0, 0, 0); PG8_SCHED; PG8_LDA(At, 0, 0); PG8_STAGE(PG8_SA(1, 1), a1 + hstep, voffA);
            PG8_WAIT_L(8); PG8_BAR; PG8_WAIT_L(0); PG8_MMA(0, 0, At, B0); PG8_BAR; PG8_SCHED;
            PG8_LDB(B1, 0, 1); PG8_STAGE(PG8_SB(0, 0), b2, voffB);
            PG8_BAR; PG8_WAIT_L(0); PG8_MMA(0, 1, At, B1); PG8_BAR;
            PG8_LDA(At, 0, 1); PG8_STAGE(PG8_SA(0, 0), a2, voffA);
            PG8_BAR; PG8_WAIT_L(0); PG8_MMA(1, 0, At, B0); PG8_BAR; PG8_SCHED;
            PG8_STAGE(PG8_SB(0, 1), b2 + hstep, voffB);
            PG8_WAIT_V(6); PG8_BAR; PG8_MMA(1, 1, At, B1); PG8_BAR;
            PG8_LDB(B0, 1, 0); PG8_SCHED; PG8_LDA(At, 1, 0); PG8_STAGE(PG8_SA(0, 1), a2 + hstep, voffA);
            PG8_WAIT_L(8); PG8_BAR; PG8_WAIT_L(0); PG8_MMA(0, 0, At, B0); PG8_BAR; PG8_SCHED;
            PG8_LDB(B1, 1, 1); PG8_STAGE(PG8_SB(1, 0), b3, voffB);
            PG8_BAR; PG8_WAIT_L(0); PG8_MMA(0, 1, At, B1); PG8_BAR;
            PG8_LDA(At, 1, 1); PG8_STAGE(PG8_SA(1, 0), a3, voffA);
            PG8_BAR; PG8_WAIT_L(0); PG8_MMA(1, 0, At, B0); PG8_BAR; PG8_SCHED;
            PG8_STAGE(PG8_SB(1, 1), b3 + hstep, voffB);
            PG8_WAIT_V(6); PG8_BAR; PG8_MMA(1, 1, At, B1); PG8_BAR;
            }
        }
        if constexpr (ALIGN_EPI) { if (wr == 0) PG8_BAR; }
        E(acc, cur, wr, wc, fr, fq);
        if (!has_next) break;
#pragma unroll
        for (int a = 0; a < 2; ++a)
#pragma unroll
            for (int b = 0; b < 2; ++b)
#pragma unroll
                for (int m = 0; m < 4; ++m)
#pragma unroll
                    for (int n = 0; n < 2; ++n) acc[a][b][m][n] = (f32x4){0.f, 0.f, 0.f, 0.f};
        cur = nxt; cA = nA; cB = nB; ++ui;
        if constexpr (ALIGN_EPI) { if (wr == 1) PG8_BAR; }
    }
    PG8_WAIT_V(0);
    if constexpr (!ALIGN_EPI) { if (wr == 0) PG8_BAR; }
    PG8_BAR;
#undef PG8_SA
#undef PG8_SB
#undef PG8_STAGE
#undef PG8_LDA
#undef PG8_LDB
#undef PG8_MMA
#undef PG8_WAIT_V
#undef PG8_WAIT_L
#undef PG8_BAR
#undef PG8_SCHED
}
}

#define LAS __attribute__((address_space(3)))
#define DI __device__ __forceinline__
typedef unsigned short bf16;
typedef short bf16x8 __attribute__((ext_vector_type(8)));
typedef short s16x4 __attribute__((ext_vector_type(4)));
typedef float f32x16 __attribute__((ext_vector_type(16)));
typedef float f32x4 __attribute__((ext_vector_type(4)));
typedef float f32x2 __attribute__((ext_vector_type(2)));
typedef unsigned u32x4 __attribute__((ext_vector_type(4)));
typedef unsigned u32x2 __attribute__((ext_vector_type(2)));
typedef __bf16 bf16x2_t __attribute__((ext_vector_type(2)));
typedef short v4i16_t __attribute__((ext_vector_type(4)));

constexpr int D = 1024, SEQ = 4096, NB = 4, MP = NB * SEQ, SB = 32, STK = 4, MS = SB * STK, MT = MP + MS, MPAD = 16640;
constexpr int NZ = 3840, FF = 4096, NWAVES = 8, NCHUNK = 64, WB = 2048;
constexpr int ZQ = 0, ZK = 512, ZV = 1024, ZMQ = 1536, ZMK = 1792, ZMV = 2048, ZMO = 2304, ZHQ = 2560, ZHF = 2816, ZHI = 3072, ZHG = 3328, ZG = 3584;
constexpr float EPS = 1e-6f;
constexpr float LOG2E = 1.4426950408889634f;

constexpr size_t O_YP = 0, O_YS = O_YP + (size_t)MP * D, O_PK = O_YS + (size_t)MS * D, O_PV = O_PK + (size_t)2 * NB * WB * 512, O_PCONV = O_PV + (size_t)2 * NB * WB * 512,
    O_PC = O_PCONV + 2 * NB * 3 * 512, O_PN = O_PC + 2 * NB * 4 * 4096, O_PM = O_PN + 2 * NB * 4 * 64, O_PS = O_PM + 2 * NB * 4, O_SK = O_PS + 2 * NB * 4 * 4096,
    O_SV = O_SK + (size_t)2 * SB * STK * 512, O_SCONV = O_SV + (size_t)2 * SB * STK * 512, O_SC = O_SCONV + 2 * SB * 3 * 512, O_SN = O_SC + (size_t)2 * SB * 4 * 4096,
    O_SM = O_SN + 2 * SB * 4 * 64, O_SS = O_SM + 2 * SB * 4, O_END = O_SS + (size_t)2 * SB * 4 * 4096;

constexpr size_t al256(size_t x) { return (x + 255) & ~(size_t)255; }
constexpr size_t WS_WIN = 0;
constexpr size_t WS_WOUT = WS_WIN + (size_t)2 * NZ * D * 2;
constexpr size_t WS_WUP = WS_WOUT + (size_t)2 * D * D * 2;
constexpr size_t WS_WDN = WS_WUP + (size_t)2 * FF * D * 2;
constexpr size_t WS_H = WS_WDN + (size_t)2 * D * FF * 2;
constexpr size_t WS_HB = WS_H + (size_t)MPAD * D * 4;
constexpr size_t WS_SSQ = WS_HB + (size_t)MPAD * D * 2;
constexpr size_t WS_Z = al256(WS_SSQ + (size_t)5 * MPAD * 4);
constexpr size_t WS_GATE = WS_Z + (size_t)MPAD * NZ * 2;
constexpr size_t WS_MIX = WS_GATE + (size_t)MPAD * 8 * 4;
constexpr size_t WS_ACT = WS_MIX + (size_t)MPAD * D * 2;
constexpr size_t WS_PO = WS_ACT + (size_t)MPAD * FF * 2;
constexpr size_t WS_PLSE = WS_PO + (size_t)2 * MP * 512 * 2;
constexpr size_t WS_BIAST = WS_PLSE + (size_t)2 * MP * 8 * 4;
constexpr size_t WS_LBV = al256(WS_BIAST + 3 * 8 * 132 * 4);
constexpr size_t WS_MLQC = WS_LBV + 2 * 256 * 4;
constexpr size_t WS_MLKC = WS_MLQC + (size_t)MP * 256 * 2;
constexpr size_t WS_MLB = WS_MLKC + (size_t)MP * 256 * 2;
constexpr size_t WS_MLU = WS_MLB + (size_t)16 * SEQ * 4;
constexpr size_t WS_MLA = WS_MLU + (size_t)16 * SEQ * 4;
constexpr size_t WS_MLBL = WS_MLA + 16 * 64 * 4;
constexpr size_t WS_MLMC = WS_MLBL + 16 * 64 * 4;
constexpr size_t WS_MLKVT = WS_MLMC + 16 * 64 * 4;
constexpr size_t WS_MLKN = WS_MLKVT + (size_t)16 * 64 * 4096 * 4;
constexpr size_t WS_MLCT = WS_MLKN + (size_t)16 * 64 * 64 * 4;
constexpr size_t WS_MLNC = WS_MLCT + (size_t)16 * 64 * 4096 * 2;
constexpr size_t WS_HGQT = WS_MLNC + (size_t)16 * 64 * 64 * 4;
constexpr size_t WS_HGKT = WS_HGQT + (size_t)MP * 256 * 2;
constexpr size_t WS_HGQB = WS_HGKT + (size_t)MP * 256 * 2;
constexpr size_t WS_HGGT = WS_HGQB + (size_t)MP * 256 * 2;
constexpr size_t WS_HGDL = WS_HGGT + (size_t)16 * 64 * 4096 * 4;
constexpr size_t WS_HGST = WS_HGDL + (size_t)16 * 64 * 64 * 4;
constexpr size_t WS_BAR = WS_HGST + (size_t)16 * 64 * 4096 * 2;
constexpr size_t WS_END = WS_BAR + 32768;

constexpr int LDS_BYTES = 147456 + 256;
constexpr int LDS_CTL = 147456;
constexpr int WLDS = 18432;
constexpr int VSTR = 144;

struct Params {
    const float* in[22];
    float* out;
    unsigned char* ws;
    int ph_lo, ph_hi;
    unsigned char bucket[3][136];
};

DI float bf2f(bf16 v) { return __builtin_bit_cast(float, (unsigned)v << 16); }
DI unsigned pk2(float lo, float hi) { f32x2 v = {lo, hi}; bf16x2_t b = __builtin_convertvector(v, bf16x2_t); return __builtin_bit_cast(unsigned, b); }
DI bf16 f2bf(float x) { return (bf16)(pk2(x, 0.f) & 0xffffu); }
DI float lo16(unsigned w) { return __builtin_bit_cast(float, w << 16); }
DI float hi16(unsigned w) { return __builtin_bit_cast(float, w & 0xffff0000u); }
DI int crow(int reg, int hh) { return (reg & 3) + 8 * (reg >> 2) + 4 * hh; }
DI bf16x8 ldg8(const bf16* p) { return *(const bf16x8*)p; }
DI float fexp(float x) { return __builtin_amdgcn_exp2f(x * LOG2E); }
DI float flog(float x) { return __builtin_amdgcn_logf(x) * 0.6931471805599453f; }
DI float sigm(float x) { return 1.0f / (1.0f + fexp(-x)); }
DI float silu(float x) { return x * sigm(x); }
DI float logsig(float x) { return fminf(x, 0.f) - flog(1.0f + fexp(-fabsf(x))); }
DI float wave_sum(float v) {
#pragma unroll
    for (int o = 1; o < 64; o <<= 1) v += __shfl_xor(v, o);
    return v; }
DI float wave_max(float v) {
#pragma unroll
    for (int o = 1; o < 64; o <<= 1) v = fmaxf(v, __shfl_xor(v, o));
    return v; }
#define MFMA32(a, b, c) __builtin_amdgcn_mfma_f32_32x32x16_bf16((a), (b), (c), 0, 0, 0)
DI bf16x8 pack8(const f32x16& x, int s) {
    u32x4 p; p.x = pk2(x[8 * s], x[8 * s + 1]); p.y = pk2(x[8 * s + 2], x[8 * s + 3]); p.z = pk2(x[8 * s + 4], x[8 * s + 5]); p.w = pk2(x[8 * s + 6], x[8 * s + 7]);
    return __builtin_bit_cast(bf16x8, p); }
DI s16x4 vtr(LAS const unsigned char* p) { return __builtin_bit_cast(s16x4, __builtin_amdgcn_ds_read_tr16_b64_v4i16((LAS v4i16_t*)p)); }
template <bool PERMK> DI bf16x8 tr_frag(LAS const unsigned char* tile, int k0, int n0, int lane) {
    const int hh = lane >> 5, q = (lane & 15) >> 2, col = n0 + 16 * ((lane >> 4) & 1) + 4 * (lane & 3);
    const int r1 = k0 + (PERMK ? 4 * hh : 8 * hh) + q, r2 = r1 + (PERMK ? 8 : 4);
    const s16x4 lo = vtr(tile + r1 * VSTR + col * 2), hi = vtr(tile + r2 * VSTR + col * 2);
    return __builtin_shufflevector(lo, hi, 0, 1, 2, 3, 4, 5, 6, 7); }
DI f32x16 zero16() { f32x16 z; for (int i = 0; i < 16; ++i) z[i] = 0.f; return z; }

struct XcdBarrier { unsigned* bar; unsigned x; volatile LAS unsigned* st; };
struct Ctx {
    const Params* P; LAS unsigned char* lds; LAS unsigned char* wl; int tid, lane, wave, vcu, G, gw, NGW;
    unsigned char* ws; float* out; XcdBarrier xb;
};

struct EpiZ {
    static constexpr bool PERM = true;
    bf16* Z; const float* ssq; float* gate;
    DI void operator()(const f32x4 (&acc)[2][2][4][2], const pg8::Unit& u, int wr, int wc, int fr, int fq) const {
        const int row0 = u.pm * 256 + wr * 64 + fr, col0 = u.pn * 256 + wc * 32 + 8 * fq;
#pragma unroll
        for (int ai = 0; ai < 2; ++ai)
#pragma unroll
            for (int m = 0; m < 4; ++m) { const int row = row0 + ai * 128 + m * 16; const float rs = __builtin_amdgcn_rsqf(ssq[row] * (1.0f / D) + EPS);
                bf16* rowp = Z + (size_t)row * NZ + col0;
#pragma unroll
                for (int bj = 0; bj < 2; ++bj) { const f32x4 v0 = acc[ai][bj][m][0] * rs, v1 = acc[ai][bj][m][1] * rs;
                    u32x4 w; w.x = pk2(v0[0], v0[1]); w.y = pk2(v0[2], v0[3]); w.z = pk2(v1[0], v1[1]); w.w = pk2(v1[2], v1[3]);
                    *(u32x4*)(rowp + bj * 128) = w;
                    if (u.pn == 14 && bj == 0 && col0 == ZG) { *(f32x4*)(gate + (size_t)row * 8) = v0; *(f32x4*)(gate + (size_t)row * 8 + 4) = v1; } } }
    }
};
struct EpiAct {
    static constexpr bool PERM = true;
    bf16* O; const float* ssq;
    DI void operator()(const f32x4 (&acc)[2][2][4][2], const pg8::Unit& u, int wr, int wc, int fr, int fq) const {
        const int row0 = u.pm * 256 + wr * 64 + fr, col0 = u.pn * 256 + wc * 32 + 8 * fq;
#pragma unroll
        for (int ai = 0; ai < 2; ++ai)
#pragma unroll
            for (int m = 0; m < 4; ++m) { const int row = row0 + ai * 128 + m * 16; const float rs = __builtin_amdgcn_rsqf(ssq[row] * (1.0f / D) + EPS);
                bf16* rowp = O + (size_t)row * FF + col0;
#pragma unroll
                for (int bj = 0; bj < 2; ++bj) { f32x4 v0 = acc[ai][bj][m][0] * rs, v1 = acc[ai][bj][m][1] * rs;
#pragma unroll
                    for (int j = 0; j < 4; ++j) { const float a = fmaxf(v0[j], 0.f), b = fmaxf(v1[j], 0.f); v0[j] = a * a; v1[j] = b * b; }
                    u32x4 w; w.x = pk2(v0[0], v0[1]); w.y = pk2(v0[2], v0[3]); w.z = pk2(v1[0], v1[1]); w.w = pk2(v1[2], v1[3]);
                    *(u32x4*)(rowp + bj * 128) = w; } }
    }
};
struct EpiRes {
    static constexpr bool PERM = false;
    float* H; bf16* HB; float* ssq;
    DI void operator()(const f32x4 (&acc)[2][2][4][2], const pg8::Unit& u, int wr, int wc, int fr, int fq) const {
        const int row0 = u.pm * 256 + wr * 64 + fr, col0 = u.pn * 256 + wc * 32 + 4 * fq;
#pragma unroll
        for (int ai = 0; ai < 2; ++ai)
#pragma unroll
            for (int m = 0; m < 4; ++m) { const int row = row0 + ai * 128 + m * 16; float* hp = H + (size_t)row * D + col0; bf16* bp = HB + (size_t)row * D + col0; float s = 0.f;
#pragma unroll
                for (int bj = 0; bj < 2; ++bj)
#pragma unroll
                    for (int n = 0; n < 2; ++n) { const f32x4 x = *(const f32x4*)(hp + bj * 128 + n * 16) + acc[ai][bj][m][n];
                        *(f32x4*)(hp + bj * 128 + n * 16) = x; u32x2 w; w.x = pk2(x[0], x[1]); w.y = pk2(x[2], x[3]); *(u32x2*)(bp + bj * 128 + n * 16) = w;
                        s += (x[0] * x[0] + x[1] * x[1]) + (x[2] * x[2] + x[3] * x[3]); }
                s += __shfl_xor(s, 16); s += __shfl_xor(s, 32);
                if (fq == 0) atomicAdd(ssq + row, s); }
    }
};

DI void transpose_item(const float* __restrict__ W, int K, int Nsrc, int src_c0, int nvalid, const float* __restrict__ gs, bf16* __restrict__ WT, int dst_row0, int k0, LAS float* scr, int lane) {
#pragma unroll 8
    for (int i = 0; i < 32; ++i) { const int kk = 2 * i + (lane >> 5), n = lane & 31;
        float v = 0.f; if (n < nvalid) { v = W[(size_t)(k0 + kk) * Nsrc + src_c0 + n]; if (gs) v *= gs[k0 + kk]; }
        scr[kk * 33 + n] = v; }
    asm volatile("s_waitcnt lgkmcnt(0)" ::: "memory");
    const int c = lane & 7;
#pragma unroll
    for (int j = 0; j < 4; ++j) { const int n = (lane >> 3) + 8 * j; const LAS float* s = scr + (8 * c) * 33 + n;
        u32x4 o; o.x = pk2(s[0 * 33], s[1 * 33]); o.y = pk2(s[2 * 33], s[3 * 33]); o.z = pk2(s[4 * 33], s[5 * 33]); o.w = pk2(s[6 * 33], s[7 * 33]);
        *(u32x4*)(WT + (size_t)(dst_row0 + n) * K + k0 + 8 * c) = o; }
    asm volatile("s_waitcnt lgkmcnt(0)" ::: "memory");
}
DI void ph_prologue(const Ctx& C) {
    const Params& P = *C.P; const int lane = C.lane;
    LAS float* scr = (LAS float*)C.wl;
    constexpr int I_IN = 16 * (NZ / 32), I_OUT = 16 * (D / 32), I_UP = 16 * (FF / 32), I_DN = 64 * (D / 32), I_L = I_IN + I_OUT + I_UP + I_DN;
    for (int it = C.gw; it < 2 * I_L; it += C.NGW) {
        const int l = it / I_L; int r = it % I_L;
        if (r < I_IN) { const int nb = r % (NZ / 32), kb = r / (NZ / 32), n0 = nb * 32;
            int c0, nv;
            if (n0 < 2560) { c0 = n0; nv = 32; } else if (n0 < ZG) { c0 = n0 + 8; nv = 32; } else if (n0 == ZG) { c0 = 2560; nv = 8; } else { c0 = 0; nv = 0; }
            transpose_item(P.in[11] + (size_t)l * D * 3592, D, 3592, c0, nv, P.in[10] + l * D, (bf16*)(C.ws + WS_WIN) + (size_t)l * NZ * D, n0, kb * 64, scr, lane); continue; }
        r -= I_IN;
        if (r < I_OUT) { const int nb = r % (D / 32), kb = r / (D / 32);
            transpose_item(P.in[17] + (size_t)l * D * D, D, D, nb * 32, 32, nullptr, (bf16*)(C.ws + WS_WOUT) + (size_t)l * D * D, nb * 32, kb * 64, scr, lane); continue; }
        r -= I_OUT;
        if (r < I_UP) { const int nb = r % (FF / 32), kb = r / (FF / 32);
            transpose_item(P.in[19] + (size_t)l * D * FF, D, FF, nb * 32, 32, P.in[18] + l * D, (bf16*)(C.ws + WS_WUP) + (size_t)l * FF * D, nb * 32, kb * 64, scr, lane); continue; }
        r -= I_UP;
        { const int nb = r % (D / 32), kb = r / (D / 32);
            transpose_item(P.in[20] + (size_t)l * FF * D, FF, D, nb * 32, 32, nullptr, (bf16*)(C.ws + WS_WDN) + (size_t)l * D * FF, nb * 32, kb * 64, scr, lane); }
    }
    float* H = (float*)(C.ws + WS_H); bf16* HB = (bf16*)(C.ws + WS_HB); float* SSQ = (float*)(C.ws + WS_SSQ);
    for (int m = C.gw; m < MPAD; m += C.NGW) {
        f32x4 v[4]; float s = 0.f;
        if (m < MT) { const float* xr = (m < MP) ? P.in[0] + (size_t)m * D : P.in[1] + (size_t)(m - MP) * D;
#pragma unroll
            for (int j = 0; j < 4; ++j) { v[j] = *(const f32x4*)(xr + 4 * lane + 256 * j); s += (v[j].x * v[j].x + v[j].y * v[j].y) + (v[j].z * v[j].z + v[j].w * v[j].w); }
        } else {
#pragma unroll
            for (int j = 0; j < 4; ++j) v[j] = (f32x4){0.f, 0.f, 0.f, 0.f}; }
        s = wave_sum(s);
#pragma unroll
        for (int j = 0; j < 4; ++j) { *(f32x4*)(H + (size_t)m * D + 4 * lane + 256 * j) = v[j]; u32x2 w; w.x = pk2(v[j].x, v[j].y); w.y = pk2(v[j].z, v[j].w); *(u32x2*)(HB + (size_t)m * D + 4 * lane + 256 * j) = w; }
        if (lane == 0) SSQ[m] = s;
    }
    for (int i = C.gw * 64 + lane; i < 4 * MPAD; i += C.NGW * 64) SSQ[MPAD + i] = 0.f;
    float* BT = (float*)(C.ws + WS_BIAST);
    for (int i = C.gw * 64 + lane; i < 3 * 8 * 132; i += C.NGW * 64) { const int br = i / (8 * 132), h = (i / 132) % 8, j = i % 132; BT[i] = (j <= 128) ? P.in[9][(int)P.bucket[br][j] * 8 + h] : 0.f; }
    float* LBV = (float*)(C.ws + WS_LBV);
    for (int i = C.gw * 64 + lane; i < 512; i += C.NGW * 64) { const int c = i & 255; LBV[i] = (i < 256) ? 0.f : sigm(P.in[15][256 + c] - P.in[15][c]); }
}

template <int br> DI void attn_unit(const Ctx& C, int l, int u) {
    const int lane = C.lane, t = lane & 31, hh = lane >> 5;
    constexpr int dil = br == 0 ? 1 : (br == 1 ? 4 : 16), nblk = 128 / dil;
    const int bh = u >> 7, rem = u & 127, r = rem / nblk, blk = rem % nblk, b = bh >> 3, h = bh & 7, i0 = blk * 32;
    const bf16* zb = (const bf16*)(C.ws + WS_Z) + (size_t)(b * SEQ) * NZ;
    const float* BT = (const float*)(C.ws + WS_BIAST) + (br * 8 + h) * 132;
    const int pq = (i0 + t) * dil + r;
    bf16x8 qf[4];
#pragma unroll
    for (int s = 0; s < 4; ++s) qf[s] = ldg8(zb + (size_t)pq * NZ + ZQ + h * 64 + 16 * s + 8 * hh);
    const int kt0 = blk < 4 ? 4 - blk : 0;
    const ptrdiff_t tile_step = (ptrdiff_t)32 * dil * NZ;
    const bf16* kp = zb + ((ptrdiff_t)(i0 - 128 + t) * dil + r) * NZ + ZK + h * 64 + 8 * hh + kt0 * tile_step;
    const bf16* vp = zb + ((ptrdiff_t)(i0 - 128 + (lane >> 3)) * dil + r) * NZ + ZV + h * 64 + 8 * (lane & 7) + kt0 * tile_step;
    f32x16 O[2]; O[0] = zero16(); O[1] = zero16();
    float mx = -1e30f, lsum = 0.f;
#pragma unroll 1
    for (int kt = kt0; kt < 5; ++kt, kp += tile_step, vp += tile_step) {
        f32x16 S = zero16();
#pragma unroll
        for (int s = 0; s < 4; ++s) S = MFMA32(ldg8(kp + 16 * s), qf[s], S);
        LAS unsigned char* vt = C.wl + (kt & 1) * (32 * VSTR);
#pragma unroll
        for (int i = 0; i < 4; ++i) *(LAS bf16x8*)(vt + ((lane >> 3) + 8 * i) * VSTR + (lane & 7) * 16) = ldg8(vp + (ptrdiff_t)(8 * i) * dil * NZ);
        float tm = -1e30f;
        const int jb = 128 + t - 32 * kt;
#pragma unroll
        for (int reg = 0; reg < 16; ++reg) { const int j = jb - crow(reg, hh); const bool ok = (j >= 0) && (j <= 128);
            const float sc = ok ? S[reg] * 0.125f + BT[ok ? j : 0] : -1e30f; S[reg] = sc; tm = fmaxf(tm, sc); }
        tm = fmaxf(tm, __shfl_xor(tm, 32));
        const float mn = fmaxf(mx, tm), alpha = fexp(mx - mn); mx = mn;
        float ps = 0.f;
#pragma unroll
        for (int reg = 0; reg < 16; ++reg) { const float p = fexp(S[reg] - mn); S[reg] = p; ps += p; }
        lsum = lsum * alpha + ps;
#pragma unroll
        for (int reg = 0; reg < 16; ++reg) { O[0][reg] *= alpha; O[1][reg] *= alpha; }
#pragma unroll
        for (int ks = 0; ks < 2; ++ks) { const bf16x8 pf = pack8(S, ks);
#pragma unroll
            for (int db = 0; db < 2; ++db) O[db] = MFMA32(tr_frag<true>(vt, 16 * ks, 32 * db, lane), pf, O[db]); }
    }
    lsum += __shfl_xor(lsum, 32);
    const float inv = 1.0f / lsum, lse = mx + flog(lsum);
    const size_t row = (size_t)b * SEQ + pq;
    if (br != 0) {
        bf16* po = (bf16*)(C.ws + WS_PO) + (size_t)(br - 1) * MP * 512 + row * 512 + h * 64;
#pragma unroll
        for (int db = 0; db < 2; ++db)
#pragma unroll
            for (int g = 0; g < 4; ++g) { u32x2 w; w.x = pk2(O[db][4 * g] * inv, O[db][4 * g + 1] * inv); w.y = pk2(O[db][4 * g + 2] * inv, O[db][4 * g + 3] * inv);
                *(u32x2*)(po + 32 * db + 8 * g + 4 * hh) = w; }
        if (hh == 0) ((float*)(C.ws + WS_PLSE))[(size_t)(br - 1) * MP * 8 + row * 8 + h] = lse;
    } else {
        const float l1 = ((const float*)(C.ws + WS_PLSE))[row * 8 + h], l2 = ((const float*)(C.ws + WS_PLSE))[(size_t)MP * 8 + row * 8 + h];
        const float M = fmaxf(lse, fmaxf(l1, l2)), w0 = fexp(lse - M), w1 = fexp(l1 - M), w2 = fexp(l2 - M), iw = 1.0f / (w0 + w1 + w2);
        const float c0 = w0 * iw * inv, c1 = w1 * iw, c2 = w2 * iw;
        const bf16* p1 = (const bf16*)(C.ws + WS_PO) + row * 512 + h * 64; const bf16* p2 = p1 + (size_t)MP * 512;
        bf16* mx_ = (bf16*)(C.ws + WS_MIX) + row * D + h * 64;
#pragma unroll
        for (int db = 0; db < 2; ++db)
#pragma unroll
            for (int g = 0; g < 4; ++g) { const int d0 = 32 * db + 8 * g + 4 * hh; const u32x2 a = *(const u32x2*)(p1 + d0), bq = *(const u32x2*)(p2 + d0);
                const float y0 = c0 * O[db][4 * g] + c1 * lo16(a.x) + c2 * lo16(bq.x), y1 = c0 * O[db][4 * g + 1] + c1 * hi16(a.x) + c2 * hi16(bq.x);
                const float y2 = c0 * O[db][4 * g + 2] + c1 * lo16(a.y) + c2 * lo16(bq.y), y3 = c0 * O[db][4 * g + 3] + c1 * hi16(a.y) + c2 * hi16(bq.y);
                u32x2 w; w.x = pk2(y0, y1); w.y = pk2(y2, y3); *(u32x2*)(mx_ + d0) = w; }
    }
}

DI void attn_sample_item(const Ctx& C, int l, int it) {
    const Params& P = *C.P; const int lane = C.lane, g = lane >> 4, i = lane & 15;
    const int b = it >> 5, t = (it >> 3) & 3, h = it & 7, srow = MP + b * 4 + t;
    const bf16* z = (const bf16*)(C.ws + WS_Z);
    LAS float* sc = (LAS float*)C.wl;
    const float* BT = (const float*)(C.ws + WS_BIAST);
    const u32x2 qw = *(const u32x2*)(z + (size_t)srow * NZ + ZQ + h * 64 + 4 * i);
    const float q0 = lo16(qw.x), q1 = hi16(qw.x), q2 = lo16(qw.y), q3 = hi16(qw.y);
    const float* ck = P.in[2] + ((size_t)(l * SB + b) * WB) * 512 + h * 64 + 4 * i;
    const float* cv = P.in[3] + ((size_t)(l * SB + b) * WB) * 512 + h * 64 + 4 * i;
    const bf16* zn = z + (size_t)(MP + b * 4) * NZ + h * 64 + 4 * i;
    for (int n0 = 0; n0 < 388; n0 += 32) {
        f32x4 kk[8]; int idxs[8];
#pragma unroll
        for (int u = 0; u < 8; ++u) { int n = n0 + 4 * u + g; n = n > 386 ? 386 : n; const int br = n / 129, j = n - br * 129, dil = br == 0 ? 1 : (br == 1 ? 4 : 16), idx = WB + t - dil * j;
            idxs[u] = idx; kk[u] = *(const f32x4*)(ck + (size_t)(idx < WB ? idx : WB - 1) * 512); }
#pragma unroll
        for (int u = 0; u < 8; ++u) { const int n = n0 + 4 * u + g;
            if (idxs[u] >= WB) { const u32x2 w = *(const u32x2*)(zn + (size_t)(idxs[u] - WB) * NZ + ZK); kk[u] = (f32x4){lo16(w.x), hi16(w.x), lo16(w.y), hi16(w.y)}; }
            float s = q0 * kk[u].x + q1 * kk[u].y + q2 * kk[u].z + q3 * kk[u].w;
            s += __shfl_xor(s, 1); s += __shfl_xor(s, 2); s += __shfl_xor(s, 4); s += __shfl_xor(s, 8);
            if (n < 387 && i == 0) { const int br = n / 129, j = n - br * 129; sc[n] = s * 0.125f + BT[(br * 8 + h) * 132 + j]; } }
    }
    float mx = -1e30f;
    for (int n = lane; n < 387; n += 64) mx = fmaxf(mx, sc[n]);
    mx = wave_max(mx);
    float ls = 0.f;
    for (int n = lane; n < 387; n += 64) { const float p = fexp(sc[n] - mx); sc[n] = p; ls += p; }
    ls = wave_sum(ls);
    f32x4 acc = (f32x4){0.f, 0.f, 0.f, 0.f};
    for (int n0 = 0; n0 < 388; n0 += 32) {
        f32x4 vv[8]; int idxs[8];
#pragma unroll
        for (int u = 0; u < 8; ++u) { int n = n0 + 4 * u + g; n = n > 386 ? 386 : n; const int br = n / 129, j = n - br * 129, dil = br == 0 ? 1 : (br == 1 ? 4 : 16), idx = WB + t - dil * j;
            idxs[u] = idx; vv[u] = *(const f32x4*)(cv + (size_t)(idx < WB ? idx : WB - 1) * 512); }
#pragma unroll
        for (int u = 0; u < 8; ++u) { const int n = n0 + 4 * u + g;
            if (idxs[u] >= WB) { const u32x2 w = *(const u32x2*)(zn + (size_t)(idxs[u] - WB) * NZ + ZV); vv[u] = (f32x4){lo16(w.x), hi16(w.x), lo16(w.y), hi16(w.y)}; }
            const float p = (n < 387) ? sc[n] : 0.f;
            acc += vv[u] * p; }
    }
#pragma unroll
    for (int c = 0; c < 4; ++c) { acc[c] += __shfl_xor(acc[c], 16); acc[c] += __shfl_xor(acc[c], 32); }
    if (g == 0) { const float inv = 1.0f / ls; u32x2 w; w.x = pk2(acc.x * inv, acc.y * inv); w.y = pk2(acc.z * inv, acc.w * inv);
        *(u32x2*)((bf16*)(C.ws + WS_MIX) + (size_t)srow * D + h * 64 + 4 * i) = w; }
}

DI float scan_add(float x, int lane) {
#pragma unroll
    for (int o = 1; o < 64; o <<= 1) { const float v = __shfl_up(x, o); if (lane >= o) x += v; }
    return x; }
DI float scan_max(float x, int lane) {
#pragma unroll
    for (int o = 1; o < 64; o <<= 1) { const float v = __shfl_up(x, o); if (lane >= o) x = fmaxf(x, v); }
    return x; }

DI void conv8(const bf16* zcol, int ts, const float* w, float scale, float (&y)[8]) {
#pragma unroll
    for (int e = 0; e < 8; ++e) y[e] = 0.f;
#pragma unroll
    for (int j = 0; j < 4; ++j) { const int tj = ts - 3 + j;
        if (tj >= 0) { const bf16x8 x = ldg8(zcol + (ptrdiff_t)(j - 3) * NZ); const f32x4 w0 = *(const f32x4*)(w + j * 512), w1 = *(const f32x4*)(w + j * 512 + 4);
            const u32x4 xw = __builtin_bit_cast(u32x4, x);
            y[0] += w0.x * lo16(xw.x); y[1] += w0.y * hi16(xw.x); y[2] += w0.z * lo16(xw.y); y[3] += w0.w * hi16(xw.y);
            y[4] += w1.x * lo16(xw.z); y[5] += w1.y * hi16(xw.z); y[6] += w1.z * lo16(xw.w); y[7] += w1.w * hi16(xw.w); } }
#pragma unroll
    for (int e = 0; e < 8; ++e) y[e] = silu(y[e]) * scale;
}

DI void mlstm_m1_item(const Ctx& C, int l, int it) {
    const Params& P = *C.P; const int lane = C.lane, hh = lane >> 5;
    const int bh = it >> 6, c = it & 63, b = bh >> 2, h = bh & 3, row0 = b * SEQ + c * 64;
    const bf16* z = (const bf16*)(C.ws + WS_Z);
    const float* gate = (const float*)(C.ws + WS_GATE);
    LAS unsigned char* kt_ = C.wl; LAS unsigned char* vt_ = C.wl + 32 * VSTR; LAS float* dpr = (LAS float*)(C.wl + 64 * VSTR);
    const float ig = gate[(size_t)(row0 + lane) * 8 + h] + P.in[12][l * 8 + h];
    const float lf = logsig(gate[(size_t)(row0 + lane) * 8 + 4 + h] + P.in[12][l * 8 + 4 + h]);
    const float bc = scan_add(lf, lane), bL = __shfl(bc, 63), uu = ig - bc, umax = wave_max(uu);
    dpr[lane] = fexp(uu - umax);
    ((float*)(C.ws + WS_MLB))[bh * SEQ + c * 64 + lane] = bc; ((float*)(C.ws + WS_MLU))[bh * SEQ + c * 64 + lane] = uu;
    if (lane == 0) { ((float*)(C.ws + WS_MLA))[bh * 64 + c] = bL + umax; ((float*)(C.ws + WS_MLBL))[bh * 64 + c] = bL; }
    const float* cw = P.in[13] + (size_t)l * 4 * 512;
    bf16* QC = (bf16*)(C.ws + WS_MLQC); bf16* KC = (bf16*)(C.ws + WS_MLKC);
#pragma unroll 2
    for (int i = 0; i < 8; ++i) { const int id = lane + 64 * i, rr = id >> 3, cgp = id & 7, ch = h * 64 + 8 * cgp, ts = c * 64 + rr; float y[8];
        conv8(z + (size_t)(row0 + rr) * NZ + ZMQ + ch, ts, cw + ch, 1.0f, y);
        u32x4 w; w.x = pk2(y[0], y[1]); w.y = pk2(y[2], y[3]); w.z = pk2(y[4], y[5]); w.w = pk2(y[6], y[7]);
        *(u32x4*)(QC + (size_t)(row0 + rr) * 256 + ch) = w; }
    f32x16 acc[2][2]; acc[0][0] = zero16(); acc[0][1] = zero16(); acc[1][0] = zero16(); acc[1][1] = zero16();
    float kn = 0.f;
    for (int hf = 0; hf < 2; ++hf) {
#pragma unroll 2
        for (int i = 0; i < 4; ++i) { const int id = lane + 64 * i, rr = id >> 3, cgp = id & 7, ch = h * 64 + 8 * cgp, rs = 32 * hf + rr, ts = c * 64 + rs; float y[8];
            conv8(z + (size_t)(row0 + rs) * NZ + ZMK + ch, ts, cw + 256 + ch, 0.125f, y);
            u32x4 w; w.x = pk2(y[0], y[1]); w.y = pk2(y[2], y[3]); w.z = pk2(y[4], y[5]); w.w = pk2(y[6], y[7]);
            *(u32x4*)(KC + (size_t)(row0 + rs) * 256 + ch) = w;
            *(LAS u32x4*)(kt_ + rr * VSTR + cgp * 16) = w;
            const float dp = dpr[rs];
            const u32x4 vw = __builtin_bit_cast(u32x4, ldg8(z + (size_t)(row0 + rs) * NZ + ZMV + ch));
            u32x4 vo; vo.x = pk2(lo16(vw.x) * dp, hi16(vw.x) * dp); vo.y = pk2(lo16(vw.y) * dp, hi16(vw.y) * dp); vo.z = pk2(lo16(vw.z) * dp, hi16(vw.z) * dp); vo.w = pk2(lo16(vw.w) * dp, hi16(vw.w) * dp);
            *(LAS u32x4*)(vt_ + rr * VSTR + cgp * 16) = vo; }
#pragma unroll
        for (int ks = 0; ks < 2; ++ks) { bf16x8 A[2], B[2];
#pragma unroll
            for (int x = 0; x < 2; ++x) { A[x] = tr_frag<false>(vt_, 16 * ks, 32 * x, lane); B[x] = tr_frag<false>(kt_, 16 * ks, 32 * x, lane); }
#pragma unroll
            for (int fb = 0; fb < 2; ++fb)
#pragma unroll
                for (int eb = 0; eb < 2; ++eb) acc[fb][eb] = MFMA32(A[fb], B[eb], acc[fb][eb]); }
        for (int s = 0; s < 32; ++s) kn += dpr[32 * hf + s] * bf2f(*(LAS const bf16*)(kt_ + s * VSTR + lane * 2));
    }
    float* KVT = (float*)(C.ws + WS_MLKVT) + (size_t)(bh * 64 + c) * 4096;
#pragma unroll
    for (int fb = 0; fb < 2; ++fb)
#pragma unroll
        for (int eb = 0; eb < 2; ++eb)
#pragma unroll
            for (int reg = 0; reg < 16; ++reg) KVT[(32 * fb + crow(reg, hh)) * 64 + 32 * eb + (lane & 31)] = acc[fb][eb][reg];
    ((float*)(C.ws + WS_MLKN))[(size_t)(bh * 64 + c) * 64 + lane] = kn;
}

DI void mlstm_m2_item(const Ctx& C, int l, int it) {
    const int lane = C.lane, bh = it >> 6, f = it & 63, b = bh >> 2, h = bh & 3;
    const float* __restrict__ MA = (const float*)(C.ws + WS_MLA) + bh * 64; const float* __restrict__ MBL = (const float*)(C.ws + WS_MLBL) + bh * 64;
    const float* __restrict__ KVT = (const float*)(C.ws + WS_MLKVT) + (size_t)bh * 64 * 4096 + f * 64 + lane;
    const float* __restrict__ KN = (const float*)(C.ws + WS_MLKN) + (size_t)bh * 64 * 64 + lane;
    bf16* __restrict__ CT = (bf16*)(C.ws + WS_MLCT) + (size_t)bh * 64 * 4096 + f * 64 + lane;
    float* __restrict__ NC = (float*)(C.ws + WS_MLNC) + (size_t)bh * 64 * 64 + lane;
    float* __restrict__ MC = (float*)(C.ws + WS_MLMC) + bh * 64;
    float m = 0.f, Cv = 0.f, nv = 0.f;
#pragma unroll 8
    for (int c = 0; c < 64; ++c) {
        const float a = MA[c], bL = MBL[c], mn = fmaxf(bL + m, a), gL = fexp(bL + m - mn), sc = fexp(a - mn);
        CT[(size_t)c * 4096] = f2bf(Cv);
        Cv = gL * Cv + sc * KVT[(size_t)c * 4096];
        if (f == 0) { NC[c * 64] = nv; nv = gL * nv + sc * KN[c * 64]; if (lane == 0) MC[c] = m; }
        m = mn;
    }
    C.out[O_PC + ((size_t)((l * NB + b) * 4 + h) * 64 + lane) * 64 + f] = Cv;
    if (f == 0) { C.out[O_PN + (size_t)((l * NB + b) * 4 + h) * 64 + lane] = nv; if (lane == 0) C.out[O_PM + (l * NB + b) * 4 + h] = m; }
}

DI void mlstm_m3_item(const Ctx& C, int l, int it) {
    const Params& P = *C.P; const int lane = C.lane, t = lane & 31, hh = lane >> 5;
    const int half = it & 1, c = (it >> 1) & 63, bh = it >> 7, b = bh >> 2, h = bh & 3, row0 = b * SEQ + c * 64, tok = 32 * half + t, row = row0 + tok;
    const bf16* z = (const bf16*)(C.ws + WS_Z);
    const bf16* QC = (const bf16*)(C.ws + WS_MLQC); const bf16* KC = (const bf16*)(C.ws + WS_MLKC);
    LAS float* us = (LAS float*)(C.wl + 64 * VSTR);
    bf16x8 qf[4];
#pragma unroll
    for (int s = 0; s < 4; ++s) qf[s] = ldg8(QC + (size_t)row * 256 + h * 64 + 16 * s + 8 * hh);
    const float u_l = ((const float*)(C.ws + WS_MLU))[bh * SEQ + c * 64 + lane], b_l = ((const float*)(C.ws + WS_MLB))[bh * SEQ + c * 64 + lane];
    const float m_c = ((const float*)(C.ws + WS_MLMC))[bh * 64 + c];
    const float cm = scan_max(u_l, lane), mt_l = b_l + fmaxf(m_c, cm);
    us[lane] = u_l;
    const float b_t = __shfl(b_l, tok), mt_t = __shfl(mt_l, tok), g_t = fexp(b_t + m_c - mt_t);
    f32x16 O[2]; O[0] = zero16(); O[1] = zero16();
    float den = 0.f;
    for (int kt = 0; kt <= half; ++kt) {
        const bf16* kp = KC + (size_t)(row0 + 32 * kt + t) * 256 + h * 64 + 8 * hh;
        f32x16 S = zero16();
#pragma unroll
        for (int s = 0; s < 4; ++s) S = MFMA32(ldg8(kp + 16 * s), qf[s], S);
#pragma unroll
        for (int reg = 0; reg < 16; ++reg) { const int sidx = 32 * kt + crow(reg, hh);
            const float w = (sidx <= tok) ? fexp(b_t + us[sidx] - mt_t) * S[reg] : 0.f; S[reg] = w; den += w; }
        LAS unsigned char* vt = C.wl + (kt & 1) * (32 * VSTR);
#pragma unroll
        for (int i = 0; i < 4; ++i) { const int id = lane + 64 * i, rr = id >> 3, cgp = id & 7;
            *(LAS bf16x8*)(vt + rr * VSTR + cgp * 16) = ldg8(z + (size_t)(row0 + 32 * kt + rr) * NZ + ZMV + h * 64 + 8 * cgp); }
#pragma unroll
        for (int ks = 0; ks < 2; ++ks) { const bf16x8 pf = pack8(S, ks);
#pragma unroll
            for (int fb = 0; fb < 2; ++fb) O[fb] = MFMA32(tr_frag<true>(vt, 16 * ks, 32 * fb, lane), pf, O[fb]); }
    }
    const bf16* CT = (const bf16*)(C.ws + WS_MLCT) + (size_t)(bh * 64 + c) * 4096;
    f32x16 X[2]; X[0] = zero16(); X[1] = zero16();
#pragma unroll
    for (int fb = 0; fb < 2; ++fb)
#pragma unroll
        for (int s = 0; s < 4; ++s) X[fb] = MFMA32(ldg8(CT + (32 * fb + t) * 64 + 16 * s + 8 * hh), qf[s], X[fb]);
    const float* NCp = (const float*)(C.ws + WS_MLNC) + (size_t)(bh * 64 + c) * 64;
    float qn = 0.f;
#pragma unroll
    for (int s = 0; s < 4; ++s) { const u32x4 qw = __builtin_bit_cast(u32x4, qf[s]); const f32x4 n0 = *(const f32x4*)(NCp + 16 * s + 8 * hh), n1 = *(const f32x4*)(NCp + 16 * s + 8 * hh + 4);
        qn += lo16(qw.x) * n0.x + hi16(qw.x) * n0.y + lo16(qw.y) * n0.z + hi16(qw.y) * n0.w + lo16(qw.z) * n1.x + hi16(qw.z) * n1.y + lo16(qw.w) * n1.z + hi16(qw.w) * n1.w; }
    qn += __shfl_xor(qn, 32); den += __shfl_xor(den, 32);
    den += g_t * qn;
    const float idn = 1.0f / fmaxf(fabsf(den), fexp(-mt_t));
    float ssq = 0.f;
#pragma unroll
    for (int fb = 0; fb < 2; ++fb)
#pragma unroll
        for (int reg = 0; reg < 16; ++reg) { const float hv = (O[fb][reg] + g_t * X[fb][reg]) * idn; O[fb][reg] = hv; ssq += hv * hv; }
    ssq += __shfl_xor(ssq, 32);
    const float rs = __builtin_amdgcn_rsqf(ssq * (1.0f / 64) + EPS);
    const float* gn = P.in[14] + l * 256 + h * 64;
    bf16* mxp = (bf16*)(C.ws + WS_MIX) + (size_t)row * D + 512 + h * 64;
    const bf16* og = z + (size_t)row * NZ + ZMO + h * 64;
#pragma unroll
    for (int fb = 0; fb < 2; ++fb)
#pragma unroll
        for (int g = 0; g < 4; ++g) { const int f0 = 32 * fb + 8 * g + 4 * hh; const u32x2 ow = *(const u32x2*)(og + f0); const f32x4 gv = *(const f32x4*)(gn + f0);
            u32x2 w; w.x = pk2(O[fb][4 * g] * rs * gv.x * sigm(lo16(ow.x)), O[fb][4 * g + 1] * rs * gv.y * sigm(hi16(ow.x)));
            w.y = pk2(O[fb][4 * g + 2] * rs * gv.z * sigm(lo16(ow.y)), O[fb][4 * g + 3] * rs * gv.w * sigm(hi16(ow.y)));
            *(u32x2*)(mxp + f0) = w; }
}

DI float rdlane(float x, int l) { return __builtin_bit_cast(float, __builtin_amdgcn_readlane(__builtin_bit_cast(int, x), l)); }
DI void mlstm_sample_item(const Ctx& C, int l, int it) {
    const Params& P = *C.P; const int lane = C.lane, b = it >> 2, h = it & 3;
    const bf16* z = (const bf16*)(C.ws + WS_Z); const float* gate = (const float*)(C.ws + WS_GATE);
    const size_t sb = (size_t)(l * SB + b) * 4 + h;
    const float* C0 = P.in[5] + sb * 4096;
    LAS float* Cs = (LAS float*)C.wl;
#pragma unroll 8
    for (int e = 0; e < 64; ++e) Cs[e * 64 + lane] = C0[e * 64 + lane];
    float nv = P.in[6][sb * 64 + lane], m = P.in[7][sb];
    const float* cw = P.in[13] + (size_t)l * 4 * 512; const float* cb = P.in[4] + (size_t)(l * SB + b) * 3 * 512;
    float xq[7], xk[7];
#pragma unroll
    for (int j = 0; j < 3; ++j) { xq[j] = cb[j * 512 + h * 64 + lane]; xk[j] = cb[j * 512 + 256 + h * 64 + lane]; }
#pragma unroll
    for (int j = 0; j < 4; ++j) { xq[3 + j] = bf2f(z[(size_t)(MP + b * 4 + j) * NZ + ZMQ + h * 64 + lane]); xk[3 + j] = bf2f(z[(size_t)(MP + b * 4 + j) * NZ + ZMK + h * 64 + lane]); }
    float wq[4], wk[4];
#pragma unroll
    for (int j = 0; j < 4; ++j) { wq[j] = cw[j * 512 + h * 64 + lane]; wk[j] = cw[j * 512 + 256 + h * 64 + lane]; }
    const float gnv = P.in[14][l * 256 + h * 64 + lane];
#pragma unroll
    for (int t = 0; t < 4; ++t) { const int row = MP + b * 4 + t;
        float qc = 0.f, kc = 0.f;
#pragma unroll
        for (int j = 0; j < 4; ++j) { qc += wq[j] * xq[t + j]; kc += wk[j] * xk[t + j]; }
        qc = silu(qc); kc = silu(kc) * 0.125f;
        const float ig = gate[(size_t)row * 8 + h] + P.in[12][l * 8 + h], lf = logsig(gate[(size_t)row * 8 + 4 + h] + P.in[12][l * 8 + 4 + h]);
        const float mn = fmaxf(lf + m, ig), fp = fexp(lf + m - mn), ip = fexp(ig - mn);
        const float vf = bf2f(z[(size_t)row * NZ + ZMV + h * 64 + lane]) * ip;
        float num = 0.f;
#pragma unroll 4
        for (int e = 0; e < 64; ++e) { const float ke = rdlane(kc, e), qe = rdlane(qc, e); const float cv = fp * Cs[e * 64 + lane] + ke * vf; Cs[e * 64 + lane] = cv; num += qe * cv; }
        nv = fp * nv + ip * kc;
        const float qn = wave_sum(qc * nv);
        const float hv = num / fmaxf(fabsf(qn), fexp(-mn));
        const float ssq = wave_sum(hv * hv), rs = __builtin_amdgcn_rsqf(ssq * (1.0f / 64) + EPS);
        const float og = bf2f(z[(size_t)row * NZ + ZMO + h * 64 + lane]);
        ((bf16*)(C.ws + WS_MIX))[(size_t)row * D + 512 + h * 64 + lane] = f2bf(hv * rs * gnv * sigm(og));
        m = mn; }
    float* oc = C.out + O_SC + sb * 4096;
#pragma unroll 8
    for (int e = 0; e < 64; ++e) oc[e * 64 + lane] = Cs[e * 64 + lane];
    C.out[O_SN + sb * 64 + lane] = nv; if (lane == 0) C.out[O_SM + sb] = m;
}

DI void hgrn_m1_item(const Ctx& C, int l, int it) {
    const int lane = C.lane, hh = lane >> 5;
    const int bh = it >> 6, c = it & 63, b = bh >> 2, h = bh & 3, row0 = b * SEQ + c * 64;
    const bf16* z = (const bf16*)(C.ws + WS_Z);
    LAS unsigned char* ft = C.wl; LAS unsigned char* kt_ = C.wl + 64 * VSTR; LAS unsigned char* vt_ = C.wl + 96 * VSTR;
    const float lb = ((const float*)(C.ws + WS_LBV))[l * 256 + h * 64 + lane];
#pragma unroll
    for (int i = 0; i < 8; ++i) { const int id = lane + 64 * i, rr = id >> 3, cgp = id & 7;
        *(LAS bf16x8*)(ft + rr * VSTR + cgp * 16) = ldg8(z + (size_t)(row0 + rr) * NZ + ZHF + h * 64 + 8 * cgp); }
    float ba = 0.f, r = 0.f;
#pragma unroll 8
    for (int t = 0; t < 64; ++t) { const float x = bf2f(*(LAS const bf16*)(ft + t * VSTR + lane * 2)); const float fg = lb + (1.0f - lb) * sigm(x); ba += flog(fg); if (t == 31) r = ba; }
    const float bL = ba;
    bf16* QT = (bf16*)(C.ws + WS_HGQT); bf16* KT = (bf16*)(C.ws + WS_HGKT); bf16* QB = (bf16*)(C.ws + WS_HGQB);
    f32x16 acc[2][2]; acc[0][0] = zero16(); acc[0][1] = zero16(); acc[1][0] = zero16(); acc[1][1] = zero16();
    ba = 0.f;
    for (int hf = 0; hf < 2; ++hf) {
#pragma unroll
        for (int i = 0; i < 4; ++i) { const int id = lane + 64 * i, rr = id >> 3, cgp = id & 7;
            *(LAS bf16x8*)(vt_ + rr * VSTR + cgp * 16) = ldg8(z + (size_t)(row0 + 32 * hf + rr) * NZ + ZHQ + h * 64 + 8 * cgp); }
#pragma unroll 8
        for (int tt = 0; tt < 32; ++tt) { const int t = 32 * hf + tt;
            const float x = bf2f(*(LAS const bf16*)(ft + t * VSTR + lane * 2)); const float fg = lb + (1.0f - lb) * sigm(x), kk = 1.0f - fg;
            ba += flog(fg);
            const float q = silu(bf2f(*(LAS const bf16*)(vt_ + tt * VSTR + lane * 2)));
            const size_t o = (size_t)(row0 + t) * 256 + h * 64 + lane;
            QT[o] = f2bf(q * fexp(ba - r)); KT[o] = f2bf(kk * fexp(r - ba)); QB[o] = f2bf(q * fexp(ba));
            *(LAS bf16*)(kt_ + tt * VSTR + lane * 2) = f2bf(kk * fexp(bL - ba)); }
#pragma unroll
        for (int i = 0; i < 4; ++i) { const int id = lane + 64 * i, rr = id >> 3, cgp = id & 7;
            *(LAS bf16x8*)(vt_ + rr * VSTR + cgp * 16) = ldg8(z + (size_t)(row0 + 32 * hf + rr) * NZ + ZHI + h * 64 + 8 * cgp); }
#pragma unroll
        for (int ks = 0; ks < 2; ++ks) { bf16x8 A[2], B[2];
#pragma unroll
            for (int x = 0; x < 2; ++x) { A[x] = tr_frag<false>(vt_, 16 * ks, 32 * x, lane); B[x] = tr_frag<false>(kt_, 16 * ks, 32 * x, lane); }
#pragma unroll
            for (int vb = 0; vb < 2; ++vb)
#pragma unroll
                for (int kb = 0; kb < 2; ++kb) acc[vb][kb] = MFMA32(A[vb], B[kb], acc[vb][kb]); }
    }
    float* GT = (float*)(C.ws + WS_HGGT) + (size_t)(bh * 64 + c) * 4096;
#pragma unroll
    for (int vb = 0; vb < 2; ++vb)
#pragma unroll
        for (int kb = 0; kb < 2; ++kb)
#pragma unroll
            for (int reg = 0; reg < 16; ++reg) GT[(32 * vb + crow(reg, hh)) * 64 + 32 * kb + (lane & 31)] = acc[vb][kb][reg];
    ((float*)(C.ws + WS_HGDL))[(size_t)(bh * 64 + c) * 64 + lane] = fexp(bL);
}
DI void hgrn_m2_item(const Ctx& C, int l, int it) {
    const int lane = C.lane, bh = it >> 6, v = it & 63, b = bh >> 2, h = bh & 3;
    const float* __restrict__ GT = (const float*)(C.ws + WS_HGGT) + (size_t)bh * 64 * 4096 + v * 64 + lane;
    const float* __restrict__ DL = (const float*)(C.ws + WS_HGDL) + (size_t)bh * 64 * 64 + lane;
    bf16* __restrict__ ST = (bf16*)(C.ws + WS_HGST) + (size_t)bh * 64 * 4096 + v * 64 + lane;
    float S = 0.f;
#pragma unroll 8
    for (int c = 0; c < 64; ++c) { ST[(size_t)c * 4096] = f2bf(S); S = DL[c * 64] * S + GT[(size_t)c * 4096]; }
    C.out[O_PS + ((size_t)((l * NB + b) * 4 + h) * 64 + lane) * 64 + v] = S;
}
DI void hgrn_m3_item(const Ctx& C, int l, int it) {
    const Params& P = *C.P; const int lane = C.lane, t = lane & 31, hh = lane >> 5;
    const int half = it & 1, c = (it >> 1) & 63, bh = it >> 7, b = bh >> 2, h = bh & 3, row0 = b * SEQ + c * 64, tok = 32 * half + t, row = row0 + tok;
    const bf16* z = (const bf16*)(C.ws + WS_Z);
    const bf16* QT = (const bf16*)(C.ws + WS_HGQT); const bf16* KT = (const bf16*)(C.ws + WS_HGKT); const bf16* QB = (const bf16*)(C.ws + WS_HGQB);
    bf16x8 qf[4];
#pragma unroll
    for (int s = 0; s < 4; ++s) qf[s] = ldg8(QT + (size_t)row * 256 + h * 64 + 16 * s + 8 * hh);
    f32x16 O[2]; O[0] = zero16(); O[1] = zero16();
    for (int kt = 0; kt <= half; ++kt) {
        const bf16* kp = KT + (size_t)(row0 + 32 * kt + t) * 256 + h * 64 + 8 * hh;
        f32x16 S = zero16();
#pragma unroll
        for (int s = 0; s < 4; ++s) S = MFMA32(ldg8(kp + 16 * s), qf[s], S);
#pragma unroll
        for (int reg = 0; reg < 16; ++reg) { const int sidx = 32 * kt + crow(reg, hh); S[reg] = (sidx <= tok) ? S[reg] : 0.f; }
        LAS unsigned char* vt = C.wl + (kt & 1) * (32 * VSTR);
#pragma unroll
        for (int i = 0; i < 4; ++i) { const int id = lane + 64 * i, rr = id >> 3, cgp = id & 7;
            *(LAS bf16x8*)(vt + rr * VSTR + cgp * 16) = ldg8(z + (size_t)(row0 + 32 * kt + rr) * NZ + ZHI + h * 64 + 8 * cgp); }
#pragma unroll
        for (int ks = 0; ks < 2; ++ks) { const bf16x8 pf = pack8(S, ks);
#pragma unroll
            for (int vb = 0; vb < 2; ++vb) O[vb] = MFMA32(tr_frag<true>(vt, 16 * ks, 32 * vb, lane), pf, O[vb]); }
    }
    const bf16* ST = (const bf16*)(C.ws + WS_HGST) + (size_t)(bh * 64 + c) * 4096;
#pragma unroll
    for (int s = 0; s < 4; ++s) { const bf16x8 qb = ldg8(QB + (size_t)row * 256 + h * 64 + 16 * s + 8 * hh);
#pragma unroll
        for (int vb = 0; vb < 2; ++vb) O[vb] = MFMA32(ldg8(ST + (32 * vb + t) * 64 + 16 * s + 8 * hh), qb, O[vb]); }
    float ssq = 0.f;
#pragma unroll
    for (int vb = 0; vb < 2; ++vb)
#pragma unroll
        for (int reg = 0; reg < 16; ++reg) ssq += O[vb][reg] * O[vb][reg];
    ssq += __shfl_xor(ssq, 32);
    const float rs = __builtin_amdgcn_rsqf(ssq * (1.0f / 64) + EPS);
    const float* gn = P.in[16] + l * 256 + h * 64;
    bf16* mxp = (bf16*)(C.ws + WS_MIX) + (size_t)row * D + 768 + h * 64;
    const bf16* og = z + (size_t)row * NZ + ZHG + h * 64;
#pragma unroll
    for (int vb = 0; vb < 2; ++vb)
#pragma unroll
        for (int g = 0; g < 4; ++g) { const int f0 = 32 * vb + 8 * g + 4 * hh; const u32x2 ow = *(const u32x2*)(og + f0); const f32x4 gv = *(const f32x4*)(gn + f0);
            u32x2 w; w.x = pk2(O[vb][4 * g] * rs * gv.x * sigm(lo16(ow.x)), O[vb][4 * g + 1] * rs * gv.y * sigm(hi16(ow.x)));
            w.y = pk2(O[vb][4 * g + 2] * rs * gv.z * sigm(lo16(ow.y)), O[vb][4 * g + 3] * rs * gv.w * sigm(hi16(ow.y)));
            *(u32x2*)(mxp + f0) = w; }
}
DI void hgrn_sample_item(const Ctx& C, int l, int it) {
    const Params& P = *C.P; const int lane = C.lane, b = it >> 2, h = it & 3;
    const bf16* z = (const bf16*)(C.ws + WS_Z);
    const size_t sb = (size_t)(l * SB + b) * 4 + h;
    const float* S0 = P.in[8] + sb * 4096;
    LAS float* Ss = (LAS float*)C.wl;
#pragma unroll 8
    for (int k = 0; k < 64; ++k) Ss[k * 64 + lane] = S0[k * 64 + lane];
    const float lb = ((const float*)(C.ws + WS_LBV))[l * 256 + h * 64 + lane], gnv = P.in[16][l * 256 + h * 64 + lane];
#pragma unroll
    for (int t = 0; t < 4; ++t) { const size_t zr = (size_t)(MP + b * 4 + t) * NZ;
        const float fg = lb + (1.0f - lb) * sigm(bf2f(z[zr + ZHF + h * 64 + lane])), kk = 1.0f - fg, q = silu(bf2f(z[zr + ZHQ + h * 64 + lane]));
        const float iv = bf2f(z[zr + ZHI + h * 64 + lane]);
        float o = 0.f;
#pragma unroll 4
        for (int k = 0; k < 64; ++k) { const float sv = rdlane(fg, k) * Ss[k * 64 + lane] + rdlane(kk, k) * iv; Ss[k * 64 + lane] = sv; o += rdlane(q, k) * sv; }
        const float ssq = wave_sum(o * o), rs = __builtin_amdgcn_rsqf(ssq * (1.0f / 64) + EPS);
        const float og = bf2f(z[zr + ZHG + h * 64 + lane]);
        ((bf16*)(C.ws + WS_MIX))[(size_t)(MP + b * 4 + t) * D + 768 + h * 64 + lane] = f2bf(o * rs * gnv * sigm(og)); }
    float* os = C.out + O_SS + sb * 4096;
#pragma unroll 8
    for (int k = 0; k < 64; ++k) os[k * 64 + lane] = Ss[k * 64 + lane];
}

DI void copy_row(const bf16* src, float* dst, int lane) {
    const u32x4 w = __builtin_bit_cast(u32x4, ldg8(src + 8 * lane));
    *(f32x4*)(dst + 8 * lane) = (f32x4){lo16(w.x), hi16(w.x), lo16(w.y), hi16(w.y)};
    *(f32x4*)(dst + 8 * lane + 4) = (f32x4){lo16(w.z), hi16(w.z), lo16(w.w), hi16(w.w)}; }
constexpr int CO_PKV = 2 * NB * WB, CO_SKV = 2 * MS, CO_PCV = NB * 3, CO_SCV = SB * 3, CO_ALL = CO_PKV + CO_SKV + CO_PCV + CO_SCV;
DI void copyout_item(const Ctx& C, int l, int it) {
    const bf16* z = (const bf16*)(C.ws + WS_Z); const int lane = C.lane;
    if (it < CO_PKV) { const int which = it / (NB * WB), r = it % (NB * WB), b = r / WB, j = r % WB;
        copy_row(z + (size_t)(b * SEQ + (SEQ - WB) + j) * NZ + (which ? ZV : ZK), C.out + (which ? O_PV : O_PK) + ((size_t)(l * NB + b) * WB + j) * 512, lane); return; }
    it -= CO_PKV;
    if (it < CO_SKV) { const int which = it / MS, r = it % MS;
        copy_row(z + (size_t)(MP + r) * NZ + (which ? ZV : ZK), C.out + (which ? O_SV : O_SK) + ((size_t)l * MS + r) * 512, lane); return; }
    it -= CO_SKV;
    if (it < CO_PCV) { const int b = it / 3, j = it % 3;
        copy_row(z + (size_t)(b * SEQ + SEQ - 3 + j) * NZ + ZMQ, C.out + O_PCONV + ((size_t)(l * NB + b) * 3 + j) * 512, lane); return; }
    it -= CO_PCV;
    { const int b = it / 3, j = it % 3;
        copy_row(z + (size_t)(MP + b * 4 + 1 + j) * NZ + ZMQ, C.out + O_SCONV + ((size_t)(l * SB + b) * 3 + j) * 512, lane); }
}

#define ITEM_LOOP(N, rot, call) do { for (int it = (C.wave * C.G + C.vcu + C.NGW - ((rot) % C.NGW)) % C.NGW; it < (N); it += C.NGW) { call; } } while (0)
DI int grab(const Ctx& C, int k) { unsigned v = 0; if (C.lane == 0) v = atomicAdd((unsigned*)(C.ws + WS_BAR + 16384) + 64 * k, 1u); return (int)__builtin_amdgcn_readfirstlane(v); }
#define QUEUE_LOOP(N, k, call) do { int it = C.gw; while (it < (N)) { call; it = C.NGW + grab(C, (k)); } } while (0)
template <int l> DI void ph_m1(const Ctx& C) {
    ITEM_LOOP(1024, 0, attn_sample_item(C, l, it));
    ITEM_LOOP(1024, 1024, hgrn_m1_item(C, l, it));
    ITEM_LOOP(1024, 0, mlstm_m1_item(C, l, it));
    ITEM_LOOP(128, 1024, mlstm_sample_item(C, l, it));
    ITEM_LOOP(128, 1152, hgrn_sample_item(C, l, it));
    QUEUE_LOOP(4096, 4 * l + 0, attn_unit<1>(C, l, it));
    QUEUE_LOOP(4096, 4 * l + 1, attn_unit<2>(C, l, it));
}
template <int l> DI void ph_m2(const Ctx& C) {
    ITEM_LOOP(1024, 0, mlstm_m2_item(C, l, it));
    ITEM_LOOP(1024, 1024, hgrn_m2_item(C, l, it));
    ITEM_LOOP(CO_ALL, 0, copyout_item(C, l, it));
}
template <int l> DI void ph_m3(const Ctx& C) {
    ITEM_LOOP(2048, 0, mlstm_m3_item(C, l, it));
    ITEM_LOOP(2048, 0, hgrn_m3_item(C, l, it));
    QUEUE_LOOP(4096, 4 * l + 2, attn_unit<0>(C, l, it));
}
DI void ph_final(const Ctx& C) {
    const Params& P = *C.P; const int lane = C.lane;
    const float* H = (const float*)(C.ws + WS_H); const float* SSQ = (const float*)(C.ws + WS_SSQ) + 4 * MPAD;
    for (int m = C.gw; m < MT; m += C.NGW) {
        const float rs = __builtin_amdgcn_rsqf(SSQ[m] * (1.0f / D) + EPS);
        float* o = (m < MP) ? C.out + O_YP + (size_t)m * D : C.out + O_YS + (size_t)(m - MP) * D;
#pragma unroll
        for (int j = 0; j < 4; ++j) { const f32x4 v = *(const f32x4*)(H + (size_t)m * D + 4 * lane + 256 * j), g = *(const f32x4*)(P.in[21] + 4 * lane + 256 * j);
            *(f32x4*)(o + 4 * lane + 256 * j) = v * rs * g; }
    }
}

#define XB_TMO      128
#define XB_XCNT(j)  (256  + 64 * (j))
#define XB_XSUB(j)  (1280 + 64 * (j))
#define XB_XGEN(j)  (2304 + 64 * (j))
#define XB_TOP      3328
#define XB_TOPGEN   3392
#define XCD_BAR_WORDS 3456
#define XB_SPIN_CAP (1u << 18)

__device__ __forceinline__ unsigned xb_ld(unsigned* p)              { return __hip_atomic_load(p, __ATOMIC_RELAXED, __HIP_MEMORY_SCOPE_AGENT); }
__device__ __forceinline__ unsigned xb_add(unsigned* p, unsigned v) { return __hip_atomic_fetch_add(p, v, __ATOMIC_RELAXED, __HIP_MEMORY_SCOPE_AGENT); }
__device__ __forceinline__ unsigned xb_xcc_id() { return (unsigned)__builtin_amdgcn_s_getreg((3 << 11) | 20) & 0xFu; }
#define XB_SPIN(cond, bar) do { unsigned _sp = 0; while (cond) { __builtin_amdgcn_s_sleep(1); \
    if ((++_sp & 255u) == 0u) { if (xb_ld(&(bar)[XB_TMO])) break; if (_sp > XB_SPIN_CAP) { atomicAdd(&(bar)[XB_TMO], 1u); break; } } } } while (0)


__device__ __forceinline__ XcdBarrier xcd_barrier_post(unsigned* bar, volatile LAS unsigned* st) {
    XcdBarrier b; b.bar = bar; b.x = xb_xcc_id(); b.st = st;
    if (threadIdx.x == 0) (void)xb_add(&bar[XB_XCNT(b.x)], 1u);
    return b;
}
__device__ __forceinline__ void xcd_barrier_complete(unsigned* bar, unsigned x, unsigned& nloc, unsigned& nx) {
    const unsigned G = gridDim.x * gridDim.y * gridDim.z;
    unsigned sum, cnt, mine, sp = 0u;
    for (;;) {
        sum = 0u; cnt = 0u; mine = 0u;
#pragma unroll
        for (unsigned j = 0; j < 16; ++j) { const unsigned c = xb_ld(&bar[XB_XCNT(j)]); sum += c; cnt += (c > 0u) ? 1u : 0u; mine = (j == x) ? c : mine; }
        if (sum == G) break;
        __builtin_amdgcn_s_sleep(1);
        if ((++sp & 255u) == 0u) { if (xb_ld(&bar[XB_TMO])) break; if (sp > XB_SPIN_CAP) { atomicAdd(&bar[XB_TMO], 1u); break; } }
    }
    nloc = mine > 0u ? mine : 1u; nx = cnt > 0u ? cnt : 1u;
}

__device__ __forceinline__ void xcd_barrier(const XcdBarrier& b) {
    asm volatile("s_waitcnt vmcnt(0)" ::: "memory");
    __syncthreads();
    if (threadIdx.x == 0) {
        unsigned* bar = b.bar;
        __builtin_amdgcn_s_waitcnt(0);
        unsigned nloc = b.st[0], nx = b.st[1];
        if (nloc == 0u) { xcd_barrier_complete(bar, b.x, nloc, nx); b.st[0] = nloc; b.st[1] = nx; }
        const unsigned old = xb_add(&bar[XB_XSUB(b.x)], 1u);
        const unsigned gen = old / nloc;
        if (old + 1u == (gen + 1u) * nloc) {
            __builtin_amdgcn_fence(__ATOMIC_RELEASE, "agent");
            asm volatile("s_waitcnt vmcnt(0)" ::: "memory");
            const unsigned og = xb_add(&bar[XB_TOP], 1u);
            const unsigned tg = og / nx;
            if (og + 1u == (tg + 1u) * nx) xb_add(&bar[XB_TOPGEN], 1u);
            else XB_SPIN(xb_ld(&bar[XB_TOPGEN]) == tg, bar);
            __builtin_amdgcn_fence(__ATOMIC_ACQUIRE, "agent");
            xb_add(&bar[XB_XGEN(b.x)], 1u);
            asm volatile("s_waitcnt vmcnt(0)" ::: "memory");
        } else {
            XB_SPIN(xb_ld(&bar[XB_XGEN(b.x)]) == gen, bar);
            __builtin_amdgcn_fence(__ATOMIC_ACQUIRE, "agent");
            asm volatile("s_waitcnt vmcnt(0)" ::: "memory");
        }
    }
    __syncthreads();
}


constexpr int NPH = 16;
#if MK_CGSYNC
#define GRID_SYNC() cg::this_grid().sync()
#else
#define GRID_SYNC() xcd_barrier(C.xb)
#endif
template <int l> DI void layer_phases(const Ctx& C, const Params& P) {
    float* SSQ = (float*)(C.ws + WS_SSQ);
#define IN(k) (P.ph_lo <= (1 + 7 * l + (k)) && (1 + 7 * l + (k)) < P.ph_hi)
#define SEAM(k) do { if (IN(k) && (1 + 7 * l + (k)) + 1 < P.ph_hi) GRID_SYNC(); } while (0)
#define DUP(k) for (int rep = 0; rep < (((PROBE_DUP >> (k)) & 1) ? 2 : 1); ++rep)
    DUP(0) { if (rep) GRID_SYNC();
    if (IN(0)) { pg8::Gemm g{(const bf16*)(C.ws + WS_HB), (const bf16*)(C.ws + WS_WIN) + (size_t)l * NZ * D, MPAD, NZ, D}; pg8::StaticOrder S; S.init(MPAD, NZ, C.G, (int)blockIdx.x);
        EpiZ E{(bf16*)(C.ws + WS_Z), SSQ + (2 * l) * MPAD, (float*)(C.ws + WS_GATE)};
        pg8::gemm_phase<EpiZ, pg8::StaticOrder, true, true>(C.lds, g, S, E); } }
    SEAM(0);
    DUP(1) { if (rep) GRID_SYNC(); if (IN(1)) ph_m1<l>(C); }
    SEAM(1);
    DUP(2) { if (rep) GRID_SYNC(); if (IN(2)) ph_m2<l>(C); }
    SEAM(2);
    DUP(3) { if (rep) GRID_SYNC(); if (IN(3)) ph_m3<l>(C); }
    SEAM(3);
    DUP(4) { if (rep) GRID_SYNC();
    if (IN(4)) { pg8::Gemm g{(const bf16*)(C.ws + WS_MIX), (const bf16*)(C.ws + WS_WOUT) + (size_t)l * D * D, MPAD, D, D}; pg8::StaticOrder S; S.init(MPAD, D, C.G, (int)blockIdx.x);
        EpiRes E{(float*)(C.ws + (rep ? WS_ACT : WS_H)), (bf16*)(C.ws + (rep ? WS_Z : WS_HB)), rep ? (float*)(C.ws + WS_GATE) : SSQ + (2 * l + 1) * MPAD};
        pg8::gemm_phase<EpiRes, pg8::StaticOrder, true, true>(C.lds, g, S, E); } }
    SEAM(4);
    DUP(5) { if (rep) GRID_SYNC();
    if (IN(5)) { pg8::Gemm g{(const bf16*)(C.ws + WS_HB), (const bf16*)(C.ws + WS_WUP) + (size_t)l * FF * D, MPAD, FF, D}; pg8::StaticOrder S; S.init(MPAD, FF, C.G, (int)blockIdx.x);
        EpiAct E{(bf16*)(C.ws + WS_ACT), SSQ + (2 * l + 1) * MPAD};
        pg8::gemm_phase<EpiAct, pg8::StaticOrder, true, true>(C.lds, g, S, E); } }
    SEAM(5);
    DUP(6) { if (rep) GRID_SYNC();
    if (IN(6)) { pg8::Gemm g{(const bf16*)(C.ws + WS_ACT), (const bf16*)(C.ws + WS_WDN) + (size_t)l * D * FF, MPAD, D, FF}; pg8::StaticOrder S; S.init(MPAD, D, C.G, (int)blockIdx.x);
        EpiRes E{(float*)(C.ws + (rep ? WS_Z : WS_H)), (bf16*)(C.ws + (rep ? WS_Z + (size_t)MPAD * D * 4 : WS_HB)), rep ? (float*)(C.ws + WS_GATE) : SSQ + (2 * l + 2) * MPAD};
        pg8::gemm_phase<EpiRes, pg8::StaticOrder, true, true>(C.lds, g, S, E); } }
    SEAM(6);
#undef DUP
#undef IN
#undef SEAM
}
__global__ void __launch_bounds__(NWAVES * 64, 2) mk_fwd(Params P) {
    extern __shared__ __attribute__((aligned(16))) unsigned char smem[];
    Ctx C; C.P = &P; C.lds = (LAS unsigned char*)smem; C.tid = threadIdx.x; C.lane = C.tid & 63; C.wave = __builtin_amdgcn_readfirstlane(C.tid >> 6);
    C.wl = C.lds + C.wave * WLDS;
    C.G = gridDim.x; { const int bx = blockIdx.x; C.vcu = (C.G % 8 == 0) ? (bx % 8) * (C.G / 8) + bx / 8 : bx; }
    C.gw = C.vcu * NWAVES + C.wave; C.NGW = C.G * NWAVES; C.ws = P.ws; C.out = P.out;
    { volatile LAS unsigned* st = (volatile LAS unsigned*)(C.lds + LDS_CTL); if (C.tid < 2) st[C.tid] = 0u; __syncthreads();
      C.xb.bar = (unsigned*)(C.ws + WS_BAR); C.xb.x = 0; C.xb.st = st;
      if (!MK_CGSYNC && P.ph_hi - P.ph_lo > 1) C.xb = xcd_barrier_post((unsigned*)(C.ws + WS_BAR), st); }
    if (P.ph_lo <= 0 && 0 < P.ph_hi) { ph_prologue(C); if ((PROBE_DUP >> 7) & 1) { GRID_SYNC(); ph_prologue(C); } if (1 < P.ph_hi) GRID_SYNC(); }
    layer_phases<0>(C, P);
    layer_phases<1>(C, P);
    if (P.ph_lo <= NPH - 1 && NPH - 1 < P.ph_hi) ph_final(C);
}

static int t5_bucket(int n) {
    const int max_exact = 16;
    if (n < max_exact) return n;
    const double scaled = std::log((double)(n < 1 ? 1 : n) / max_exact) / std::log(2048.0 / max_exact);
    int v = max_exact + (int)(scaled * (32 - max_exact));
    return v < 31 ? v : 31;
}

extern "C" void kernel_launch(void* const* d_in, const int* in_sizes, int n_in, void* d_out, int out_size, void* d_ws, size_t ws_size, hipStream_t stream) {
    static int grid = 0;
    if (grid == 0) {
        if (n_in != 22 || (size_t)out_size != O_END || ws_size < WS_END) { fprintf(stderr, "kernel_launch: unexpected shapes n_in %d out %d ws %zu (need %zu)\n", n_in, out_size, ws_size, (size_t)WS_END); grid = -1; return; }
        int dev = 0, cus = 0, per_cu = 0;
        hipGetDevice(&dev); hipDeviceGetAttribute(&cus, hipDeviceAttributeMultiprocessorCount, dev);
        hipFuncSetAttribute((const void*)mk_fwd, hipFuncAttributeMaxDynamicSharedMemorySize, LDS_BYTES);
        hipOccupancyMaxActiveBlocksPerMultiprocessor(&per_cu, (const void*)mk_fwd, NWAVES * 64, LDS_BYTES);
        if (per_cu < 1) { fprintf(stderr, "kernel_launch: occupancy query says %d blocks per CU\n", per_cu); per_cu = 1; }
        (void)hipGetLastError();
        grid = cus;
    }
    if (grid < 0) return;
    Params p{};
    for (int i = 0; i < 22; ++i) p.in[i] = (const float*)d_in[i];
    p.out = (float*)d_out; p.ws = (unsigned char*)d_ws;
    const int dils[3] = {1, 4, 16};
    for (int br = 0; br < 3; ++br) for (int j = 0; j <= 128; ++j) p.bucket[br][j] = (unsigned char)t5_bucket(dils[br] * j);
#if MK_MULTI
    for (int ph = 0; ph < NPH; ++ph) { p.ph_lo = ph; p.ph_hi = ph + 1; hipLaunchKernelGGL(mk_fwd, dim3(grid), dim3(NWAVES * 64), LDS_BYTES, stream, p); }
#else
    p.ph_lo = 0; p.ph_hi = NPH;
    if (hipMemsetAsync((char*)d_ws + WS_BAR, 0, 32768, stream) != hipSuccess) { fprintf(stderr, "kernel_launch: memset of the barrier words failed\n"); return; }
    void* args[] = {&p};
    hipError_t e = hipLaunchCooperativeKernel((const void*)mk_fwd, dim3(grid), dim3(NWAVES * 64), args, LDS_BYTES, stream);
    if (e != hipSuccess) fprintf(stderr, "cooperative launch failed: %s (grid %d)\n", hipGetErrorString(e), grid);
#endif
}
```

```cpp
#include <hip/hip_runtime.h>
#include <hip/hip_cooperative_groups.h>
#include <cstdio>
#include <cstdint>
#include <cmath>
namespace cg = cooperative_groups;

#ifndef MK_CGSYNC
#define MK_CGSYNC 0
#endif
#ifndef PROBE_DUP
#define PROBE_DUP 0
#endif
#ifndef PROBE_T0
#define PROBE_T0 -1
#define PROBE_T1 -1
#endif
#ifndef PROBE_BLK
#define PROBE_BLK 0
#endif
#ifndef PROBE_TSCALE
#define PROBE_TSCALE 1e-6f
#endif
#ifndef MK_MULTI
#define MK_MULTI 0
#endif

namespace pg8 {
#define PG8_LAS __attribute__((address_space(3)))
typedef unsigned short bf16_t;
typedef short bf16x8 __attribute__((ext_vector_type(8)));
typedef float f32x4 __attribute__((ext_vector_type(4)));
typedef unsigned u32x4 __attribute__((ext_vector_type(4)));
constexpr int BM = 256, BK = 64, HALF = 128, HTB = HALF * BK * 2, STAGE_BYTES = 8 * HTB, NXCD = 8, WGM = 8;

__host__ __device__ __forceinline__ int lds_byte(int r, int c) { const int st = (r >> 4) * 2 + (c >> 5), rr = r & 15, cc = c & 31, ob = rr * 64 + cc * 2; return st * 1024 + (ob ^ (((ob >> 9) & 1) << 5)); }
__host__ __device__ __forceinline__ void stage_rc(int b, int& R, int& C) { const int st = b / 1024, sb = b % 1024, swz = sb ^ (((sb >> 9) & 1) << 5); R = (st >> 1) * 16 + swz / 64; C = (st & 1) * 32 + (swz % 64) / 2; }
__host__ __device__ __forceinline__ int perm32(int rho) { const int n = rho >> 4, i = rho & 15; return 8 * (i >> 2) + 4 * n + (i & 3); }

struct Unit { int pm, pn; };
struct Gemm { const bf16_t* A; const bf16_t* Bt; int M, N, K; };

struct StaticOrder {
    int nM, nN, nwg, G, c;
    __host__ __device__ void init(int M, int N, int G_, int c_) { nM = M / BM; nN = N / BM; nwg = nM * nN; G = G_; c = c_; }
    __host__ __device__ bool next(int i, Unit& u) const {
        const long L = (long)i * G + c; if (L >= nwg) return false;
        int wgid = (int)L; { const int q = nwg / NXCD, r = nwg % NXCD, xcd = wgid % NXCD, off = wgid / NXCD; wgid = (xcd < r ? xcd * (q + 1) : r * (q + 1) + (xcd - r) * q) + off; }
        const int nig = WGM * nN, gid = wgid / nig, fm = gid * WGM, gsz = (nM - fm) < WGM ? (nM - fm) : WGM;
        u.pm = fm + ((wgid % nig) % gsz); u.pn = (wgid % nig) / gsz; return true;
    }
    __device__ __forceinline__ void a_ready(const Unit&) const {}
    __device__ __forceinline__ void done(const Unit&) const {}
};

__device__ __forceinline__ unsigned cvt_pk_bf16(float lo, float hi) { unsigned r; asm volatile("v_cvt_pk_bf16_f32 %0, %1, %2" : "=v"(r) : "v"(lo), "v"(hi)); return r; }

template <class Epi, class Sched, bool ALIGN_EPI = false, bool SP2 = false>
__device__ __forceinline__ void gemm_phase(PG8_LAS unsigned char* lds, const Gemm g, const Sched& S, const Epi& E) {
    int tid_ = threadIdx.x; asm volatile("" : "+v"(tid_));
    const int tid = tid_, wid = __builtin_amdgcn_readfirstlane(tid >> 6), lane = tid & 63, wr = wid >> 2, wc = wid & 3, fr = lane & 15, fq = lane >> 4;
    const int K = g.K, nt = K / BK;
    unsigned voffA[2], voffB[2];
#pragma unroll
    for (int i = 0; i < 2; ++i) { int R, C; stage_rc(tid * 16 + i * 8192, R, C); const int Rb = Epi::PERM ? ((R & ~31) + perm32(R & 31)) : R;
        voffA[i] = (unsigned)(R * K + C) * 2u; voffB[i] = (unsigned)(Rb * K + C) * 2u; }
    const size_t kstep = (size_t)(BK * 2);
    const size_t hstep = (size_t)HALF * K * 2;
    const size_t tstep = 2 * hstep;
    const unsigned ldsw = (unsigned)wid * 1024u;
    const int aoff = lds_byte(wr * 64 + fr, fq * 8), boff = lds_byte(wc * 32 + fr, fq * 8);
#define PG8_SA(b, h) (((b) * 2 + (h)) * HTB)
#define PG8_SB(b, h) ((4 + (b) * 2 + (h)) * HTB)
#define PG8_STAGE(bufoff, gbase, voff) do { _Pragma("unroll") for (int _i = 0; _i < 2; ++_i) \
        __builtin_amdgcn_global_load_lds((const unsigned*)((const char*)(gbase) + (voff)[_i]), (PG8_LAS unsigned*)(lds + (bufoff) + ldsw + _i * 8192), 16, 0, 0); } while (0)
#define PG8_LDA(dst, b, h) do { _Pragma("unroll") for (int m = 0; m < 4; ++m) _Pragma("unroll") for (int k = 0; k < 2; ++k) dst[m][k] = *(const PG8_LAS bf16x8*)(lds + PG8_SA(b, h) + aoff + m * 2048 + k * 1024); } while (0)
#define PG8_LDB(dst, b, h) do { _Pragma("unroll") for (int n = 0; n < 2; ++n) _Pragma("unroll") for (int k = 0; k < 2; ++k) dst[n][k] = *(const PG8_LAS bf16x8*)(lds + PG8_SB(b, h) + boff + n * 2048 + k * 1024); } while (0)
#define PG8_MMA(ai, bj, At, Bt) do { __builtin_amdgcn_s_setprio(1); _Pragma("unroll") for (int m = 0; m < 4; ++m) _Pragma("unroll") for (int n = 0; n < 2; ++n) _Pragma("unroll") for (int k = 0; k < 2; ++k) \
        acc[ai][bj][m][n] = __builtin_amdgcn_mfma_f32_16x16x32_bf16(Bt[n][k], At[m][k], acc[ai][bj][m][n], 0, 0, 0); __builtin_amdgcn_s_setprio(0); } while (0)
#define PG8_WAIT_V(n) asm volatile("s_waitcnt vmcnt(" #n ")" ::: "memory")
#define PG8_WAIT_L(n) asm volatile("s_waitcnt lgkmcnt(" #n ")" ::: "memory")
#define PG8_BAR __builtin_amdgcn_s_barrier()
#define PG8_SCHED __builtin_amdgcn_sched_barrier(0)
    Unit cur, nxt; int ui = 0;
    if (!S.next(0, cur)) return;
    f32x4 acc[2][2][4][2];
#pragma unroll
    for (int a = 0; a < 2; ++a)
#pragma unroll
        for (int b = 0; b < 2; ++b)
#pragma unroll
            for (int m = 0; m < 4; ++m)
#pragma unroll
                for (int n = 0; n < 2; ++n) acc[a][b][m][n] = (f32x4){0.f, 0.f, 0.f, 0.f};
    bf16x8 At[4][2], B0[2][2], B1[2][2];
    const char* cA = (const char*)g.A + (size_t)cur.pm * tstep; const char* cB = (const char*)g.Bt + (size_t)cur.pn * tstep;
    S.a_ready(cur);
    if constexpr (SP2) {
        PG8_STAGE(PG8_SB(0, 0), cB, voffB); PG8_STAGE(PG8_SB(0, 1), cB + hstep, voffB); PG8_STAGE(PG8_SA(0, 0), cA, voffA); PG8_STAGE(PG8_SA(0, 1), cA + hstep, voffA);
        if (wr == 1) PG8_BAR;
        PG8_WAIT_V(2); PG8_BAR;
        PG8_STAGE(PG8_SB(1, 0), cB + kstep, voffB); PG8_STAGE(PG8_SA(1, 0), cA + kstep, voffA); PG8_STAGE(PG8_SB(1, 1), cB + hstep + kstep, voffB);
        PG8_WAIT_V(6); PG8_BAR;
    } else {
        PG8_STAGE(PG8_SB(0, 0), cB, voffB); PG8_STAGE(PG8_SA(0, 0), cA, voffA); PG8_STAGE(PG8_SB(0, 1), cB + hstep, voffB); PG8_STAGE(PG8_SA(0, 1), cA + hstep, voffA);
        if (wr == 1) PG8_BAR;
        PG8_WAIT_V(4); PG8_BAR;
        PG8_STAGE(PG8_SB(1, 0), cB + kstep, voffB); PG8_STAGE(PG8_SA(1, 0), cA + kstep, voffA); PG8_STAGE(PG8_SB(1, 1), cB + hstep + kstep, voffB);
        PG8_WAIT_V(6); PG8_BAR;
    }
    for (;;) {
        const bool has_next = S.next(ui + 1, nxt);
        const char* nA = has_next ? (const char*)g.A + (size_t)nxt.pm * tstep : cA; const char* nB = has_next ? (const char*)g.Bt + (size_t)nxt.pn * tstep : cB;
        for (int t = 0; t < nt; t += 2) {
            const bool last = (t == nt - 2);
            const char* a1 = cA + (size_t)(t + 1) * kstep;
            const char* a2 = last ? nA : cA + (size_t)(t + 2) * kstep; const char* b2 = last ? nB : cB + (size_t)(t + 2) * kstep;
            const char* a3 = a2 + kstep; const char* b3 = b2 + kstep;
            if (last && has_next) S.a_ready(nxt);
            if constexpr (SP2) {
            PG8_LDB(B0, 0, 0); PG8_LDB(B1, 0, 1); PG8_SCHED; PG8_LDA(At, 0, 0); PG8_STAGE(PG8_SA(1, 1), a1 + hstep, voffA);
            PG8_WAIT_V(8); PG8_WAIT_L(0); PG8_BAR; PG8_MMA(0, 0, At, B0); PG8_MMA(0, 1, At, B1); PG8_BAR; PG8_SCHED;
            PG8_LDA(At, 0, 1); PG8_STAGE(PG8_SB(0, 0), b2, voffB); PG8_STAGE(PG8_SB(0, 1), b2 + hstep, voffB); PG8_STAGE(PG8_SA(0, 0), a2, voffA);
            PG8_WAIT_V(8); PG8_WAIT_L(0); PG8_BAR; PG8_MMA(1, 0, At, B0); PG8_MMA(1, 1, At, B1); PG8_BAR; PG8_SCHED;
            PG8_LDB(B0, 1, 0); PG8_LDB(B1, 1, 1); PG8_SCHED; PG8_LDA(At, 1, 0); PG8_STAGE(PG8_SA(0, 1), a2 + hstep, voffA);
            PG8_WAIT_V(8); PG8_WAIT_L(0); PG8_BAR; PG8_MMA(0, 0, At, B0); PG8_MMA(0, 1, At, B1); PG8_BAR; PG8_SCHED;
            PG8_LDA(At, 1, 1); PG8_STAGE(PG8_SB(1, 0), b3, voffB); PG8_STAGE(PG8_SB(1, 1), b3 + hstep, voffB); PG8_STAGE(PG8_SA(1, 0), a3, voffA);
            PG8_WAIT_V(8); PG8_WAIT_L(0); PG8_BAR; PG8_MMA(1, 0, At, B0); PG8_MMA(1, 1, At, B1); PG8_BAR; PG8_SCHED;
            } else {
            PG8_LDB(B0, 0, 0); PG8_SCHED; PG8_LDA(At, 0, 0); PG8_STAGE(PG8_SA(1, 1), a1 + hstep, voffA);
            PG8_WAIT_L(8); PG8_BAR; PG8_WAIT_L(0); PG8_MMA(0, 0, At, B0); PG8_BAR; PG8_SCHED;
            PG8_LDB(B1, 0, 1); PG8_STAGE(PG8_SB(0, 0), b2, voffB);
            PG8_BAR; PG8_WAIT_L(0); PG8_MMA(0, 1, At, B1); PG8_BAR;
            PG8_LDA(At, 0, 1); PG8_STAGE(PG8_SA(0, 0), a2, voffA);
            PG8_BAR; PG8_WAIT_L(0); PG8_MMA(1, 0, At, B0); PG8_BAR; PG8_SCHED;
            PG8_STAGE(PG8_SB(0, 1), b2 + hstep, voffB);
            PG8_WAIT_V(6); PG8_BAR; PG8_MMA(1, 1, At, B1); PG8_BAR;
            PG8_LDB(B0, 1, 0); PG8_SCHED; PG8_LDA(At, 1, 0); PG8_STAGE(PG8_SA(0, 1), a2 + hstep, voffA);
            PG8_WAIT_L(8); PG8_BAR; PG8_WAIT_L(0); PG8_MMA(0, 0, At, B0); PG8_BAR; PG8_SCHED;
            PG8_LDB(B1, 1, 1); PG8_STAGE(PG8_SB(1, 0), b3, voffB);
            PG8_BAR; PG8_WAIT_L(0); PG8_MMA(0, 1, At, B1); PG8_BAR;
            PG8_LDA(At, 1, 1); PG8_STAGE(PG8_SA(1, 0), a3, voffA);
            PG8_BAR; PG8_WAIT_L(0); PG8_MMA(1, 0, At, B0); PG8_BAR; PG8_SCHED;
            PG8_STAGE(PG8_SB(1, 1), b3 + hstep, voffB);
            PG8_WAIT_V(6); PG8_BAR; PG8_MMA(1, 1, At, B1); PG8_BAR;
            }
        }
        if constexpr (ALIGN_EPI) { if (wr == 0) PG8_BAR; }
        E(acc, cur, wr, wc, fr, fq);
        if (!has_next) break;
#pragma unroll
        for (int a = 0; a < 2; ++a)
#pragma unroll
            for (int b = 0; b < 2; ++b)
#pragma unroll
                for (int m = 0; m < 4; ++m)
#pragma unroll
                    for (int n = 0; n < 2; ++n) acc[a][b][m][n] = (f32x4){0.f, 0.f, 0.f, 0.f};
        cur = nxt; cA = nA; cB = nB; ++ui;
        if constexpr (ALIGN_EPI) { if (wr == 1) PG8_BAR; }
    }
    PG8_WAIT_V(0);
    if constexpr (!ALIGN_EPI) { if (wr == 0) PG8_BAR; }
    PG8_BAR;
#undef PG8_SA
#undef PG8_SB
#undef PG8_STAGE
#undef PG8_LDA
#undef PG8_LDB
#undef PG8_MMA
#undef PG8_WAIT_V
#undef PG8_WAIT_L
#undef PG8_BAR
#undef PG8_SCHED
}
}

#define LAS __attribute__((address_space(3)))
#define DI __device__ __forceinline__
typedef unsigned short bf16;
typedef short bf16x8 __attribute__((ext_vector_type(8)));
typedef short s16x4 __attribute__((ext_vector_type(4)));
typedef float f32x16 __attribute__((ext_vector_type(16)));
typedef float f32x4 __attribute__((ext_vector_type(4)));
typedef float f32x2 __attribute__((ext_vector_type(2)));
typedef unsigned u32x4 __attribute__((ext_vector_type(4)));
typedef unsigned u32x2 __attribute__((ext_vector_type(2)));
typedef __bf16 bf16x2_t __attribute__((ext_vector_type(2)));
typedef short v4i16_t __attribute__((ext_vector_type(4)));

constexpr int D = 1024, SEQ = 4096, NB = 4, MP = NB * SEQ, SB = 32, STK = 4, MS = SB * STK, MT = MP + MS, MPAD = 16640;
constexpr int NZ = 3840, FF = 4096, NWAVES = 8, NCHUNK = 64, WB = 2048;
constexpr int ZQ = 0, ZK = 512, ZV = 1024, ZMQ = 1536, ZMK = 1792, ZMV = 2048, ZMO = 2304, ZHQ = 2560, ZHF = 2816, ZHI = 3072, ZHG = 3328, ZG = 3584;
constexpr float EPS = 1e-6f;
constexpr float LOG2E = 1.4426950408889634f;

constexpr size_t O_YP = 0, O_YS = O_YP + (size_t)MP * D, O_PK = O_YS + (size_t)MS * D, O_PV = O_PK + (size_t)2 * NB * WB * 512, O_PCONV = O_PV + (size_t)2 * NB * WB * 512,
    O_PC = O_PCONV + 2 * NB * 3 * 512, O_PN = O_PC + 2 * NB * 4 * 4096, O_PM = O_PN + 2 * NB * 4 * 64, O_PS = O_PM + 2 * NB * 4, O_SK = O_PS + 2 * NB * 4 * 4096,
    O_SV = O_SK + (size_t)2 * SB * STK * 512, O_SCONV = O_SV + (size_t)2 * SB * STK * 512, O_SC = O_SCONV + 2 * SB * 3 * 512, O_SN = O_SC + (size_t)2 * SB * 4 * 4096,
    O_SM = O_SN + 2 * SB * 4 * 64, O_SS = O_SM + 2 * SB * 4, O_END = O_SS + (size_t)2 * SB * 4 * 4096;

constexpr size_t al256(size_t x) { return (x + 255) & ~(size_t)255; }
constexpr size_t WS_WIN = 0;
constexpr size_t WS_WOUT = WS_WIN + (size_t)2 * NZ * D * 2;
constexpr size_t WS_WUP = WS_WOUT + (size_t)2 * D * D * 2;
constexpr size_t WS_WDN = WS_WUP + (size_t)2 * FF * D * 2;
constexpr size_t WS_H = WS_WDN + (size_t)2 * D * FF * 2;
constexpr size_t WS_HB = WS_H + (size_t)MPAD * D * 4;
constexpr size_t WS_SSQ = WS_HB + (size_t)MPAD * D * 2;
constexpr size_t WS_Z = al256(WS_SSQ + (size_t)5 * MPAD * 4);
constexpr size_t WS_GATE = WS_Z + (size_t)MPAD * NZ * 2;
constexpr size_t WS_MIX = WS_GATE + (size_t)MPAD * 8 * 4;
constexpr size_t WS_ACT = WS_MIX + (size_t)MPAD * D * 2;
constexpr size_t WS_PO = WS_ACT + (size_t)MPAD * FF * 2;
constexpr size_t WS_PLSE = WS_PO + (size_t)2 * MP * 512 * 2;
constexpr size_t WS_BIAST = WS_PLSE + (size_t)2 * MP * 8 * 4;
constexpr size_t WS_LBV = al256(WS_BIAST + 3 * 8 * 132 * 4);
constexpr size_t WS_MLQC = WS_LBV + 2 * 256 * 4;
constexpr size_t WS_MLKC = WS_MLQC + (size_t)MP * 256 * 2;
constexpr size_t WS_MLB = WS_MLKC + (size_t)MP * 256 * 2;
constexpr size_t WS_MLU = WS_MLB + (size_t)16 * SEQ * 4;
constexpr size_t WS_MLA = WS_MLU + (size_t)16 * SEQ * 4;
constexpr size_t WS_MLBL = WS_MLA + 16 * 64 * 4;
constexpr size_t WS_MLMC = WS_MLBL + 16 * 64 * 4;
constexpr size_t WS_MLKVT = WS_MLMC + 16 * 64 * 4;
constexpr size_t WS_MLKN = WS_MLKVT + (size_t)16 * 64 * 4096 * 4;
constexpr size_t WS_MLCT = WS_MLKN + (size_t)16 * 64 * 64 * 4;
constexpr size_t WS_MLNC = WS_MLCT + (size_t)16 * 64 * 4096 * 2;
constexpr size_t WS_HGQT = WS_MLNC + (size_t)16 * 64 * 64 * 4;
constexpr size_t WS_HGKT = WS_HGQT + (size_t)MP * 256 * 2;
constexpr size_t WS_HGQB = WS_HGKT + (size_t)MP * 256 * 2;
constexpr size_t WS_HGGT = WS_HGQB + (size_t)MP * 256 * 2;
constexpr size_t WS_HGDL = WS_HGGT + (size_t)16 * 64 * 4096 * 4;
constexpr size_t WS_HGST = WS_HGDL + (size_t)16 * 64 * 64 * 4;
constexpr size_t WS_BAR = WS_HGST + (size_t)16 * 64 * 4096 * 2;
constexpr size_t WS_KC = WS_BAR + 32768;
constexpr size_t WS_VC = WS_KC + (size_t)NB * 8 * SEQ * 64 * 2;
constexpr size_t WS_SAP = WS_VC + (size_t)NB * 8 * SEQ * 64 * 2;
constexpr size_t WS_TS = WS_SAP + (size_t)3072 * 68 * 4;
constexpr size_t WS_END = WS_TS + 512;

constexpr int LDS_BYTES = 147456 + 256;
constexpr int LDS_CTL = 147456;
constexpr int WLDS = 18432;
constexpr int VSTR = 144;

struct Params {
    const float* in[22];
    float* out;
    unsigned char* ws;
    int ph_lo, ph_hi;
    unsigned char bucket[3][136];
};

DI float bf2f(bf16 v) { return __builtin_bit_cast(float, (unsigned)v << 16); }
DI unsigned pk2(float lo, float hi) { f32x2 v = {lo, hi}; bf16x2_t b = __builtin_convertvector(v, bf16x2_t); return __builtin_bit_cast(unsigned, b); }
DI bf16 f2bf(float x) { return (bf16)(pk2(x, 0.f) & 0xffffu); }
DI float lo16(unsigned w) { return __builtin_bit_cast(float, w << 16); }
DI float hi16(unsigned w) { return __builtin_bit_cast(float, w & 0xffff0000u); }
DI int crow(int reg, int hh) { return (reg & 3) + 8 * (reg >> 2) + 4 * hh; }
DI bf16x8 ldg8(const bf16* p) { return *(const bf16x8*)p; }
DI float fexp(float x) { return __builtin_amdgcn_exp2f(x * LOG2E); }
DI float flog(float x) { return __builtin_amdgcn_logf(x) * 0.6931471805599453f; }
DI float sigm(float x) { return __builtin_amdgcn_rcpf(1.0f + fexp(-x)); }
DI float silu(float x) { return x * sigm(x); }
DI float logsig(float x) { return fminf(x, 0.f) - flog(1.0f + fexp(-fabsf(x))); }
DI float wave_sum(float v) {
#pragma unroll
    for (int o = 1; o < 64; o <<= 1) v += __shfl_xor(v, o);
    return v; }
DI float wave_max(float v) {
#pragma unroll
    for (int o = 1; o < 64; o <<= 1) v = fmaxf(v, __shfl_xor(v, o));
    return v; }
#define MFMA32(a, b, c) __builtin_amdgcn_mfma_f32_32x32x16_bf16((a), (b), (c), 0, 0, 0)
DI bf16x8 pack8(const f32x16& x, int s) {
    u32x4 p; p.x = pk2(x[8 * s], x[8 * s + 1]); p.y = pk2(x[8 * s + 2], x[8 * s + 3]); p.z = pk2(x[8 * s + 4], x[8 * s + 5]); p.w = pk2(x[8 * s + 6], x[8 * s + 7]);
    return __builtin_bit_cast(bf16x8, p); }
DI s16x4 vtr(LAS const unsigned char* p) { return __builtin_bit_cast(s16x4, __builtin_amdgcn_ds_read_tr16_b64_v4i16((LAS v4i16_t*)p)); }
template <bool PERMK> DI bf16x8 tr_frag(LAS const unsigned char* tile, int k0, int n0, int lane) {
    const int hh = lane >> 5, q = (lane & 15) >> 2, col = n0 + 16 * ((lane >> 4) & 1) + 4 * (lane & 3);
    const int r1 = k0 + (PERMK ? 4 * hh : 8 * hh) + q, r2 = r1 + (PERMK ? 8 : 4);
    const s16x4 lo = vtr(tile + r1 * VSTR + col * 2), hi = vtr(tile + r2 * VSTR + col * 2);
    return __builtin_shufflevector(lo, hi, 0, 1, 2, 3, 4, 5, 6, 7); }
DI f32x16 zero16() { f32x16 z; for (int i = 0; i < 16; ++i) z[i] = 0.f; return z; }

struct XcdBarrier { unsigned* bar; unsigned x; volatile LAS unsigned* st; };
struct Ctx {
    const Params* P; LAS unsigned char* lds; LAS unsigned char* wl; int tid, lane, wave, vcu, G, gw, NGW;
    unsigned char* ws; float* out; XcdBarrier xb;
};

DI Ctx fresh(const Ctx& C0) { return C0; }
struct EpiZ {
    static constexpr bool PERM = true;
    bf16* Z; const float* ssq; float* gate; bf16* KV;
    DI void operator()(const f32x4 (&acc)[2][2][4][2], const pg8::Unit& u, int wr, int wc, int fr, int fq) const {
        const int row0 = u.pm * 256 + wr * 64 + fr, col0 = u.pn * 256 + wc * 32 + 8 * fq;
#pragma unroll
        for (int ai = 0; ai < 2; ++ai)
#pragma unroll
            for (int m = 0; m < 4; ++m) { const int row = row0 + ai * 128 + m * 16; const float rs = __builtin_amdgcn_rsqf(ssq[row] * (1.0f / D) + EPS);
                bf16* rowp = Z + (size_t)row * NZ + col0;
#pragma unroll
                for (int bj = 0; bj < 2; ++bj) { const f32x4 v0 = acc[ai][bj][m][0] * rs, v1 = acc[ai][bj][m][1] * rs;
                    u32x4 w; w.x = pk2(v0[0], v0[1]); w.y = pk2(v0[2], v0[3]); w.z = pk2(v1[0], v1[1]); w.w = pk2(v1[2], v1[3]);
                    if (u.pn >= 2 && u.pn <= 5) { const int hc = col0 + bj * 128 - 512, kv = hc >> 9, head = (hc >> 6) & 7, d = hc & 63;
                        *(u32x4*)(KV + (size_t)kv * ((size_t)NB * 8 * SEQ * 64) + ((size_t)((row >> 12) * 8 + head) * SEQ + (row & (SEQ - 1))) * 64 + d) = w; }
                    else *(u32x4*)(rowp + bj * 128) = w;
                    if (u.pn == 14 && bj == 0 && col0 == ZG) { *(f32x4*)(gate + (size_t)row * 8) = v0; *(f32x4*)(gate + (size_t)row * 8 + 4) = v1; } } }
    }
};
struct EpiAct {
    static constexpr bool PERM = true;
    bf16* O; const float* ssq;
    DI void operator()(const f32x4 (&acc)[2][2][4][2], const pg8::Unit& u, int wr, int wc, int fr, int fq) const {
        const int row0 = u.pm * 256 + wr * 64 + fr, col0 = u.pn * 256 + wc * 32 + 8 * fq;
#pragma unroll
        for (int ai = 0; ai < 2; ++ai)
#pragma unroll
            for (int m = 0; m < 4; ++m) { const int row = row0 + ai * 128 + m * 16; const float rs = __builtin_amdgcn_rsqf(ssq[row] * (1.0f / D) + EPS);
                bf16* rowp = O + (size_t)row * FF + col0;
#pragma unroll
                for (int bj = 0; bj < 2; ++bj) { f32x4 v0 = acc[ai][bj][m][0] * rs, v1 = acc[ai][bj][m][1] * rs;
#pragma unroll
                    for (int j = 0; j < 4; ++j) { const float a = fmaxf(v0[j], 0.f), b = fmaxf(v1[j], 0.f); v0[j] = a * a; v1[j] = b * b; }
                    u32x4 w; w.x = pk2(v0[0], v0[1]); w.y = pk2(v0[2], v0[3]); w.z = pk2(v1[0], v1[1]); w.w = pk2(v1[2], v1[3]);
                    *(u32x4*)(rowp + bj * 128) = w; } }
    }
};
struct EpiRes {
    static constexpr bool PERM = true;
    bf16* HB; float* ssq;
    DI void operator()(const f32x4 (&acc)[2][2][4][2], const pg8::Unit& u, int wr, int wc, int fr, int fq) const {
        const int row0 = u.pm * 256 + wr * 64 + fr, col0 = u.pn * 256 + wc * 32 + 8 * fq;
#pragma unroll
        for (int ai = 0; ai < 2; ++ai)
#pragma unroll
            for (int m = 0; m < 4; ++m) { const int row = row0 + ai * 128 + m * 16; bf16* bp = HB + (size_t)row * D + col0; float s = 0.f;
#pragma unroll
                for (int bj = 0; bj < 2; ++bj) { const u32x4 hw = *(const u32x4*)(bp + bj * 128); const f32x4 a0 = acc[ai][bj][m][0], a1 = acc[ai][bj][m][1];
                    const float x0 = lo16(hw.x) + a0[0], x1 = hi16(hw.x) + a0[1], x2 = lo16(hw.y) + a0[2], x3 = hi16(hw.y) + a0[3];
                    const float x4 = lo16(hw.z) + a1[0], x5 = hi16(hw.z) + a1[1], x6 = lo16(hw.w) + a1[2], x7 = hi16(hw.w) + a1[3];
                    u32x4 w; w.x = pk2(x0, x1); w.y = pk2(x2, x3); w.z = pk2(x4, x5); w.w = pk2(x6, x7); *(u32x4*)(bp + bj * 128) = w;
                    s += ((x0 * x0 + x1 * x1) + (x2 * x2 + x3 * x3)) + ((x4 * x4 + x5 * x5) + (x6 * x6 + x7 * x7)); }
                s += __shfl_xor(s, 16); s += __shfl_xor(s, 32);
                if (fq == 0) atomicAdd(ssq + row, s); }
    }
};

DI void transpose_item(const float* __restrict__ W, int Nsrc, int src_c0, int nvalid, const float* __restrict__ gs, bf16* __restrict__ WT, int K, int dst_row0, int k0, LAS float* scr, int lane) {
    const int n4 = 4 * (lane & 15);
    f32x4 v[16];
#pragma unroll
    for (int i = 0; i < 16; ++i) { const int kk = 4 * i + (lane >> 4);
        v[i] = (n4 < nvalid) ? *(const f32x4*)(W + (size_t)(k0 + kk) * Nsrc + src_c0 + n4) : (f32x4){0.f, 0.f, 0.f, 0.f}; }
#pragma unroll
    for (int i = 0; i < 16; ++i) { const int kk = 4 * i + (lane >> 4); const float g = gs ? gs[k0 + kk] : 1.0f;
        scr[kk * 65 + n4] = v[i].x * g; scr[kk * 65 + n4 + 1] = v[i].y * g; scr[kk * 65 + n4 + 2] = v[i].z * g; scr[kk * 65 + n4 + 3] = v[i].w * g; }
    asm volatile("s_waitcnt lgkmcnt(0)" ::: "memory");
    const int c = lane & 7;
#pragma unroll
    for (int j = 0; j < 8; ++j) { const int n = (lane >> 3) + 8 * j; const LAS float* s = scr + (8 * c) * 65 + n;
        u32x4 o; o.x = pk2(s[0 * 65], s[1 * 65]); o.y = pk2(s[2 * 65], s[3 * 65]); o.z = pk2(s[4 * 65], s[5 * 65]); o.w = pk2(s[6 * 65], s[7 * 65]);
        *(u32x4*)(WT + (size_t)(dst_row0 + n) * K + k0 + 8 * c) = o; }
    asm volatile("s_waitcnt lgkmcnt(0)" ::: "memory");
}
DI void convert_weights(const Ctx& C, int l) {
    const Params& P = *C.P; const int lane = C.lane;
    LAS float* scr = (LAS float*)C.wl;
    constexpr int I_IN = 16 * (NZ / 64), I_OUT = 16 * (D / 64), I_UP = 16 * (FF / 64), I_DN = 64 * (D / 64), I_L = I_IN + I_OUT + I_UP + I_DN;
    for (int it = C.gw; it < I_L; it += C.NGW) {
        int r = it;
        if (r < I_IN) { const int nb = r % (NZ / 64), kb = r / (NZ / 64), n0 = nb * 64;
            int c0, nv;
            if (n0 < 2560) { c0 = n0; nv = 64; } else if (n0 < ZG) { c0 = n0 + 8; nv = 64; } else if (n0 == ZG) { c0 = 2560; nv = 8; } else { c0 = 0; nv = 0; }
            transpose_item(P.in[11] + (size_t)l * D * 3592, 3592, c0, nv, P.in[10] + l * D, (bf16*)(C.ws + WS_WIN) + (size_t)l * NZ * D, D, n0, kb * 64, scr, lane); continue; }
        r -= I_IN;
        if (r < I_OUT) { const int nb = r % (D / 64), kb = r / (D / 64);
            transpose_item(P.in[17] + (size_t)l * D * D, D, nb * 64, 64, nullptr, (bf16*)(C.ws + WS_WOUT) + (size_t)l * D * D, D, nb * 64, kb * 64, scr, lane); continue; }
        r -= I_OUT;
        if (r < I_UP) { const int nb = r % (FF / 64), kb = r / (FF / 64);
            transpose_item(P.in[19] + (size_t)l * D * FF, FF, nb * 64, 64, P.in[18] + l * D, (bf16*)(C.ws + WS_WUP) + (size_t)l * FF * D, D, nb * 64, kb * 64, scr, lane); continue; }
        r -= I_UP;
        { const int nb = r % (D / 64), kb = r / (D / 64);
            transpose_item(P.in[20] + (size_t)l * FF * D, D, nb * 64, 64, nullptr, (bf16*)(C.ws + WS_WDN) + (size_t)l * D * FF, FF, nb * 64, kb * 64, scr, lane); }
    }
}
DI void ph_prologue(const Ctx& C) {
    const Params& P = *C.P; const int lane = C.lane;
    convert_weights(C, 0);
    bf16* HB = (bf16*)(C.ws + WS_HB); float* SSQ = (float*)(C.ws + WS_SSQ);
#pragma unroll 2
    for (int m = C.gw; m < MPAD; m += C.NGW) {
        f32x4 v[4]; float s = 0.f;
        if (m < MT) { const float* xr = (m < MP) ? P.in[0] + (size_t)m * D : P.in[1] + (size_t)(m - MP) * D;
#pragma unroll
            for (int j = 0; j < 4; ++j) { v[j] = *(const f32x4*)(xr + 4 * lane + 256 * j); s += (v[j].x * v[j].x + v[j].y * v[j].y) + (v[j].z * v[j].z + v[j].w * v[j].w); }
        } else {
#pragma unroll
            for (int j = 0; j < 4; ++j) v[j] = (f32x4){0.f, 0.f, 0.f, 0.f}; }
        s = wave_sum(s);
#pragma unroll
        for (int j = 0; j < 4; ++j) { u32x2 w; w.x = pk2(v[j].x, v[j].y); w.y = pk2(v[j].z, v[j].w); *(u32x2*)(HB + (size_t)m * D + 4 * lane + 256 * j) = w; }
        if (lane == 0) SSQ[m] = s;
    }
    for (int i = C.gw * 64 + lane; i < 4 * MPAD; i += C.NGW * 64) SSQ[MPAD + i] = 0.f;
    float* BT = (float*)(C.ws + WS_BIAST);
    for (int i = C.gw * 64 + lane; i < 3 * 8 * 132; i += C.NGW * 64) { const int br = i / (8 * 132), h = (i / 132) % 8, j = i % 132; BT[i] = (j <= 128) ? P.in[9][(int)P.bucket[br][j] * 8 + h] : 0.f; }
    float* LBV = (float*)(C.ws + WS_LBV);
    for (int i = C.gw * 64 + lane; i < 512; i += C.NGW * 64) { const int c = i & 255; LBV[i] = (i < 256) ? 0.f : sigm(P.in[15][256 + c] - P.in[15][c]); }
}

template <int br> DI void attn_unit(const Ctx& C, int l, int u) {
    const int lane = C.lane, t = lane & 31, hh = lane >> 5;
    constexpr int dil = br == 0 ? 1 : (br == 1 ? 4 : 16), npair = 64 / dil;
    const int bh = u >> 6, rem = u & 63, r = rem / npair, p = rem % npair, b = bh >> 3, h = bh & 7, i0 = p * 64;
    const bf16* zb = (const bf16*)(C.ws + WS_Z) + (size_t)(b * SEQ) * NZ;
    const float* BT = (const float*)(C.ws + WS_BIAST) + (br * 8 + h) * 132;
    LAS float* btl = (LAS float*)(C.wl + 64 * VSTR);
    bf16x8 qf[2][4];
#pragma unroll
    for (int qb = 0; qb < 2; ++qb)
#pragma unroll
        for (int s = 0; s < 4; ++s) qf[qb][s] = ldg8(zb + (size_t)((i0 + 32 * qb + t) * dil + r) * NZ + ZQ + h * 64 + 16 * s + 8 * hh);
    btl[128 - lane] = BT[lane] * LOG2E; btl[64 - lane] = BT[lane + 64] * LOG2E; if (lane == 0) btl[0] = BT[128] * LOG2E;
    const int kt0 = p < 2 ? 4 - 2 * p : 0;
    const ptrdiff_t tile_step = (ptrdiff_t)32 * dil * 64;
    const bf16* kb_ = (const bf16*)(C.ws + WS_KC) + (size_t)(b * 8 + h) * SEQ * 64; const bf16* vb_ = (const bf16*)(C.ws + WS_VC) + (size_t)(b * 8 + h) * SEQ * 64;
    const bf16* kp = kb_ + ((ptrdiff_t)(i0 - 128 + (lane >> 3)) * dil + r) * 64 + 8 * (lane & 7) + kt0 * tile_step;
    const bf16* vp = vb_ + ((ptrdiff_t)(i0 - 128 + (lane >> 3)) * dil + r) * 64 + 8 * (lane & 7) + kt0 * tile_step;
    f32x16 O[2][2]; O[0][0] = zero16(); O[0][1] = zero16(); O[1][0] = zero16(); O[1][1] = zero16();
    float mx[2] = {-1e30f, -1e30f}, lsum[2] = {0.f, 0.f};
    bf16x8 kf[4], vf[4];
#pragma unroll
    for (int s = 0; s < 4; ++s) { kf[s] = ldg8(kp + (ptrdiff_t)(8 * s) * dil * 64); vf[s] = ldg8(vp + (ptrdiff_t)(8 * s) * dil * 64); }
    LAS unsigned char* ktile = C.wl + 68 * VSTR + 64;
    constexpr float SC = 0.125f * LOG2E;
#pragma unroll 1
    for (int kt = kt0; kt < 6; ++kt) {
        f32x16 S[2];
#pragma unroll
        for (int i = 0; i < 4; ++i) *(LAS bf16x8*)(ktile + ((lane >> 3) + 8 * i) * VSTR + (lane & 7) * 16) = kf[i];
        { bf16x8 ka[4];
#pragma unroll
          for (int s = 0; s < 4; ++s) ka[s] = *(LAS const bf16x8*)(ktile + t * VSTR + 32 * s + 16 * hh);
#pragma unroll
          for (int qb = 0; qb < 2; ++qb) { S[qb] = zero16();
#pragma unroll
            for (int s = 0; s < 4; ++s) S[qb] = MFMA32(ka[s], qf[qb][s], S[qb]); } }
        LAS unsigned char* vt = C.wl + (kt & 1) * (32 * VSTR);
#pragma unroll
        for (int i = 0; i < 4; ++i) *(LAS bf16x8*)(vt + ((lane >> 3) + 8 * i) * VSTR + (lane & 7) * 16) = vf[i];
        if (kt < 5) { kp += tile_step; vp += tile_step;
#pragma unroll
            for (int s = 0; s < 4; ++s) { kf[s] = ldg8(kp + (ptrdiff_t)(8 * s) * dil * 64); vf[s] = ldg8(vp + (ptrdiff_t)(8 * s) * dil * 64); } }
#pragma unroll
        for (int qb = 0; qb < 2; ++qb) { const int rel = kt - qb;
            if (rel >= 0 && rel <= 4) {
                float tm = -1e30f;
                const int ib = 32 * rel - t + 4 * hh;
                if (rel == 0 || rel == 4) {
#pragma unroll
                    for (int reg = 0; reg < 16; ++reg) { const int i = ib + (reg & 3) + 8 * (reg >> 2); const bool ok = (i >= 0) && (i <= 128);
                        const float sc = ok ? S[qb][reg] * SC + btl[ok ? i : 0] : -1e30f; S[qb][reg] = sc; tm = fmaxf(tm, sc); }
                } else {
                    const LAS float* bp = btl + ib;
#pragma unroll
                    for (int reg = 0; reg < 16; ++reg) { const float sc = S[qb][reg] * SC + bp[(reg & 3) + 8 * (reg >> 2)]; S[qb][reg] = sc; tm = fmaxf(tm, sc); }
                }
                tm = fmaxf(tm, __shfl_xor(tm, 32));
                const float mn = fmaxf(mx[qb], tm), alpha = __builtin_amdgcn_exp2f(mx[qb] - mn); mx[qb] = mn;
                float ps = 0.f;
#pragma unroll
                for (int reg = 0; reg < 16; ++reg) { const float pe = __builtin_amdgcn_exp2f(S[qb][reg] - mn); S[qb][reg] = pe; ps += pe; }
                lsum[qb] = lsum[qb] * alpha + ps;
#pragma unroll
                for (int reg = 0; reg < 16; ++reg) { O[qb][0][reg] *= alpha; O[qb][1][reg] *= alpha; }
#pragma unroll
                for (int ks = 0; ks < 2; ++ks) { const bf16x8 pf = pack8(S[qb], ks);
#pragma unroll
                    for (int db = 0; db < 2; ++db) O[qb][db] = MFMA32(tr_frag<true>(vt, 16 * ks, 32 * db, lane), pf, O[qb][db]); }
            } }
    }
    LAS unsigned char* T0 = C.wl; LAS unsigned char* T1 = C.wl + 32 * VSTR; LAS unsigned char* T2 = ktile;
#pragma unroll
    for (int qb = 0; qb < 2; ++qb) {
        const size_t rowr = (size_t)b * SEQ + (size_t)(i0 + 32 * qb + (lane >> 3)) * dil + r;
        float ls = lsum[qb]; ls += __shfl_xor(ls, 32);
        const float inv = 1.0f / ls, lse = (mx[qb] + __builtin_amdgcn_logf(ls)) * 0.6931471805599453f;
        const size_t row = (size_t)b * SEQ + (i0 + 32 * qb + t) * dil + r;
        if (br != 0) {
#pragma unroll
            for (int db = 0; db < 2; ++db)
#pragma unroll
                for (int g = 0; g < 4; ++g) { u32x2 w; w.x = pk2(O[qb][db][4 * g] * inv, O[qb][db][4 * g + 1] * inv); w.y = pk2(O[qb][db][4 * g + 2] * inv, O[qb][db][4 * g + 3] * inv);
                    *(LAS u32x2*)(T2 + t * VSTR + (32 * db + 8 * g + 4 * hh) * 2) = w; }
            bf16* po = (bf16*)(C.ws + WS_PO) + (size_t)(br - 1) * MP * 512 + h * 64 + 8 * (lane & 7);
#pragma unroll
            for (int i = 0; i < 4; ++i) *(u32x4*)(po + (rowr + (size_t)(8 * i) * dil) * 512) = *(LAS const u32x4*)(T2 + ((lane >> 3) + 8 * i) * VSTR + (lane & 7) * 16);
            if (hh == 0) ((float*)(C.ws + WS_PLSE))[(size_t)(br - 1) * MP * 8 + row * 8 + h] = lse;
        } else {
            const float l1 = ((const float*)(C.ws + WS_PLSE))[row * 8 + h], l2 = ((const float*)(C.ws + WS_PLSE))[(size_t)MP * 8 + row * 8 + h];
            const bf16* p1 = (const bf16*)(C.ws + WS_PO) + h * 64 + 8 * (lane & 7);
#pragma unroll
            for (int i = 0; i < 4; ++i) { const size_t ro = (rowr + (size_t)(8 * i) * dil) * 512;
                *(LAS u32x4*)(T0 + ((lane >> 3) + 8 * i) * VSTR + (lane & 7) * 16) = *(const u32x4*)(p1 + ro);
                *(LAS u32x4*)(T1 + ((lane >> 3) + 8 * i) * VSTR + (lane & 7) * 16) = *(const u32x4*)(p1 + (size_t)MP * 512 + ro); }
            const float M = fmaxf(lse, fmaxf(l1, l2)), w0 = fexp(lse - M), w1 = fexp(l1 - M), w2 = fexp(l2 - M), iw = 1.0f / (w0 + w1 + w2);
            const float c0 = w0 * iw * inv, c1 = w1 * iw, c2 = w2 * iw;
#pragma unroll
            for (int db = 0; db < 2; ++db)
#pragma unroll
                for (int g = 0; g < 4; ++g) { const int d0 = 32 * db + 8 * g + 4 * hh; const u32x2 a = *(LAS const u32x2*)(T0 + t * VSTR + d0 * 2), bq = *(LAS const u32x2*)(T1 + t * VSTR + d0 * 2);
                    const float y0 = c0 * O[qb][db][4 * g] + c1 * lo16(a.x) + c2 * lo16(bq.x), y1 = c0 * O[qb][db][4 * g + 1] + c1 * hi16(a.x) + c2 * hi16(bq.x);
                    const float y2 = c0 * O[qb][db][4 * g + 2] + c1 * lo16(a.y) + c2 * lo16(bq.y), y3 = c0 * O[qb][db][4 * g + 3] + c1 * hi16(a.y) + c2 * hi16(bq.y);
                    u32x2 w; w.x = pk2(y0, y1); w.y = pk2(y2, y3); *(LAS u32x2*)(T2 + t * VSTR + d0 * 2) = w; }
            bf16* mxo = (bf16*)(C.ws + WS_MIX) + h * 64 + 8 * (lane & 7);
#pragma unroll
            for (int i = 0; i < 4; ++i) *(u32x4*)(mxo + (rowr + (size_t)(8 * i) * dil) * D) = *(LAS const u32x4*)(T2 + ((lane >> 3) + 8 * i) * VSTR + (lane & 7) * 16);
        }
    }
}

DI void attn_sample_item(const Ctx& C, int l, int it) {
    const Params& P = *C.P; const int lane = C.lane, g = lane >> 4, i = lane & 15;
    const int br = it % 3, bth = it / 3, b = bth >> 5, t = (bth >> 3) & 3, h = bth & 7, srow = MP + b * 4 + t, dil = br == 0 ? 1 : (br == 1 ? 4 : 16);
    const bf16* z = (const bf16*)(C.ws + WS_Z);
    const float* BT = (const float*)(C.ws + WS_BIAST) + (br * 8 + h) * 132;
    const u32x2 qw = *(const u32x2*)(z + (size_t)srow * NZ + ZQ + h * 64 + 4 * i);
    constexpr float SC = 0.125f * LOG2E;
    const float q0 = lo16(qw.x) * SC, q1 = hi16(qw.x) * SC, q2 = lo16(qw.y) * SC, q3 = hi16(qw.y) * SC;
    const float* ck = P.in[2] + ((size_t)(l * SB + b) * WB) * 512 + h * 64 + 4 * i;
    const float* cv = P.in[3] + ((size_t)(l * SB + b) * WB) * 512 + h * 64 + 4 * i;
    const bf16* zn = z + (size_t)(MP + b * 4) * NZ + h * 64 + 4 * i;
    float mx = -1e30f, ls = 0.f; f32x4 acc = (f32x4){0.f, 0.f, 0.f, 0.f};
#pragma unroll 1
    for (int j0 = 0; j0 < 129; j0 += 68) {
        f32x4 kk[17], vv[17]; float sc[17];
#pragma unroll
        for (int u = 0; u < 17; ++u) { int j = j0 + 4 * u + g; j = j > 128 ? 128 : j; const int idx = WB + t - dil * j;
            const size_t off = (size_t)(idx < WB ? idx : WB - 1) * 512; kk[u] = *(const f32x4*)(ck + off); vv[u] = *(const f32x4*)(cv + off); }
        float tm = -1e30f;
#pragma unroll
        for (int u = 0; u < 17; ++u) { const int j = j0 + 4 * u + g, jc = j > 128 ? 128 : j, idx = WB + t - dil * jc;
            if (idx >= WB) { const u32x2 w = *(const u32x2*)(zn + (size_t)(idx - WB) * NZ + ZK), w2 = *(const u32x2*)(zn + (size_t)(idx - WB) * NZ + ZV);
                kk[u] = (f32x4){lo16(w.x), hi16(w.x), lo16(w.y), hi16(w.y)}; vv[u] = (f32x4){lo16(w2.x), hi16(w2.x), lo16(w2.y), hi16(w2.y)}; }
            float s = q0 * kk[u].x + q1 * kk[u].y + q2 * kk[u].z + q3 * kk[u].w;
            s += __shfl_xor(s, 1); s += __shfl_xor(s, 2); s += __shfl_xor(s, 4); s += __shfl_xor(s, 8);
            s = (j <= 128) ? s + BT[jc] * LOG2E : -1e30f; sc[u] = s; tm = fmaxf(tm, s); }
        tm = fmaxf(tm, __shfl_xor(tm, 16)); tm = fmaxf(tm, __shfl_xor(tm, 32));
        const float mn = fmaxf(mx, tm), alpha = __builtin_amdgcn_exp2f(mx - mn); mx = mn;
        ls *= alpha; acc *= alpha;
#pragma unroll
        for (int u = 0; u < 17; ++u) { const float p = __builtin_amdgcn_exp2f(sc[u] - mn); ls += p; acc += vv[u] * p; }
    }
    ls += __shfl_xor(ls, 16); ls += __shfl_xor(ls, 32);
#pragma unroll
    for (int c = 0; c < 4; ++c) { acc[c] += __shfl_xor(acc[c], 16); acc[c] += __shfl_xor(acc[c], 32); }
    float* sp = (float*)(C.ws + WS_SAP) + (size_t)it * 68;
    if (g == 0) { const float inv = 1.0f / ls; *(f32x4*)(sp + 4 * i) = acc * inv; if (i == 0) sp[64] = (mx + __builtin_amdgcn_logf(ls)) * 0.6931471805599453f; }
}
DI void attn_sample_combine(const Ctx& C, int it) {
    const int lane = C.lane, bth = it * 4 + (lane >> 4), i = lane & 15, b = bth >> 5, t = (bth >> 3) & 3, h = bth & 7;
    const float* sp = (const float*)(C.ws + WS_SAP) + (size_t)bth * 3 * 68;
    const float l0 = sp[64], l1 = sp[68 + 64], l2 = sp[136 + 64], M = fmaxf(l0, fmaxf(l1, l2)), w0 = fexp(l0 - M), w1 = fexp(l1 - M), w2 = fexp(l2 - M), iw = 1.0f / (w0 + w1 + w2);
    const f32x4 o = (*(const f32x4*)(sp + 4 * i) * w0 + *(const f32x4*)(sp + 68 + 4 * i) * w1 + *(const f32x4*)(sp + 136 + 4 * i) * w2) * iw;
    u32x2 w; w.x = pk2(o.x, o.y); w.y = pk2(o.z, o.w);
    *(u32x2*)((bf16*)(C.ws + WS_MIX) + (size_t)(MP + b * 4 + t) * D + h * 64 + 4 * i) = w;
}

DI float rdlane(float x, int l) { return __builtin_bit_cast(float, __builtin_amdgcn_readlane(__builtin_bit_cast(int, x), l)); }
DI float scan_add(float x, int lane) {
#pragma unroll
    for (int o = 1; o < 64; o <<= 1) { const float v = __shfl_up(x, o); if (lane >= o) x += v; }
    return x; }
DI float scan_max(float x, int lane) {
#pragma unroll
    for (int o = 1; o < 64; o <<= 1) { const float v = __shfl_up(x, o); if (lane >= o) x = fmaxf(x, v); }
    return x; }

DI void conv8(const bf16* zcol, int ts, const float* w, float scale, float (&y)[8]) {
#pragma unroll
    for (int e = 0; e < 8; ++e) y[e] = 0.f;
#pragma unroll
    for (int j = 0; j < 4; ++j) { const int tj = ts - 3 + j;
        if (tj >= 0) { const bf16x8 x = ldg8(zcol + (ptrdiff_t)(j - 3) * NZ); const f32x4 w0 = *(const f32x4*)(w + j * 512), w1 = *(const f32x4*)(w + j * 512 + 4);
            const u32x4 xw = __builtin_bit_cast(u32x4, x);
            y[0] += w0.x * lo16(xw.x); y[1] += w0.y * hi16(xw.x); y[2] += w0.z * lo16(xw.y); y[3] += w0.w * hi16(xw.y);
            y[4] += w1.x * lo16(xw.z); y[5] += w1.y * hi16(xw.z); y[6] += w1.z * lo16(xw.w); y[7] += w1.w * hi16(xw.w); } }
#pragma unroll
    for (int e = 0; e < 8; ++e) y[e] = silu(y[e]) * scale;
}

DI void conv_win(const bf16* zcol  , int ts0  , const float* w, float scale, u32x4 (&out)[8]) {
    u32x4 x[11];
#pragma unroll
    for (int j = 0; j < 11; ++j) { x[j] = (ts0 - 3 + j >= 0) ? __builtin_bit_cast(u32x4, ldg8(zcol + (ptrdiff_t)(j - 3) * NZ)) : (u32x4){0u, 0u, 0u, 0u}; }
    f32x4 w0[4], w1[4];
#pragma unroll
    for (int j = 0; j < 4; ++j) { w0[j] = *(const f32x4*)(w + j * 512); w1[j] = *(const f32x4*)(w + j * 512 + 4); }
#pragma unroll
    for (int tk = 0; tk < 8; ++tk) { float y[8];
#pragma unroll
        for (int e = 0; e < 8; ++e) y[e] = 0.f;
#pragma unroll
        for (int j = 0; j < 4; ++j) { const u32x4 xw = x[tk + j];
            y[0] += w0[j].x * lo16(xw.x); y[1] += w0[j].y * hi16(xw.x); y[2] += w0[j].z * lo16(xw.y); y[3] += w0[j].w * hi16(xw.y);
            y[4] += w1[j].x * lo16(xw.z); y[5] += w1[j].y * hi16(xw.z); y[6] += w1[j].z * lo16(xw.w); y[7] += w1[j].w * hi16(xw.w); }
#pragma unroll
        for (int e = 0; e < 8; ++e) y[e] = silu(y[e]) * scale;
        out[tk].x = pk2(y[0], y[1]); out[tk].y = pk2(y[2], y[3]); out[tk].z = pk2(y[4], y[5]); out[tk].w = pk2(y[6], y[7]); }
}
DI void mlstm_m1_item(const Ctx& C, int l, int it) {
    const Params& P = *C.P; const int lane = C.lane, hh = lane >> 5, g8 = lane >> 3, cgp = lane & 7;
    const int bh = it >> 6, c = it & 63, b = bh >> 2, h = bh & 3, row0 = b * SEQ + c * 64;
    const bf16* z = (const bf16*)(C.ws + WS_Z);
    const float* gate = (const float*)(C.ws + WS_GATE);
    LAS unsigned char* kt_ = C.wl; LAS unsigned char* vt_ = C.wl + 64 * VSTR;
    const float ig = gate[(size_t)(row0 + lane) * 8 + h] + P.in[12][l * 8 + h];
    const float lf = logsig(gate[(size_t)(row0 + lane) * 8 + 4 + h] + P.in[12][l * 8 + 4 + h]);
    const int ch = h * 64 + 8 * cgp, tl0 = 8 * g8;
    const float* cw = P.in[13] + (size_t)l * 4 * 512;
    bf16* QC = (bf16*)(C.ws + WS_MLQC); bf16* KC = (bf16*)(C.ws + WS_MLKC);
    u32x4 vraw[8];
#pragma unroll
    for (int tk = 0; tk < 8; ++tk) vraw[tk] = __builtin_bit_cast(u32x4, ldg8(z + (size_t)(row0 + tl0 + tk) * NZ + ZMV + ch));
    u32x4 kc[8];
    conv_win(z + (size_t)(row0 + tl0) * NZ + ZMK + ch, c * 64 + tl0, cw + 256 + ch, 0.125f, kc);
#pragma unroll
    for (int tk = 0; tk < 8; ++tk) { *(u32x4*)(KC + (size_t)(row0 + tl0 + tk) * 256 + ch) = kc[tk]; *(LAS u32x4*)(kt_ + (tl0 + tk) * VSTR + cgp * 16) = kc[tk]; }
    const float bc = scan_add(lf, lane), bL = __shfl(bc, 63), uu = ig - bc, umax = wave_max(uu);
    const float dpr = fexp(uu - umax);
    ((float*)(C.ws + WS_MLB))[bh * SEQ + c * 64 + lane] = bc; ((float*)(C.ws + WS_MLU))[bh * SEQ + c * 64 + lane] = uu;
    if (lane == 0) { ((float*)(C.ws + WS_MLA))[bh * 64 + c] = bL + umax; ((float*)(C.ws + WS_MLBL))[bh * 64 + c] = bL; }
#pragma unroll
    for (int tk = 0; tk < 8; ++tk) { const float dp = __shfl(dpr, tl0 + tk); const u32x4 vw = vraw[tk];
        u32x4 vo; vo.x = pk2(lo16(vw.x) * dp, hi16(vw.x) * dp); vo.y = pk2(lo16(vw.y) * dp, hi16(vw.y) * dp); vo.z = pk2(lo16(vw.z) * dp, hi16(vw.z) * dp); vo.w = pk2(lo16(vw.w) * dp, hi16(vw.w) * dp);
        *(LAS u32x4*)(vt_ + (tl0 + tk) * VSTR + cgp * 16) = vo; }
    { u32x4 qc[8];
      conv_win(z + (size_t)(row0 + tl0) * NZ + ZMQ + ch, c * 64 + tl0, cw + ch, 1.0f, qc);
#pragma unroll
      for (int tk = 0; tk < 8; ++tk) *(u32x4*)(QC + (size_t)(row0 + tl0 + tk) * 256 + ch) = qc[tk]; }
    f32x16 acc[2][2]; acc[0][0] = zero16(); acc[0][1] = zero16(); acc[1][0] = zero16(); acc[1][1] = zero16();
#pragma unroll
    for (int ks = 0; ks < 4; ++ks) { bf16x8 A[2], B[2];
#pragma unroll
        for (int x = 0; x < 2; ++x) { A[x] = tr_frag<false>(vt_, 16 * ks, 32 * x, lane); B[x] = tr_frag<false>(kt_, 16 * ks, 32 * x, lane); }
#pragma unroll
        for (int fb = 0; fb < 2; ++fb)
#pragma unroll
            for (int eb = 0; eb < 2; ++eb) acc[fb][eb] = MFMA32(A[fb], B[eb], acc[fb][eb]); }
    float kn = 0.f;
#pragma unroll 8
    for (int s = 0; s < 64; ++s) kn += rdlane(dpr, s) * bf2f(*(LAS const bf16*)(kt_ + s * VSTR + lane * 2));
    float* KVT = (float*)(C.ws + WS_MLKVT) + (size_t)(bh * 64 + c) * 4096;
#pragma unroll
    for (int fb = 0; fb < 2; ++fb)
#pragma unroll
        for (int eb = 0; eb < 2; ++eb)
#pragma unroll
            for (int reg = 0; reg < 16; ++reg) KVT[(32 * fb + crow(reg, hh)) * 64 + 32 * eb + (lane & 31)] = acc[fb][eb][reg];
    ((float*)(C.ws + WS_MLKN))[(size_t)(bh * 64 + c) * 64 + lane] = kn;
}

DI void mlstm_m2_item(const Ctx& C, int l, int it) {
    const int lane = C.lane, bh = it < 1024 ? it >> 6 : it - 1024, f = it < 1024 ? it & 63 : 64, b = bh >> 2, h = bh & 3;
    const float* __restrict__ MA = (const float*)(C.ws + WS_MLA) + bh * 64; const float* __restrict__ MBL = (const float*)(C.ws + WS_MLBL) + bh * 64;
    const float* __restrict__ KVT = (const float*)(C.ws + WS_MLKVT) + (size_t)bh * 64 * 4096 + f * 64 + lane;
    const float* __restrict__ KN = (const float*)(C.ws + WS_MLKN) + (size_t)bh * 64 * 64 + lane;
    bf16* __restrict__ CT = (bf16*)(C.ws + WS_MLCT) + (size_t)bh * 64 * 4096 + f * 64 + lane;
    float* __restrict__ NC = (float*)(C.ws + WS_MLNC) + (size_t)bh * 64 * 64 + lane;
    float* __restrict__ MC = (float*)(C.ws + WS_MLMC) + bh * 64;
    const float a_l = MA[lane], bL_l = MBL[lane];
    if (f >= 64) {
        float knv[64];
#pragma unroll
        for (int c = 0; c < 64; ++c) knv[c] = KN[c * 64];
        float m = 0.f, nv = 0.f, ms = 0.f;
#pragma unroll
        for (int c = 0; c < 64; ++c) { const float a = rdlane(a_l, c), bL = rdlane(bL_l, c), mn = fmaxf(bL + m, a), gL = fexp(bL + m - mn), sc = fexp(a - mn);
            NC[c * 64] = nv; nv = gL * nv + sc * knv[c]; if (lane == c) ms = m; m = mn; }
        MC[lane] = ms;
        C.out[O_PN + (size_t)((l * NB + b) * 4 + h) * 64 + lane] = nv; if (lane == 0) C.out[O_PM + (l * NB + b) * 4 + h] = m;
        return; }
    float kv[64];
#pragma unroll
    for (int c = 0; c < 64; ++c) kv[c] = KVT[(size_t)c * 4096];
    float m = 0.f, Cv = 0.f;
#pragma unroll
    for (int c = 0; c < 64; ++c) {
        const float a = rdlane(a_l, c), bL = rdlane(bL_l, c), mn = fmaxf(bL + m, a), gL = fexp(bL + m - mn), sc = fexp(a - mn);
        CT[(size_t)c * 4096] = f2bf(Cv);
        Cv = gL * Cv + sc * kv[c];
        m = mn;
    }
    C.out[O_PC + ((size_t)((l * NB + b) * 4 + h) * 64 + lane) * 64 + f] = Cv;
}

DI void mlstm_m3_item(const Ctx& C, int l, int it) {
    const Params& P = *C.P; const int lane = C.lane, t = lane & 31, hh = lane >> 5;
    const int half = it & 1, c = (it >> 1) & 63, bh = it >> 7, b = bh >> 2, h = bh & 3, row0 = b * SEQ + c * 64, tok = 32 * half + t, row = row0 + tok;
    const bf16* z = (const bf16*)(C.ws + WS_Z);
    const bf16* QC = (const bf16*)(C.ws + WS_MLQC); const bf16* KC = (const bf16*)(C.ws + WS_MLKC);
    LAS float* us = (LAS float*)(C.wl + 64 * VSTR);
    bf16x8 qf[4], kf[2][4], vr[2][4];
#pragma unroll
    for (int s = 0; s < 4; ++s) qf[s] = ldg8(QC + (size_t)row * 256 + h * 64 + 16 * s + 8 * hh);
    const float u_l = ((const float*)(C.ws + WS_MLU))[bh * SEQ + c * 64 + lane], b_l = ((const float*)(C.ws + WS_MLB))[bh * SEQ + c * 64 + lane];
    const float m_c = ((const float*)(C.ws + WS_MLMC))[bh * 64 + c];
#pragma unroll
    for (int kt = 0; kt < 2; ++kt) if (kt <= half) {
#pragma unroll
        for (int s = 0; s < 4; ++s) { kf[kt][s] = ldg8(KC + (size_t)(row0 + 32 * kt + t) * 256 + h * 64 + 8 * hh + 16 * s);
            vr[kt][s] = ldg8(z + (size_t)(row0 + 32 * kt + (lane >> 3) + 8 * s) * NZ + ZMV + h * 64 + 8 * (lane & 7)); } }
    const float cm = scan_max(u_l, lane), mt_l = b_l + fmaxf(m_c, cm);
    us[lane] = u_l;
    const float b_t = __shfl(b_l, tok), mt_t = __shfl(mt_l, tok), g_t = fexp(b_t + m_c - mt_t);
    f32x16 S[2]; S[0] = zero16(); S[1] = zero16();
#pragma unroll
    for (int kt = 0; kt < 2; ++kt) if (kt <= half) {
#pragma unroll
        for (int s = 0; s < 4; ++s) S[kt] = MFMA32(kf[kt][s], qf[s], S[kt]);
#pragma unroll
        for (int i = 0; i < 4; ++i) *(LAS bf16x8*)(C.wl + kt * (32 * VSTR) + ((lane >> 3) + 8 * i) * VSTR + (lane & 7) * 16) = vr[kt][i]; }
    const bf16* CT = (const bf16*)(C.ws + WS_MLCT) + (size_t)(bh * 64 + c) * 4096;
    bf16x8 ctf[2][4];
#pragma unroll
    for (int fb = 0; fb < 2; ++fb)
#pragma unroll
        for (int s = 0; s < 4; ++s) ctf[fb][s] = ldg8(CT + (32 * fb + t) * 64 + 16 * s + 8 * hh);
    const float* NCp = (const float*)(C.ws + WS_MLNC) + (size_t)(bh * 64 + c) * 64;
    f32x4 ncv[8];
#pragma unroll
    for (int s = 0; s < 4; ++s) { ncv[2 * s] = *(const f32x4*)(NCp + 16 * s + 8 * hh); ncv[2 * s + 1] = *(const f32x4*)(NCp + 16 * s + 8 * hh + 4); }
    LAS unsigned char* OG = C.wl + 64 * VSTR + 256;
#pragma unroll
    for (int i = 0; i < 4; ++i) *(LAS bf16x8*)(OG + ((lane >> 3) + 8 * i) * VSTR + (lane & 7) * 16) = ldg8(z + (size_t)(row0 + 32 * half + (lane >> 3) + 8 * i) * NZ + ZMO + h * 64 + 8 * (lane & 7));
    f32x16 O[2]; O[0] = zero16(); O[1] = zero16();
    float den = 0.f;
#pragma unroll
    for (int kt = 0; kt < 2; ++kt) if (kt <= half) {
#pragma unroll
        for (int reg = 0; reg < 16; ++reg) { const int sidx = 32 * kt + crow(reg, hh);
            const float w = (sidx <= tok) ? fexp(b_t + us[sidx] - mt_t) * S[kt][reg] : 0.f; S[kt][reg] = w; den += w; }
#pragma unroll
        for (int ks = 0; ks < 2; ++ks) { const bf16x8 pf = pack8(S[kt], ks);
#pragma unroll
            for (int fb = 0; fb < 2; ++fb) O[fb] = MFMA32(tr_frag<true>(C.wl + kt * (32 * VSTR), 16 * ks, 32 * fb, lane), pf, O[fb]); } }
    f32x16 X[2]; X[0] = zero16(); X[1] = zero16();
#pragma unroll
    for (int fb = 0; fb < 2; ++fb)
#pragma unroll
        for (int s = 0; s < 4; ++s) X[fb] = MFMA32(ctf[fb][s], qf[s], X[fb]);
    float qn = 0.f;
#pragma unroll
    for (int s = 0; s < 4; ++s) { const u32x4 qw = __builtin_bit_cast(u32x4, qf[s]); const f32x4 n0 = ncv[2 * s], n1 = ncv[2 * s + 1];
        qn += lo16(qw.x) * n0.x + hi16(qw.x) * n0.y + lo16(qw.y) * n0.z + hi16(qw.y) * n0.w + lo16(qw.z) * n1.x + hi16(qw.z) * n1.y + lo16(qw.w) * n1.z + hi16(qw.w) * n1.w; }
    qn += __shfl_xor(qn, 32); den += __shfl_xor(den, 32);
    den += g_t * qn;
    const float idn = __builtin_amdgcn_rcpf(fmaxf(fabsf(den), fexp(-mt_t)));
    float ssq = 0.f;
#pragma unroll
    for (int fb = 0; fb < 2; ++fb)
#pragma unroll
        for (int reg = 0; reg < 16; ++reg) { const float hv = (O[fb][reg] + g_t * X[fb][reg]) * idn; O[fb][reg] = hv; ssq += hv * hv; }
    ssq += __shfl_xor(ssq, 32);
    const float rs = __builtin_amdgcn_rsqf(ssq * (1.0f / 64) + EPS);
    const float* gn = P.in[14] + l * 256 + h * 64;
    LAS unsigned char* OT = C.wl;
#pragma unroll
    for (int fb = 0; fb < 2; ++fb)
#pragma unroll
        for (int g = 0; g < 4; ++g) { const int f0 = 32 * fb + 8 * g + 4 * hh; const u32x2 ow = *(LAS const u32x2*)(OG + t * VSTR + f0 * 2); const f32x4 gv = *(const f32x4*)(gn + f0);
            u32x2 w; w.x = pk2(O[fb][4 * g] * rs * gv.x * sigm(lo16(ow.x)), O[fb][4 * g + 1] * rs * gv.y * sigm(hi16(ow.x)));
            w.y = pk2(O[fb][4 * g + 2] * rs * gv.z * sigm(lo16(ow.y)), O[fb][4 * g + 3] * rs * gv.w * sigm(hi16(ow.y)));
            *(LAS u32x2*)(OT + t * VSTR + f0 * 2) = w; }
    bf16* mxp = (bf16*)(C.ws + WS_MIX) + (size_t)(row0 + 32 * half + (lane >> 3)) * D + 512 + h * 64 + 8 * (lane & 7);
#pragma unroll
    for (int i = 0; i < 4; ++i) *(u32x4*)(mxp + (size_t)(8 * i) * D) = *(LAS const u32x4*)(OT + ((lane >> 3) + 8 * i) * VSTR + (lane & 7) * 16);
}

DI void mlstm_sample_item(const Ctx& C, int l, int it) {
    const Params& P = *C.P; const int lane = C.lane, b = it >> 2, h = it & 3;
    const bf16* z = (const bf16*)(C.ws + WS_Z); const float* gate = (const float*)(C.ws + WS_GATE);
    const size_t sb = (size_t)(l * SB + b) * 4 + h;
    const float* C0 = P.in[5] + sb * 4096;
    LAS float* Cs = (LAS float*)C.wl;
    { float c0[64];
#pragma unroll
      for (int e = 0; e < 64; ++e) c0[e] = C0[e * 64 + lane];
#pragma unroll
      for (int e = 0; e < 64; ++e) Cs[e * 64 + lane] = c0[e]; }
    float nv = P.in[6][sb * 64 + lane], m = P.in[7][sb];
    const float* cw = P.in[13] + (size_t)l * 4 * 512; const float* cb = P.in[4] + (size_t)(l * SB + b) * 3 * 512;
    float xq[7], xk[7];
#pragma unroll
    for (int j = 0; j < 3; ++j) { xq[j] = cb[j * 512 + h * 64 + lane]; xk[j] = cb[j * 512 + 256 + h * 64 + lane]; }
#pragma unroll
    for (int j = 0; j < 4; ++j) { xq[3 + j] = bf2f(z[(size_t)(MP + b * 4 + j) * NZ + ZMQ + h * 64 + lane]); xk[3 + j] = bf2f(z[(size_t)(MP + b * 4 + j) * NZ + ZMK + h * 64 + lane]); }
    float wq[4], wk[4];
#pragma unroll
    for (int j = 0; j < 4; ++j) { wq[j] = cw[j * 512 + h * 64 + lane]; wk[j] = cw[j * 512 + 256 + h * 64 + lane]; }
    const float gnv = P.in[14][l * 256 + h * 64 + lane];
#pragma unroll
    for (int t = 0; t < 4; ++t) { const int row = MP + b * 4 + t;
        float qc = 0.f, kc = 0.f;
#pragma unroll
        for (int j = 0; j < 4; ++j) { qc += wq[j] * xq[t + j]; kc += wk[j] * xk[t + j]; }
        qc = silu(qc); kc = silu(kc) * 0.125f;
        const float ig = gate[(size_t)row * 8 + h] + P.in[12][l * 8 + h], lf = logsig(gate[(size_t)row * 8 + 4 + h] + P.in[12][l * 8 + 4 + h]);
        const float mn = fmaxf(lf + m, ig), fp = fexp(lf + m - mn), ip = fexp(ig - mn);
        const float vf = bf2f(z[(size_t)row * NZ + ZMV + h * 64 + lane]) * ip;
        float num = 0.f;
#pragma unroll 4
        for (int e = 0; e < 64; ++e) { const float ke = rdlane(kc, e), qe = rdlane(qc, e); const float cv = fp * Cs[e * 64 + lane] + ke * vf; Cs[e * 64 + lane] = cv; num += qe * cv; }
        nv = fp * nv + ip * kc;
        const float qn = wave_sum(qc * nv);
        const float hv = num / fmaxf(fabsf(qn), fexp(-mn));
        const float ssq = wave_sum(hv * hv), rs = __builtin_amdgcn_rsqf(ssq * (1.0f / 64) + EPS);
        const float og = bf2f(z[(size_t)row * NZ + ZMO + h * 64 + lane]);
        ((bf16*)(C.ws + WS_MIX))[(size_t)row * D + 512 + h * 64 + lane] = f2bf(hv * rs * gnv * sigm(og));
        m = mn; }
    float* oc = C.out + O_SC + sb * 4096;
#pragma unroll 8
    for (int e = 0; e < 64; ++e) oc[e * 64 + lane] = Cs[e * 64 + lane];
    C.out[O_SN + sb * 64 + lane] = nv; if (lane == 0) C.out[O_SM + sb] = m;
}

DI void hgrn_m1_item(const Ctx& C, int l, int it) {
    const int lane = C.lane, hh = lane >> 5;
    const int bh = it >> 6, c = it & 63, b = bh >> 2, h = bh & 3, row0 = b * SEQ + c * 64;
    const bf16* z = (const bf16*)(C.ws + WS_Z);
    LAS unsigned char* ft = C.wl; LAS unsigned char* kt_ = C.wl + 64 * VSTR; LAS unsigned char* vt_ = C.wl + 96 * VSTR;
    const float lb = ((const float*)(C.ws + WS_LBV))[l * 256 + h * 64 + lane];
#pragma unroll
    for (int i = 0; i < 8; ++i) { const int id = lane + 64 * i, rr = id >> 3, cgp = id & 7;
        *(LAS bf16x8*)(ft + rr * VSTR + cgp * 16) = ldg8(z + (size_t)(row0 + rr) * NZ + ZHF + h * 64 + 8 * cgp); }
    float ba = 0.f, r = 0.f;
#pragma unroll 8
    for (int t = 0; t < 64; ++t) { const float x = bf2f(*(LAS const bf16*)(ft + t * VSTR + lane * 2)); const float fg = lb + (1.0f - lb) * sigm(x); ba += flog(fg); if (t == 31) r = ba; }
    const float bL = ba, er = fexp(r), eLr = fexp(bL - r);
    bf16* QT = (bf16*)(C.ws + WS_HGQT); bf16* KT = (bf16*)(C.ws + WS_HGKT); bf16* QB = (bf16*)(C.ws + WS_HGQB);
    f32x16 acc[2][2]; acc[0][0] = zero16(); acc[0][1] = zero16(); acc[1][0] = zero16(); acc[1][1] = zero16();
    ba = 0.f;
    for (int hf = 0; hf < 2; ++hf) {
#pragma unroll
        for (int i = 0; i < 4; ++i) { const int id = lane + 64 * i, rr = id >> 3, cgp = id & 7;
            *(LAS bf16x8*)(vt_ + rr * VSTR + cgp * 16) = ldg8(z + (size_t)(row0 + 32 * hf + rr) * NZ + ZHQ + h * 64 + 8 * cgp); }
#pragma unroll 8
        for (int tt = 0; tt < 32; ++tt) { const int t = 32 * hf + tt;
            const float x = bf2f(*(LAS const bf16*)(ft + t * VSTR + lane * 2)); const float fg = lb + (1.0f - lb) * sigm(x), kk = 1.0f - fg;
            ba += flog(fg);
            const float q = silu(bf2f(*(LAS const bf16*)(vt_ + tt * VSTR + lane * 2)));
            const size_t o = (size_t)(row0 + t) * 256 + h * 64 + lane;
            const float e1 = fexp(ba - r), qt = q * e1, ktv = kk * __builtin_amdgcn_rcpf(e1);
            QT[o] = f2bf(qt); KT[o] = f2bf(ktv); QB[o] = f2bf(qt * er);
            *(LAS bf16*)(kt_ + tt * VSTR + lane * 2) = f2bf(ktv * eLr); }
#pragma unroll
        for (int i = 0; i < 4; ++i) { const int id = lane + 64 * i, rr = id >> 3, cgp = id & 7;
            *(LAS bf16x8*)(vt_ + rr * VSTR + cgp * 16) = ldg8(z + (size_t)(row0 + 32 * hf + rr) * NZ + ZHI + h * 64 + 8 * cgp); }
#pragma unroll
        for (int ks = 0; ks < 2; ++ks) { bf16x8 A[2], B[2];
#pragma unroll
            for (int x = 0; x < 2; ++x) { A[x] = tr_frag<false>(vt_, 16 * ks, 32 * x, lane); B[x] = tr_frag<false>(kt_, 16 * ks, 32 * x, lane); }
#pragma unroll
            for (int vb = 0; vb < 2; ++vb)
#pragma unroll
                for (int kb = 0; kb < 2; ++kb) acc[vb][kb] = MFMA32(A[vb], B[kb], acc[vb][kb]); }
    }
    float* GT = (float*)(C.ws + WS_HGGT) + (size_t)(bh * 64 + c) * 4096;
#pragma unroll
    for (int vb = 0; vb < 2; ++vb)
#pragma unroll
        for (int kb = 0; kb < 2; ++kb)
#pragma unroll
            for (int reg = 0; reg < 16; ++reg) GT[(32 * vb + crow(reg, hh)) * 64 + 32 * kb + (lane & 31)] = acc[vb][kb][reg];
    ((float*)(C.ws + WS_HGDL))[(size_t)(bh * 64 + c) * 64 + lane] = fexp(bL);
}
DI void hgrn_m2_item(const Ctx& C, int l, int it) {
    const int lane = C.lane, bh = it >> 6, v = it & 63, b = bh >> 2, h = bh & 3;
    const float* __restrict__ GT = (const float*)(C.ws + WS_HGGT) + (size_t)bh * 64 * 4096 + v * 64 + lane;
    const float* __restrict__ DL = (const float*)(C.ws + WS_HGDL) + (size_t)bh * 64 * 64 + lane;
    bf16* __restrict__ ST = (bf16*)(C.ws + WS_HGST) + (size_t)bh * 64 * 4096 + v * 64 + lane;
    float gt[64], dl[64];
#pragma unroll
    for (int c = 0; c < 64; ++c) { gt[c] = GT[(size_t)c * 4096]; dl[c] = DL[c * 64]; }
    float S = 0.f;
#pragma unroll
    for (int c = 0; c < 64; ++c) { ST[(size_t)c * 4096] = f2bf(S); S = dl[c] * S + gt[c]; }
    C.out[O_PS + ((size_t)((l * NB + b) * 4 + h) * 64 + lane) * 64 + v] = S;
}
DI void hgrn_m3_item(const Ctx& C, int l, int it) {
    const Params& P = *C.P; const int lane = C.lane, t = lane & 31, hh = lane >> 5;
    const int half = it & 1, c = (it >> 1) & 63, bh = it >> 7, b = bh >> 2, h = bh & 3, row0 = b * SEQ + c * 64, tok = 32 * half + t, row = row0 + tok;
    const bf16* z = (const bf16*)(C.ws + WS_Z);
    const bf16* QT = (const bf16*)(C.ws + WS_HGQT); const bf16* KT = (const bf16*)(C.ws + WS_HGKT); const bf16* QB = (const bf16*)(C.ws + WS_HGQB);
    bf16x8 qf[4], kf[2][4], vr[2][4];
#pragma unroll
    for (int s = 0; s < 4; ++s) qf[s] = ldg8(QT + (size_t)row * 256 + h * 64 + 16 * s + 8 * hh);
#pragma unroll
    for (int kt = 0; kt < 2; ++kt) if (kt <= half) {
#pragma unroll
        for (int s = 0; s < 4; ++s) { kf[kt][s] = ldg8(KT + (size_t)(row0 + 32 * kt + t) * 256 + h * 64 + 8 * hh + 16 * s);
            vr[kt][s] = ldg8(z + (size_t)(row0 + 32 * kt + (lane >> 3) + 8 * s) * NZ + ZHI + h * 64 + 8 * (lane & 7)); } }
    f32x16 S[2]; S[0] = zero16(); S[1] = zero16();
#pragma unroll
    for (int kt = 0; kt < 2; ++kt) if (kt <= half) {
#pragma unroll
        for (int s = 0; s < 4; ++s) S[kt] = MFMA32(kf[kt][s], qf[s], S[kt]);
#pragma unroll
        for (int i = 0; i < 4; ++i) *(LAS bf16x8*)(C.wl + kt * (32 * VSTR) + ((lane >> 3) + 8 * i) * VSTR + (lane & 7) * 16) = vr[kt][i]; }
    const bf16* ST = (const bf16*)(C.ws + WS_HGST) + (size_t)(bh * 64 + c) * 4096;
    bf16x8 stf[2][4], qb[4];
#pragma unroll
    for (int s = 0; s < 4; ++s) { qb[s] = ldg8(QB + (size_t)row * 256 + h * 64 + 16 * s + 8 * hh);
#pragma unroll
        for (int vb = 0; vb < 2; ++vb) stf[vb][s] = ldg8(ST + (32 * vb + t) * 64 + 16 * s + 8 * hh); }
    LAS unsigned char* OG = C.wl + 64 * VSTR + 256;
#pragma unroll
    for (int i = 0; i < 4; ++i) *(LAS bf16x8*)(OG + ((lane >> 3) + 8 * i) * VSTR + (lane & 7) * 16) = ldg8(z + (size_t)(row0 + 32 * half + (lane >> 3) + 8 * i) * NZ + ZHG + h * 64 + 8 * (lane & 7));
    f32x16 O[2]; O[0] = zero16(); O[1] = zero16();
#pragma unroll
    for (int kt = 0; kt < 2; ++kt) if (kt <= half) {
#pragma unroll
        for (int reg = 0; reg < 16; ++reg) { const int sidx = 32 * kt + crow(reg, hh); S[kt][reg] = (sidx <= tok) ? S[kt][reg] : 0.f; }
#pragma unroll
        for (int ks = 0; ks < 2; ++ks) { const bf16x8 pf = pack8(S[kt], ks);
#pragma unroll
            for (int vb = 0; vb < 2; ++vb) O[vb] = MFMA32(tr_frag<true>(C.wl + kt * (32 * VSTR), 16 * ks, 32 * vb, lane), pf, O[vb]); } }
#pragma unroll
    for (int s = 0; s < 4; ++s)
#pragma unroll
        for (int vb = 0; vb < 2; ++vb) O[vb] = MFMA32(stf[vb][s], qb[s], O[vb]);
    float ssq = 0.f;
#pragma unroll
    for (int vb = 0; vb < 2; ++vb)
#pragma unroll
        for (int reg = 0; reg < 16; ++reg) ssq += O[vb][reg] * O[vb][reg];
    ssq += __shfl_xor(ssq, 32);
    const float rs = __builtin_amdgcn_rsqf(ssq * (1.0f / 64) + EPS);
    const float* gn = P.in[16] + l * 256 + h * 64;
    LAS unsigned char* OT = C.wl;
#pragma unroll
    for (int vb = 0; vb < 2; ++vb)
#pragma unroll
        for (int g = 0; g < 4; ++g) { const int f0 = 32 * vb + 8 * g + 4 * hh; const u32x2 ow = *(LAS const u32x2*)(OG + t * VSTR + f0 * 2); const f32x4 gv = *(const f32x4*)(gn + f0);
            u32x2 w; w.x = pk2(O[vb][4 * g] * rs * gv.x * sigm(lo16(ow.x)), O[vb][4 * g + 1] * rs * gv.y * sigm(hi16(ow.x)));
            w.y = pk2(O[vb][4 * g + 2] * rs * gv.z * sigm(lo16(ow.y)), O[vb][4 * g + 3] * rs * gv.w * sigm(hi16(ow.y)));
            *(LAS u32x2*)(OT + t * VSTR + f0 * 2) = w; }
    bf16* mxp = (bf16*)(C.ws + WS_MIX) + (size_t)(row0 + 32 * half + (lane >> 3)) * D + 768 + h * 64 + 8 * (lane & 7);
#pragma unroll
    for (int i = 0; i < 4; ++i) *(u32x4*)(mxp + (size_t)(8 * i) * D) = *(LAS const u32x4*)(OT + ((lane >> 3) + 8 * i) * VSTR + (lane & 7) * 16);
}
DI void hgrn_sample_item(const Ctx& C, int l, int it) {
    const Params& P = *C.P; const int lane = C.lane, b = it >> 2, h = it & 3;
    const bf16* z = (const bf16*)(C.ws + WS_Z);
    const size_t sb = (size_t)(l * SB + b) * 4 + h;
    const float* S0 = P.in[8] + sb * 4096;
    LAS float* Ss = (LAS float*)C.wl;
    { float s0[64];
#pragma unroll
      for (int k = 0; k < 64; ++k) s0[k] = S0[k * 64 + lane];
#pragma unroll
      for (int k = 0; k < 64; ++k) Ss[k * 64 + lane] = s0[k]; }
    const float lb = ((const float*)(C.ws + WS_LBV))[l * 256 + h * 64 + lane], gnv = P.in[16][l * 256 + h * 64 + lane];
#pragma unroll
    for (int t = 0; t < 4; ++t) { const size_t zr = (size_t)(MP + b * 4 + t) * NZ;
        const float fg = lb + (1.0f - lb) * sigm(bf2f(z[zr + ZHF + h * 64 + lane])), kk = 1.0f - fg, q = silu(bf2f(z[zr + ZHQ + h * 64 + lane]));
        const float iv = bf2f(z[zr + ZHI + h * 64 + lane]);
        float o = 0.f;
#pragma unroll 4
        for (int k = 0; k < 64; ++k) { const float sv = rdlane(fg, k) * Ss[k * 64 + lane] + rdlane(kk, k) * iv; Ss[k * 64 + lane] = sv; o += rdlane(q, k) * sv; }
        const float ssq = wave_sum(o * o), rs = __builtin_amdgcn_rsqf(ssq * (1.0f / 64) + EPS);
        const float og = bf2f(z[zr + ZHG + h * 64 + lane]);
        ((bf16*)(C.ws + WS_MIX))[(size_t)(MP + b * 4 + t) * D + 768 + h * 64 + lane] = f2bf(o * rs * gnv * sigm(og)); }
    float* os = C.out + O_SS + sb * 4096;
#pragma unroll 8
    for (int k = 0; k < 64; ++k) os[k * 64 + lane] = Ss[k * 64 + lane];
}

DI void copy_row(const bf16* src, float* dst, int lane) {
    const u32x4 w = __builtin_bit_cast(u32x4, ldg8(src + 8 * lane));
    *(f32x4*)(dst + 8 * lane) = (f32x4){lo16(w.x), hi16(w.x), lo16(w.y), hi16(w.y)};
    *(f32x4*)(dst + 8 * lane + 4) = (f32x4){lo16(w.z), hi16(w.z), lo16(w.w), hi16(w.w)}; }
constexpr int CO_PKV8 = 2 * NB * WB / 8, CO_SKV = 2 * MS, CO_PCV = NB * 3, CO_SCV = SB * 3, CO_ALL = CO_PKV8 + CO_SKV + CO_PCV + CO_SCV;
DI void copyout_item(const Ctx& C, int l, int it) {
    const bf16* z = (const bf16*)(C.ws + WS_Z); const int lane = C.lane;
    if (it < CO_PKV8) { const int which = it / (NB * WB / 8), r = it % (NB * WB / 8), b = r / (WB / 8), j = (r % (WB / 8)) * 8;
        const bf16* src = (const bf16*)(C.ws + (which ? WS_VC : WS_KC)) + ((size_t)(b * 8 + (lane >> 3)) * SEQ + (SEQ - WB) + j) * 64 + 8 * (lane & 7); float* dst = C.out + (which ? O_PV : O_PK) + ((size_t)(l * NB + b) * WB + j) * 512 + 8 * lane;
        u32x4 w[8];
#pragma unroll
        for (int q = 0; q < 8; ++q) w[q] = __builtin_bit_cast(u32x4, ldg8(src + (size_t)q * 64));
#pragma unroll
        for (int q = 0; q < 8; ++q) { *(f32x4*)(dst + q * 512) = (f32x4){lo16(w[q].x), hi16(w[q].x), lo16(w[q].y), hi16(w[q].y)}; *(f32x4*)(dst + q * 512 + 4) = (f32x4){lo16(w[q].z), hi16(w[q].z), lo16(w[q].w), hi16(w[q].w)}; }
        return; }
    it -= CO_PKV8;
    if (it < CO_SKV) { const int which = it / MS, r = it % MS;
        copy_row(z + (size_t)(MP + r) * NZ + (which ? ZV : ZK), C.out + (which ? O_SV : O_SK) + ((size_t)l * MS + r) * 512, lane); return; }
    it -= CO_SKV;
    if (it < CO_PCV) { const int b = it / 3, j = it % 3;
        copy_row(z + (size_t)(b * SEQ + SEQ - 3 + j) * NZ + ZMQ, C.out + O_PCONV + ((size_t)(l * NB + b) * 3 + j) * 512, lane); return; }
    it -= CO_PCV;
    { const int b = it / 3, j = it % 3;
        copy_row(z + (size_t)(MP + b * 4 + 1 + j) * NZ + ZMQ, C.out + O_SCONV + ((size_t)(l * SB + b) * 3 + j) * 512, lane); }
}

#define STAMP(i) do { if (PROBE_T0 >= 0 && blockIdx.x == PROBE_BLK && threadIdx.x == 0) ((unsigned long long*)(C.ws + WS_TS))[(i)] = __builtin_amdgcn_s_memrealtime(); } while (0)
#define STAMPB(i) do { if (PROBE_T0 >= 0 && blockIdx.x == PROBE_BLK && threadIdx.x == 256) ((unsigned long long*)(C.ws + WS_TS))[(i)] = __builtin_amdgcn_s_memrealtime(); } while (0)
#define ITEM_LOOP(N, rot, call) do { for (int it = (C.wave * C.G + C.vcu + C.NGW - ((rot) % C.NGW)) % C.NGW; it < (N); it += C.NGW) { call; } } while (0)
DI int grab_lds(const Ctx& C, int k) { unsigned v = 0; if (C.lane == 0) v = __hip_atomic_fetch_add((LAS unsigned*)(C.lds + LDS_CTL) + 8 + k, 1u, __ATOMIC_RELAXED, __HIP_MEMORY_SCOPE_WORKGROUP); return (int)__builtin_amdgcn_readfirstlane(v); }
#define QUEUE_LOOP(N, k, call) do { const int per = (N) / C.G, base = C.vcu * per; for (int q = grab_lds(C, (k)); q < per; q = grab_lds(C, (k))) { const int it = base + q; call; } } while (0)
#define QUEUE_RESET() do { if (C.tid < 8) ((LAS unsigned*)(C.lds + LDS_CTL))[8 + C.tid] = 0u; __syncthreads(); } while (0)
template <int l> DI void ph_m1(const Ctx& C) {
    QUEUE_RESET();
    if (l == 0) { STAMP(20); STAMPB(40); }
    if (C.wave == 7) { if (C.vcu < 128) mlstm_sample_item(C, l, C.vcu); else hgrn_sample_item(C, l, C.vcu - 128); }
    if (C.wave < 4) { QUEUE_LOOP(3072, 0, attn_sample_item(C, l, it)); }
    else { QUEUE_LOOP(2048, 4, attn_unit<2>(C, l, it)); }
    if (l == 0) { STAMP(21); STAMPB(41); }
    QUEUE_LOOP(1024, 1, hgrn_m1_item(C, l, it));
    if (l == 0) { STAMP(22); STAMPB(42); }
    QUEUE_LOOP(1024, 2, mlstm_m1_item(C, l, it));
    if (l == 0) { STAMP(23); STAMPB(43); }
    if (l == 0) { STAMP(24); STAMPB(44); }
    QUEUE_LOOP(2048, 3, attn_unit<1>(C, l, it));
    if (l == 0) { STAMP(25); STAMPB(45); }
}
template <int l> DI void ph_m2(const Ctx& C) {
    ITEM_LOOP(1040, 0, mlstm_m2_item(C, l, it));
    if (l == 0) convert_weights(C, 1);
    ITEM_LOOP(1024, 1040, hgrn_m2_item(C, l, it));
    ITEM_LOOP(256, 1040, attn_sample_combine(C, it));
}
template <int l> DI void ph_m3(const Ctx& C) {
    QUEUE_RESET();
    if (l == 0) STAMP(28);
    QUEUE_LOOP(2048, 0, mlstm_m3_item(C, l, it));
    if (l == 0) STAMP(29);
    QUEUE_LOOP(2048, 1, hgrn_m3_item(C, l, it));
    if (l == 0) STAMP(30);
    QUEUE_LOOP(2048, 2, attn_unit<0>(C, l, it));
    if (l == 0) STAMP(31);
    ITEM_LOOP(CO_ALL, 0, copyout_item(C, l, it));
    if (l == 0) STAMP(32);
}
DI void ph_final(const Ctx& C) {
    const Params& P = *C.P; const int lane = C.lane;
    const bf16* HB = (const bf16*)(C.ws + WS_HB); const float* SSQ = (const float*)(C.ws + WS_SSQ) + 4 * MPAD;
#pragma unroll 4
    for (int m = C.gw; m < MT; m += C.NGW) {
        const float rs = __builtin_amdgcn_rsqf(SSQ[m] * (1.0f / D) + EPS);
        float* o = (m < MP) ? C.out + O_YP + (size_t)m * D : C.out + O_YS + (size_t)(m - MP) * D;
#pragma unroll
        for (int j = 0; j < 2; ++j) { const u32x4 hw = *(const u32x4*)(HB + (size_t)m * D + 8 * lane + 512 * j); const f32x4 g0 = *(const f32x4*)(P.in[21] + 8 * lane + 512 * j), g1 = *(const f32x4*)(P.in[21] + 8 * lane + 512 * j + 4);
            *(f32x4*)(o + 8 * lane + 512 * j) = (f32x4){lo16(hw.x), hi16(hw.x), lo16(hw.y), hi16(hw.y)} * rs * g0;
            *(f32x4*)(o + 8 * lane + 512 * j + 4) = (f32x4){lo16(hw.z), hi16(hw.z), lo16(hw.w), hi16(hw.w)} * rs * g1; }
    }
}

constexpr int SGS = 272;
template <int NBK  > DI void sgemm_acc(const Ctx& C, const bf16* __restrict__ A, const bf16* __restrict__ Bt, int K, int rb, int cb, int k_lo, int k_hi, int lane, f32x16& acc) {
    const int r = lane & 31, hh = lane >> 5, lr = lane >> 4, lc = lane & 15;
    const bf16* ap = A + (size_t)(32 * rb + lr) * K + 8 * lc; const bf16* bp = Bt + (size_t)(32 * cb + lr) * K + 8 * lc;
    LAS unsigned char* ta = C.wl; LAS unsigned char* tb = C.wl + 32 * SGS;
    bf16x8 ga[8], gb[8];
#pragma unroll
    for (int i = 0; i < 8; ++i) { ga[i] = ldg8(ap + (size_t)(4 * i) * K + k_lo); gb[i] = ldg8(bp + (size_t)(4 * i) * K + k_lo); }
#pragma unroll 1
    for (int k = k_lo; k < k_hi; k += 128) {
#pragma unroll
        for (int i = 0; i < 8; ++i) { *(LAS bf16x8*)(ta + (4 * i + lr) * SGS + lc * 16) = ga[i]; *(LAS bf16x8*)(tb + (4 * i + lr) * SGS + lc * 16) = gb[i]; }
        if (k + 128 < k_hi) {
#pragma unroll
            for (int i = 0; i < 8; ++i) { ga[i] = ldg8(ap + (size_t)(4 * i) * K + k + 128); gb[i] = ldg8(bp + (size_t)(4 * i) * K + k + 128); } }
#pragma unroll
        for (int s = 0; s < 8; ++s) acc = MFMA32(*(LAS const bf16x8*)(ta + r * SGS + 32 * s + 16 * hh), *(LAS const bf16x8*)(tb + r * SGS + 32 * s + 16 * hh), acc);
    }
}
template <int KIND> DI void sgemm_epi(const Ctx& C, int l, int rb, int cb, int reg, int lane, float v) {
    const int hh = lane >> 5, row = MP + 32 * rb + crow(reg, hh), col = 32 * cb + (lane & 31);
    float* SSQ = (float*)(C.ws + WS_SSQ);
    if (KIND == 0) { const float rs = __builtin_amdgcn_rsqf(SSQ[(2 * l) * MPAD + row] * (1.0f / D) + EPS); const float x = v * rs;
        ((bf16*)(C.ws + WS_Z))[(size_t)row * NZ + col] = f2bf(x); if (col >= ZG && col < ZG + 8) ((float*)(C.ws + WS_GATE))[(size_t)row * 8 + col - ZG] = x; }
    else if (KIND == 2) { const float rs = __builtin_amdgcn_rsqf(SSQ[(2 * l + 1) * MPAD + row] * (1.0f / D) + EPS); const float x = fmaxf(v * rs, 0.f);
        ((bf16*)(C.ws + WS_ACT))[(size_t)row * FF + col] = f2bf(x * x); }
    else { bf16* hp = (bf16*)(C.ws + WS_HB) + (size_t)row * D + col; const float x = bf2f(*hp) + v; *hp = f2bf(x);
        float s = x * x; s += __shfl_xor(s, 1); s += __shfl_xor(s, 2); s += __shfl_xor(s, 4); s += __shfl_xor(s, 8); s += __shfl_xor(s, 16);
        if ((lane & 31) == 0) atomicAdd(SSQ + (KIND == 1 ? 2 * l + 1 : 2 * l + 2) * MPAD + row, s); }
}
template <int KIND> DI void sgemm_phase(const Ctx& C0, int l) {
    const Ctx C = fresh(C0); const int lane = C.lane;
    constexpr int K = KIND == 3 ? FF : D;
    const bf16* A = (const bf16*)(C.ws + (KIND == 1 ? WS_MIX : (KIND == 3 ? WS_ACT : WS_HB))) + (size_t)MP * K;
    const bf16* Bt = (const bf16*)(C.ws + (KIND == 0 ? WS_WIN : (KIND == 1 ? WS_WOUT : (KIND == 2 ? WS_WUP : WS_WDN)))) + (size_t)l * (KIND == 0 ? NZ * D : (KIND == 1 ? D * D : FF * D));
    if (KIND == 0) {
        int u = -1; if ((int)blockIdx.x >= 192) u = ((int)blockIdx.x - 192) * 8 + C.wave; if (u >= 480) u = -1;
        if (u >= 0) { const int rb = u & 3, cb = u >> 2; f32x16 acc = zero16();
            sgemm_acc<16>(C, A, Bt, K, rb, cb, 0, K, lane, acc);
#pragma unroll
            for (int reg = 0; reg < 16; ++reg) sgemm_epi<0>(C, l, rb, cb, reg, lane, acc[reg]); }
        return; }
    constexpr int KS = KIND == 2 ? 4 : 8;
    if (KIND != 2 && C.vcu >= 128) return;
    const int grp = C.wave / KS, ki = C.wave % KS, u = KIND == 2 ? C.vcu * 2 + grp : C.vcu, rb = u & 3, cb = u >> 2;
    f32x16 acc = zero16();
    sgemm_acc<0>(C, A, Bt, K, rb, cb, ki * (K / KS), (ki + 1) * (K / KS), lane, acc);
    __syncthreads();
    LAS float* red = (LAS float*)C.lds;
#pragma unroll
    for (int reg = 0; reg < 16; ++reg) red[(C.wave * 16 + reg) * 64 + lane] = acc[reg];
    __syncthreads();
#pragma unroll
    for (int q = 0; q < 16 / KS; ++q) { const int reg = (16 / KS) * ki + q; float v = 0.f;
#pragma unroll
        for (int w = 0; w < KS; ++w) v += red[((grp * KS + w) * 16 + reg) * 64 + lane];
        sgemm_epi<KIND>(C, l, rb, cb, reg, lane, v); }
}

#define XB_TMO      128
#define XB_XCNT(j)  (256  + 64 * (j))
#define XB_XSUB(j)  (1280 + 64 * (j))
#define XB_XGEN(j)  (2304 + 64 * (j))
#define XB_TOP      3328
#define XB_TOPGEN   3392
#define XCD_BAR_WORDS 3456
#define XB_SPIN_CAP (1u << 18)

__device__ __forceinline__ unsigned xb_ld(unsigned* p)              { return __hip_atomic_load(p, __ATOMIC_RELAXED, __HIP_MEMORY_SCOPE_AGENT); }
__device__ __forceinline__ unsigned xb_add(unsigned* p, unsigned v) { return __hip_atomic_fetch_add(p, v, __ATOMIC_RELAXED, __HIP_MEMORY_SCOPE_AGENT); }
__device__ __forceinline__ unsigned xb_xcc_id() { return (unsigned)__builtin_amdgcn_s_getreg((3 << 11) | 20) & 0xFu; }
#define XB_SPIN(cond, bar) do { unsigned _sp = 0; while (cond) { __builtin_amdgcn_s_sleep(1); \
    if ((++_sp & 255u) == 0u) { if (xb_ld(&(bar)[XB_TMO])) break; if (_sp > XB_SPIN_CAP) { atomicAdd(&(bar)[XB_TMO], 1u); break; } } } } while (0)


__device__ __forceinline__ XcdBarrier xcd_barrier_post(unsigned* bar, volatile LAS unsigned* st) {
    XcdBarrier b; b.bar = bar; b.x = xb_xcc_id(); b.st = st;
    if (threadIdx.x == 0) (void)xb_add(&bar[XB_XCNT(b.x)], 1u);
    return b;
}
__device__ __forceinline__ void xcd_barrier_complete(unsigned* bar, unsigned x, unsigned& nloc, unsigned& nx) {
    const unsigned G = gridDim.x * gridDim.y * gridDim.z;
    unsigned sum, cnt, mine, sp = 0u;
    for (;;) {
        sum = 0u; cnt = 0u; mine = 0u;
#pragma unroll
        for (unsigned j = 0; j < 16; ++j) { const unsigned c = xb_ld(&bar[XB_XCNT(j)]); sum += c; cnt += (c > 0u) ? 1u : 0u; mine = (j == x) ? c : mine; }
        if (sum == G) break;
        __builtin_amdgcn_s_sleep(1);
        if ((++sp & 255u) == 0u) { if (xb_ld(&bar[XB_TMO])) break; if (sp > XB_SPIN_CAP) { atomicAdd(&bar[XB_TMO], 1u); break; } }
    }
    nloc = mine > 0u ? mine : 1u; nx = cnt > 0u ? cnt : 1u;
}

__device__ __forceinline__ void xcd_barrier(const XcdBarrier& b) {
    asm volatile("s_waitcnt vmcnt(0)" ::: "memory");
    __syncthreads();
    if (threadIdx.x == 0) {
        unsigned* bar = b.bar;
        __builtin_amdgcn_s_waitcnt(0);
        unsigned nloc = b.st[0], nx = b.st[1];
        if (nloc == 0u) { xcd_barrier_complete(bar, b.x, nloc, nx); b.st[0] = nloc; b.st[1] = nx; }
        const unsigned old = xb_add(&bar[XB_XSUB(b.x)], 1u);
        const unsigned gen = old / nloc;
        if (old + 1u == (gen + 1u) * nloc) {
            __builtin_amdgcn_fence(__ATOMIC_RELEASE, "agent");
            asm volatile("s_waitcnt vmcnt(0)" ::: "memory");
            const unsigned og = xb_add(&bar[XB_TOP], 1u);
            const unsigned tg = og / nx;
            if (og + 1u == (tg + 1u) * nx) xb_add(&bar[XB_TOPGEN], 1u);
            else XB_SPIN(xb_ld(&bar[XB_TOPGEN]) == tg, bar);
            __builtin_amdgcn_fence(__ATOMIC_ACQUIRE, "agent");
            xb_add(&bar[XB_XGEN(b.x)], 1u);
            asm volatile("s_waitcnt vmcnt(0)" ::: "memory");
        } else {
            XB_SPIN(xb_ld(&bar[XB_XGEN(b.x)]) == gen, bar);
            __builtin_amdgcn_fence(__ATOMIC_ACQUIRE, "agent");
            asm volatile("s_waitcnt vmcnt(0)" ::: "memory");
        }
    }
    __syncthreads();
}


constexpr int NPH = 16;
#if MK_CGSYNC
#define GRID_SYNC() cg::this_grid().sync()
#else
#define GRID_SYNC() xcd_barrier(C.xb)
#endif
template <int l> DI void layer_phases(const Ctx& C, const Params& P) {
    float* SSQ = (float*)(C.ws + WS_SSQ);
#define IN(k) (P.ph_lo <= (1 + 7 * l + (k)) && (1 + 7 * l + (k)) < P.ph_hi)
#define SEAM(k) do { if (IN(k) && (1 + 7 * l + (k)) + 1 < P.ph_hi) GRID_SYNC(); STAMP(2 + 7 * l + (k)); } while (0)
#define DUP(k) for (int rep = 0; rep < (((PROBE_DUP >> (k)) & 1) ? 2 : 1); ++rep)
    DUP(0) { if (rep) GRID_SYNC();
    if (IN(0)) { pg8::Gemm g{(const bf16*)(C.ws + WS_HB), (const bf16*)(C.ws + WS_WIN) + (size_t)l * NZ * D, MP, NZ, D}; pg8::StaticOrder S; S.init(MP, NZ, C.G, (int)blockIdx.x);
        EpiZ E{(bf16*)(C.ws + WS_Z), SSQ + (2 * l) * MPAD, (float*)(C.ws + WS_GATE), (bf16*)(C.ws + WS_KC)};
        pg8::gemm_phase<EpiZ, pg8::StaticOrder, true, true>(C.lds, g, S, E); if (!rep) sgemm_phase<0>(C, l); } }
    SEAM(0);
    DUP(1) { if (rep) GRID_SYNC(); if (IN(1)) ph_m1<l>(C); }
    SEAM(1);
    DUP(2) { if (rep) GRID_SYNC(); if (IN(2)) ph_m2<l>(C); }
    SEAM(2);
    DUP(3) { if (rep) GRID_SYNC(); if (IN(3)) ph_m3<l>(C); }
    SEAM(3);
    DUP(4) { if (rep) GRID_SYNC();
    if (IN(4)) { pg8::Gemm g{(const bf16*)(C.ws + WS_MIX), (const bf16*)(C.ws + WS_WOUT) + (size_t)l * D * D, MP, D, D}; pg8::StaticOrder S; S.init(MP, D, C.G, (int)blockIdx.x);
        EpiRes E{(bf16*)(C.ws + (rep ? WS_Z : WS_HB)), rep ? (float*)(C.ws + WS_GATE) : SSQ + (2 * l + 1) * MPAD};
        pg8::gemm_phase<EpiRes, pg8::StaticOrder, true, true>(C.lds, g, S, E); if (!rep) sgemm_phase<1>(C, l); } }
    SEAM(4);
    DUP(5) { if (rep) GRID_SYNC();
    if (IN(5)) { pg8::Gemm g{(const bf16*)(C.ws + WS_HB), (const bf16*)(C.ws + WS_WUP) + (size_t)l * FF * D, MP, FF, D}; pg8::StaticOrder S; S.init(MP, FF, C.G, (int)blockIdx.x);
        EpiAct E{(bf16*)(C.ws + WS_ACT), SSQ + (2 * l + 1) * MPAD};
        pg8::gemm_phase<EpiAct, pg8::StaticOrder, true, true>(C.lds, g, S, E); if (!rep) sgemm_phase<2>(C, l); } }
    SEAM(5);
    DUP(6) { if (rep) GRID_SYNC();
    if (IN(6)) { pg8::Gemm g{(const bf16*)(C.ws + WS_ACT), (const bf16*)(C.ws + WS_WDN) + (size_t)l * D * FF, MP, D, FF}; pg8::StaticOrder S; S.init(MP, D, C.G, (int)blockIdx.x);
        EpiRes E{(bf16*)(C.ws + (rep ? WS_Z : WS_HB)), rep ? (float*)(C.ws + WS_GATE) : SSQ + (2 * l + 2) * MPAD};
        pg8::gemm_phase<EpiRes, pg8::StaticOrder, true, true>(C.lds, g, S, E); if (!rep) sgemm_phase<3>(C, l); } }
    SEAM(6);
#undef DUP
#undef IN
#undef SEAM
}
__global__ void __launch_bounds__(NWAVES * 64, 2) mk_fwd(Params P) {
    extern __shared__ __attribute__((aligned(16))) unsigned char smem[];
    Ctx C; C.P = &P; C.lds = (LAS unsigned char*)smem; C.tid = threadIdx.x; C.lane = C.tid & 63; C.wave = __builtin_amdgcn_readfirstlane(C.tid >> 6);
    C.wl = C.lds + C.wave * WLDS;
    C.G = gridDim.x; { const int bx = blockIdx.x; C.vcu = (C.G % 8 == 0) ? (bx % 8) * (C.G / 8) + bx / 8 : bx; }
    C.gw = C.vcu * NWAVES + C.wave; C.NGW = C.G * NWAVES; C.ws = P.ws; C.out = P.out;
    { volatile LAS unsigned* st = (volatile LAS unsigned*)(C.lds + LDS_CTL); if (C.tid < 2) st[C.tid] = 0u; __syncthreads();
      C.xb.bar = (unsigned*)(C.ws + WS_BAR); C.xb.x = 0; C.xb.st = st;
      if (!MK_CGSYNC && P.ph_hi - P.ph_lo > 1) C.xb = xcd_barrier_post((unsigned*)(C.ws + WS_BAR), st); }
    STAMP(0);
    if (P.ph_lo <= 0 && 0 < P.ph_hi) { ph_prologue(C); if ((PROBE_DUP >> 7) & 1) { GRID_SYNC(); ph_prologue(C); } if (1 < P.ph_hi) GRID_SYNC(); }
    STAMP(1);
    layer_phases<0>(C, P);
    layer_phases<1>(C, P);
    if (P.ph_lo <= NPH - 1 && NPH - 1 < P.ph_hi) ph_final(C);
    if (PROBE_T0 >= 0 && blockIdx.x == 0 && threadIdx.x < 32) { const unsigned long long* ts = (const unsigned long long*)(C.ws + WS_TS);
        const float us = (float)(ts[PROBE_T1 < 0 ? 0 : PROBE_T1] - ts[PROBE_T0 < 0 ? 0 : PROBE_T0]) * 0.01f; C.out[O_PM + threadIdx.x] *= 1.0f + sqrtf(us * PROBE_TSCALE); }
}

static int t5_bucket(int n) {
    const int max_exact = 16;
    if (n < max_exact) return n;
    const double scaled = std::log((double)(n < 1 ? 1 : n) / max_exact) / std::log(2048.0 / max_exact);
    int v = max_exact + (int)(scaled * (32 - max_exact));
    return v < 31 ? v : 31;
}

extern "C" void kernel_launch(void* const* d_in, const int* in_sizes, int n_in, void* d_out, int out_size, void* d_ws, size_t ws_size, hipStream_t stream) {
    static int grid = 0;
    if (grid == 0) {
        if (n_in != 22 || (size_t)out_size != O_END || ws_size < WS_END) { fprintf(stderr, "kernel_launch: unexpected shapes n_in %d out %d ws %zu (need %zu)\n", n_in, out_size, ws_size, (size_t)WS_END); grid = -1; return; }
        int dev = 0, cus = 0, per_cu = 0;
        hipGetDevice(&dev); hipDeviceGetAttribute(&cus, hipDeviceAttributeMultiprocessorCount, dev);
        hipFuncSetAttribute((const void*)mk_fwd, hipFuncAttributeMaxDynamicSharedMemorySize, LDS_BYTES);
        hipOccupancyMaxActiveBlocksPerMultiprocessor(&per_cu, (const void*)mk_fwd, NWAVES * 64, LDS_BYTES);
        if (per_cu < 1) { fprintf(stderr, "kernel_launch: occupancy query says %d blocks per CU\n", per_cu); per_cu = 1; }
        (void)hipGetLastError();
        grid = cus;
    }
    if (grid < 0) return;
    Params p{};
    for (int i = 0; i < 22; ++i) p.in[i] = (const float*)d_in[i];
    p.out = (float*)d_out; p.ws = (unsigned char*)d_ws;
    const int dils[3] = {1, 4, 16};
    for (int br = 0; br < 3; ++br) for (int j = 0; j <= 128; ++j) p.bucket[br][j] = (unsigned char)t5_bucket(dils[br] * j);
#if MK_MULTI
    for (int ph = 0; ph < NPH; ++ph) { p.ph_lo = ph; p.ph_hi = ph + 1; hipLaunchKernelGGL(mk_fwd, dim3(grid), dim3(NWAVES * 64), LDS_BYTES, stream, p); }
#else
    p.ph_lo = 0; p.ph_hi = NPH;
    if (hipMemsetAsync((char*)d_ws + WS_BAR, 0, 32768, stream) != hipSuccess) { fprintf(stderr, "kernel_launch: memset of the barrier words failed\n"); return; }
    void* args[] = {&p};
    hipError_t e = hipLaunchCooperativeKernel((const void*)mk_fwd, dim3(grid), dim3(NWAVES * 64), args, LDS_BYTES, stream);
    if (e != hipSuccess) fprintf(stderr, "cooperative launch failed: %s (grid %d)\n", hipGetErrorString(e), grid);
#endif
}
```

```cpp
#include <hip/hip_runtime.h>
#include <hip/hip_cooperative_groups.h>
#include <cstdio>
#include <cstdint>
#include <cmath>
namespace cg = cooperative_groups;

#ifndef MK_CGSYNC
#define MK_CGSYNC 0
#endif
#ifndef PROBE_DUP
#define PROBE_DUP 0
#endif
#ifndef PROBE_T0
#define PROBE_T0 -1
#define PROBE_T1 -1
#endif
#ifndef PROBE_BLK
#define PROBE_BLK 0
#endif
#ifndef PROBE_TSCALE
#define PROBE_TSCALE 1e-6f
#endif
#ifndef MK_MULTI
#define MK_MULTI 0
#endif

namespace pg8 {
#define PG8_LAS __attribute__((address_space(3)))
typedef unsigned short bf16_t;
typedef short bf16x8 __attribute__((ext_vector_type(8)));
typedef float f32x4 __attribute__((ext_vector_type(4)));
typedef unsigned u32x4 __attribute__((ext_vector_type(4)));
constexpr int BM = 256, BK = 64, HALF = 128, HTB = HALF * BK * 2, STAGE_BYTES = 8 * HTB, NXCD = 8, WGM = 8;

__host__ __device__ __forceinline__ int lds_byte(int r, int c) { const int st = (r >> 4) * 2 + (c >> 5), rr = r & 15, cc = c & 31, ob = rr * 64 + cc * 2; return st * 1024 + (ob ^ (((ob >> 9) & 1) << 5)); }
__host__ __device__ __forceinline__ void stage_rc(int b, int& R, int& C) { const int st = b / 1024, sb = b % 1024, swz = sb ^ (((sb >> 9) & 1) << 5); R = (st >> 1) * 16 + swz / 64; C = (st & 1) * 32 + (swz % 64) / 2; }
__host__ __device__ __forceinline__ int perm32(int rho) { const int n = rho >> 4, i = rho & 15; return 8 * (i >> 2) + 4 * n + (i & 3); }

struct Unit { int pm, pn; };
struct Gemm { const bf16_t* A; const bf16_t* Bt; int M, N, K; };

struct StaticOrder {
    int nM, nN, nwg, G, c;
    __host__ __device__ void init(int M, int N, int G_, int c_) { nM = M / BM; nN = N / BM; nwg = nM * nN; G = G_; c = c_; }
    __host__ __device__ bool next(int i, Unit& u) const {
        const long L = (long)i * G + c; if (L >= nwg) return false;
        int wgid = (int)L; { const int q = nwg / NXCD, r = nwg % NXCD, xcd = wgid % NXCD, off = wgid / NXCD; wgid = (xcd < r ? xcd * (q + 1) : r * (q + 1) + (xcd - r) * q) + off; }
        const int nig = WGM * nN, gid = wgid / nig, fm = gid * WGM, gsz = (nM - fm) < WGM ? (nM - fm) : WGM;
        u.pm = fm + ((wgid % nig) % gsz); u.pn = (wgid % nig) / gsz; return true;
    }
    __device__ __forceinline__ void a_ready(const Unit&) const {}
    __device__ __forceinline__ void done(const Unit&) const {}
};

__device__ __forceinline__ unsigned cvt_pk_bf16(float lo, float hi) { unsigned r; asm volatile("v_cvt_pk_bf16_f32 %0, %1, %2" : "=v"(r) : "v"(lo), "v"(hi)); return r; }

template <class Epi, class Sched, bool ALIGN_EPI = false, bool SP2 = false>
__device__ __forceinline__ void gemm_phase(PG8_LAS unsigned char* lds, const Gemm g, const Sched& S, const Epi& E) {
    int tid_ = threadIdx.x; asm volatile("" : "+v"(tid_));
    const int tid = tid_, wid = __builtin_amdgcn_readfirstlane(tid >> 6), lane = tid & 63, wr = wid >> 2, wc = wid & 3, fr = lane & 15, fq = lane >> 4;
    const int K = g.K, nt = K / BK;
    unsigned voffA[2], voffB[2];
#pragma unroll
    for (int i = 0; i < 2; ++i) { int R, C; stage_rc(tid * 16 + i * 8192, R, C); const int Rb = Epi::PERM ? ((R & ~31) + perm32(R & 31)) : R;
        voffA[i] = (unsigned)(R * K + C) * 2u; voffB[i] = (unsigned)(Rb * K + C) * 2u; }
    const size_t kstep = (size_t)(BK * 2);
    const size_t hstep = (size_t)HALF * K * 2;
    const size_t tstep = 2 * hstep;
    const unsigned ldsw = (unsigned)wid * 1024u;
    const int aoff = lds_byte(wr * 64 + fr, fq * 8), boff = lds_byte(wc * 32 + fr, fq * 8);
#define PG8_SA(b, h) (((b) * 2 + (h)) * HTB)
#define PG8_SB(b, h) ((4 + (b) * 2 + (h)) * HTB)
#define PG8_STAGE(bufoff, gbase, voff) do { _Pragma("unroll") for (int _i = 0; _i < 2; ++_i) \
        __builtin_amdgcn_global_load_lds((const unsigned*)((const char*)(gbase) + (voff)[_i]), (PG8_LAS unsigned*)(lds + (bufoff) + ldsw + _i * 8192), 16, 0, 0); } while (0)
#define PG8_LDA(dst, b, h) do { _Pragma("unroll") for (int m = 0; m < 4; ++m) _Pragma("unroll") for (int k = 0; k < 2; ++k) dst[m][k] = *(const PG8_LAS bf16x8*)(lds + PG8_SA(b, h) + aoff + m * 2048 + k * 1024); } while (0)
#define PG8_LDB(dst, b, h) do { _Pragma("unroll") for (int n = 0; n < 2; ++n) _Pragma("unroll") for (int k = 0; k < 2; ++k) dst[n][k] = *(const PG8_LAS bf16x8*)(lds + PG8_SB(b, h) + boff + n * 2048 + k * 1024); } while (0)
#define PG8_MMA(ai, bj, At, Bt) do { __builtin_amdgcn_s_setprio(1); _Pragma("unroll") for (int m = 0; m < 4; ++m) _Pragma("unroll") for (int n = 0; n < 2; ++n) _Pragma("unroll") for (int k = 0; k < 2; ++k) \
        acc[ai][bj][m][n] = __builtin_amdgcn_mfma_f32_16x16x32_bf16(Bt[n][k], At[m][k], acc[ai][bj][m][n], 0, 0, 0); __builtin_amdgcn_s_setprio(0); } while (0)
#define PG8_WAIT_V(n) asm volatile("s_waitcnt vmcnt(" #n ")" ::: "memory")
#define PG8_WAIT_L(n) asm volatile("s_waitcnt lgkmcnt(" #n ")" ::: "memory")
#define PG8_BAR __builtin_amdgcn_s_barrier()
#define PG8_SCHED __builtin_amdgcn_sched_barrier(0)
    Unit cur, nxt; int ui = 0;
    if (!S.next(0, cur)) return;
    f32x4 acc[2][2][4][2];
#pragma unroll
    for (int a = 0; a < 2; ++a)
#pragma unroll
        for (int b = 0; b < 2; ++b)
#pragma unroll
            for (int m = 0; m < 4; ++m)
#pragma unroll
                for (int n = 0; n < 2; ++n) acc[a][b][m][n] = (f32x4){0.f, 0.f, 0.f, 0.f};
    bf16x8 At[4][2], B0[2][2], B1[2][2];
    const char* cA = (const char*)g.A + (size_t)cur.pm * tstep; const char* cB = (const char*)g.Bt + (size_t)cur.pn * tstep;
    S.a_ready(cur);
    if constexpr (SP2) {
        PG8_STAGE(PG8_SB(0, 0), cB, voffB); PG8_STAGE(PG8_SB(0, 1), cB + hstep, voffB); PG8_STAGE(PG8_SA(0, 0), cA, voffA); PG8_STAGE(PG8_SA(0, 1), cA + hstep, voffA);
        if (wr == 1) PG8_BAR;
        PG8_WAIT_V(2); PG8_BAR;
        PG8_STAGE(PG8_SB(1, 0), cB + kstep, voffB); PG8_STAGE(PG8_SA(1, 0), cA + kstep, voffA); PG8_STAGE(PG8_SB(1, 1), cB + hstep + kstep, voffB);
        PG8_WAIT_V(6); PG8_BAR;
    } else {
        PG8_STAGE(PG8_SB(0, 0), cB, voffB); PG8_STAGE(PG8_SA(0, 0), cA, voffA); PG8_STAGE(PG8_SB(0, 1), cB + hstep, voffB); PG8_STAGE(PG8_SA(0, 1), cA + hstep, voffA);
        if (wr == 1) PG8_BAR;
        PG8_WAIT_V(4); PG8_BAR;
        PG8_STAGE(PG8_SB(1, 0), cB + kstep, voffB); PG8_STAGE(PG8_SA(1, 0), cA + kstep, voffA); PG8_STAGE(PG8_SB(1, 1), cB + hstep + kstep, voffB);
        PG8_WAIT_V(6); PG8_BAR;
    }
    for (;;) {
        const bool has_next = S.next(ui + 1, nxt);
        const char* nA = has_next ? (const char*)g.A + (size_t)nxt.pm * tstep : cA; const char* nB = has_next ? (const char*)g.Bt + (size_t)nxt.pn * tstep : cB;
        for (int t = 0; t < nt; t += 2) {
            const bool last = (t == nt - 2);
            const char* a1 = cA + (size_t)(t + 1) * kstep;
            const char* a2 = last ? nA : cA + (size_t)(t + 2) * kstep; const char* b2 = last ? nB : cB + (size_t)(t + 2) * kstep;
            const char* a3 = a2 + kstep; const char* b3 = b2 + kstep;
            if (last && has_next) S.a_ready(nxt);
            if constexpr (SP2) {
            PG8_LDB(B0, 0, 0); PG8_LDB(B1, 0, 1); PG8_SCHED; PG8_LDA(At, 0, 0); PG8_STAGE(PG8_SA(1, 1), a1 + hstep, voffA);
            PG8_WAIT_V(8); PG8_WAIT_L(0); PG8_BAR; PG8_MMA(0, 0, At, B0); PG8_MMA(0, 1, At, B1); PG8_BAR; PG8_SCHED;
            PG8_LDA(At, 0, 1); PG8_STAGE(PG8_SB(0, 0), b2, voffB); PG8_STAGE(PG8_SB(0, 1), b2 + hstep, voffB); PG8_STAGE(PG8_SA(0, 0), a2, voffA);
            PG8_WAIT_V(8); PG8_WAIT_L(0); PG8_BAR; PG8_MMA(1, 0, At, B0); PG8_MMA(1, 1, At, B1); PG8_BAR; PG8_SCHED;
            PG8_LDB(B0, 1, 0); PG8_LDB(B1, 1, 1); PG8_SCHED; PG8_LDA(At, 1, 0); PG8_STAGE(PG8_SA(0, 1), a2 + hstep, voffA);
            PG8_WAIT_V(8); PG8_WAIT_L(0); PG8_BAR; PG8_MMA(0, 0, At, B0); PG8_MMA(0, 1, At, B1); PG8_BAR; PG8_SCHED;
            PG8_LDA(At, 1, 1); PG8_STAGE(PG8_SB(1, 0), b3, voffB); PG8_STAGE(PG8_SB(1, 1), b3 + hstep, voffB); PG8_STAGE(PG8_SA(1, 0), a3, voffA);
            PG8_WAIT_V(8); PG8_WAIT_L(0); PG8_BAR; PG8_MMA(1, 0, At, B0); PG8_MMA(1, 1, At, B1); PG8_BAR; PG8_SCHED;
            } else {
            PG8_LDB(B0, 0, 0); PG8_SCHED; PG8_LDA(At, 0, 0); PG8_STAGE(PG8_SA(1, 1), a1 + hstep, voffA);
            PG8_WAIT_L(8); PG8_BAR; PG8_WAIT_L(0); PG8_MMA(0, 0, At, B0); PG8_BAR; PG8_SCHED;
            PG8_LDB(B1, 0, 1); PG8_STAGE(PG8_SB(0, 0), b2, voffB);
            PG8_BAR; PG8_WAIT_L(0); PG8_MMA(0, 1, At, B1); PG8_BAR;
            PG8_LDA(At, 0, 1); PG8_STAGE(PG8_SA(0, 0), a2, voffA);
            PG8_BAR; PG8_WAIT_L(0); PG8_MMA(1, 0, At, B0); PG8_BAR; PG8_SCHED;
            PG8_STAGE(PG8_SB(0, 1), b2 + hstep, voffB);
            PG8_WAIT_V(6); PG8_BAR; PG8_MMA(1, 1, At, B1); PG8_BAR;
            PG8_LDB(B0, 1, 0); PG8_SCHED; PG8_LDA(At, 1, 0); PG8_STAGE(PG8_SA(0, 1), a2 + hstep, voffA);
            PG8_WAIT_L(8); PG8_BAR; PG8_WAIT_L(0); PG8_MMA(0, 0, At, B0); PG8_BAR; PG8_SCHED;
            PG8_LDB(B1, 1, 1); PG8_STAGE(PG8_SB(1, 0), b3, voffB);
            PG8_BAR; PG8_WAIT_L(0); PG8_MMA(0, 1, At, B1); PG8_BAR;
            PG8_LDA(At, 1, 1); PG8_STAGE(PG8_SA(1, 0), a3, voffA);
            PG8_BAR; PG8_WAIT_L(0); PG8_MMA(1, 0, At, B0); PG8_BAR; PG8_SCHED;
            PG8_STAGE(PG8_SB(1, 1), b3 + hstep, voffB);
            PG8_WAIT_V(6); PG8_BAR; PG8_MMA(1, 1, At, B1); PG8_BAR;
            }
        }
        if constexpr (ALIGN_EPI) { if (wr == 0) PG8_BAR; }
        E(acc, cur, wr, wc, fr, fq);
        if (!has_next) break;
#pragma unroll
        for (int a = 0; a < 2; ++a)
#pragma unroll
            for (int b = 0; b < 2; ++b)
#pragma unroll
                for (int m = 0; m < 4; ++m)
#pragma unroll
                    for (int n = 0; n < 2; ++n) acc[a][b][m][n] = (f32x4){0.f, 0.f, 0.f, 0.f};
        cur = nxt; cA = nA; cB = nB; ++ui;
        if constexpr (ALIGN_EPI) { if (wr == 1) PG8_BAR; }
    }
    PG8_WAIT_V(0);
    if constexpr (!ALIGN_EPI) { if (wr == 0) PG8_BAR; }
    PG8_BAR;
#undef PG8_SA
#undef PG8_SB
#undef PG8_STAGE
#undef PG8_LDA
#undef PG8_LDB
#undef PG8_MMA
#undef PG8_WAIT_V
#undef PG8_WAIT_L
#undef PG8_BAR
#undef PG8_SCHED
}
}

#define LAS __attribute__((address_space(3)))
#define DI __device__ __forceinline__
typedef unsigned short bf16;
typedef short bf16x8 __attribute__((ext_vector_type(8)));
typedef short s16x4 __attribute__((ext_vector_type(4)));
typedef float f32x16 __attribute__((ext_vector_type(16)));
typedef float f32x4 __attribute__((ext_vector_type(4)));
typedef float f32x2 __attribute__((ext_vector_type(2)));
typedef unsigned u32x4 __attribute__((ext_vector_type(4)));
typedef unsigned u32x2 __attribute__((ext_vector_type(2)));
typedef __bf16 bf16x2_t __attribute__((ext_vector_type(2)));
typedef short v4i16_t __attribute__((ext_vector_type(4)));

constexpr int D = 1024, SEQ = 4096, NB = 4, MP = NB * SEQ, SB = 32, STK = 4, MS = SB * STK, MT = MP + MS, MPAD = 16640;
constexpr int NZ = 3840, FF = 4096, NWAVES = 8, NCHUNK = 64, WB = 2048;
constexpr int ZQ = 0, ZK = 512, ZV = 1024, ZMQ = 1536, ZMK = 1792, ZMV = 2048, ZMO = 2304, ZHQ = 2560, ZHF = 2816, ZHI = 3072, ZHG = 3328, ZG = 3584;
constexpr float EPS = 1e-6f;
constexpr float LOG2E = 1.4426950408889634f;

constexpr size_t O_YP = 0, O_YS = O_YP + (size_t)MP * D, O_PK = O_YS + (size_t)MS * D, O_PV = O_PK + (size_t)2 * NB * WB * 512, O_PCONV = O_PV + (size_t)2 * NB * WB * 512,
    O_PC = O_PCONV + 2 * NB * 3 * 512, O_PN = O_PC + 2 * NB * 4 * 4096, O_PM = O_PN + 2 * NB * 4 * 64, O_PS = O_PM + 2 * NB * 4, O_SK = O_PS + 2 * NB * 4 * 4096,
    O_SV = O_SK + (size_t)2 * SB * STK * 512, O_SCONV = O_SV + (size_t)2 * SB * STK * 512, O_SC = O_SCONV + 2 * SB * 3 * 512, O_SN = O_SC + (size_t)2 * SB * 4 * 4096,
    O_SM = O_SN + 2 * SB * 4 * 64, O_SS = O_SM + 2 * SB * 4, O_END = O_SS + (size_t)2 * SB * 4 * 4096;

constexpr size_t al256(size_t x) { return (x + 255) & ~(size_t)255; }
constexpr size_t WS_WIN = 0;
constexpr size_t WS_WOUT = WS_WIN + (size_t)2 * NZ * D * 2;
constexpr size_t WS_WUP = WS_WOUT + (size_t)2 * D * D * 2;
constexpr size_t WS_WDN = WS_WUP + (size_t)2 * FF * D * 2;
constexpr size_t WS_H = WS_WDN + (size_t)2 * D * FF * 2;
constexpr size_t WS_HB = WS_H + (size_t)MPAD * D * 4;
constexpr size_t WS_SSQ = WS_HB + (size_t)MPAD * D * 2;
constexpr size_t WS_Z = al256(WS_SSQ + (size_t)5 * MPAD * 4);
constexpr size_t WS_GATE = WS_Z + (size_t)MPAD * NZ * 2;
constexpr size_t WS_MIX = WS_GATE + (size_t)MPAD * 8 * 4;
constexpr size_t WS_ACT = WS_MIX + (size_t)MPAD * D * 2;
constexpr size_t WS_PO = WS_ACT + (size_t)MPAD * FF * 2;
constexpr size_t WS_PLSE = WS_PO + (size_t)2 * MP * 512 * 2;
constexpr size_t WS_BIAST = WS_PLSE + (size_t)2 * MP * 8 * 4;
constexpr size_t WS_LBV = al256(WS_BIAST + 3 * 8 * 132 * 4);
constexpr size_t WS_MLQC = WS_LBV + 2 * 256 * 4;
constexpr size_t WS_MLKC = WS_MLQC + (size_t)MP * 256 * 2;
constexpr size_t WS_MLB = WS_MLKC + (size_t)MP * 256 * 2;
constexpr size_t WS_MLU = WS_MLB + (size_t)16 * SEQ * 4;
constexpr size_t WS_MLA = WS_MLU + (size_t)16 * SEQ * 4;
constexpr size_t WS_MLBL = WS_MLA + 16 * 64 * 4;
constexpr size_t WS_MLMC = WS_MLBL + 16 * 64 * 4;
constexpr size_t WS_MLKVT = WS_MLMC + 16 * 64 * 4;
constexpr size_t WS_MLKN = WS_MLKVT + (size_t)16 * 64 * 4096 * 4;
constexpr size_t WS_MLCT = WS_MLKN + (size_t)16 * 64 * 64 * 4;
constexpr size_t WS_MLNC = WS_MLCT + (size_t)16 * 64 * 4096 * 2;
constexpr size_t WS_HGQT = WS_MLNC + (size_t)16 * 64 * 64 * 4;
constexpr size_t WS_HGKT = WS_HGQT + (size_t)MP * 256 * 2;
constexpr size_t WS_HGQB = WS_HGKT + (size_t)MP * 256 * 2;
constexpr size_t WS_HGGT = WS_HGQB + (size_t)MP * 256 * 2;
constexpr size_t WS_HGDL = WS_HGGT + (size_t)16 * 64 * 4096 * 4;
constexpr size_t WS_HGST = WS_HGDL + (size_t)16 * 64 * 64 * 4;
constexpr size_t WS_BAR = WS_HGST + (size_t)16 * 64 * 4096 * 2;
constexpr size_t WS_KC = WS_BAR + 32768;
constexpr size_t WS_VC = WS_KC + (size_t)NB * 8 * SEQ * 64 * 2;
constexpr size_t WS_SAP = WS_VC + (size_t)NB * 8 * SEQ * 64 * 2;
constexpr size_t WS_TS = WS_SAP + (size_t)3072 * 68 * 4;
constexpr size_t WS_END = WS_TS + 512;

constexpr int LDS_BYTES = 147456 + 256;
constexpr int LDS_CTL = 147456;
constexpr int WLDS = 18432;
constexpr int VSTR = 144;

struct Params {
    const float* in[22];
    float* out;
    unsigned char* ws;
    int ph_lo, ph_hi;
    unsigned char bucket[3][136];
};

DI float bf2f(bf16 v) { return __builtin_bit_cast(float, (unsigned)v << 16); }
DI unsigned pk2(float lo, float hi) { f32x2 v = {lo, hi}; bf16x2_t b = __builtin_convertvector(v, bf16x2_t); return __builtin_bit_cast(unsigned, b); }
DI bf16 f2bf(float x) { return (bf16)(pk2(x, 0.f) & 0xffffu); }
DI float lo16(unsigned w) { return __builtin_bit_cast(float, w << 16); }
DI float hi16(unsigned w) { return __builtin_bit_cast(float, w & 0xffff0000u); }
DI int crow(int reg, int hh) { return (reg & 3) + 8 * (reg >> 2) + 4 * hh; }
DI bf16x8 ldg8(const bf16* p) { return *(const bf16x8*)p; }
DI float fexp(float x) { return __builtin_amdgcn_exp2f(x * LOG2E); }
DI float flog(float x) { return __builtin_amdgcn_logf(x) * 0.6931471805599453f; }
DI float sigm(float x) { return __builtin_amdgcn_rcpf(1.0f + fexp(-x)); }
DI float silu(float x) { return x * sigm(x); }
DI float logsig(float x) { return fminf(x, 0.f) - flog(1.0f + fexp(-fabsf(x))); }
DI float wave_sum(float v) {
#pragma unroll
    for (int o = 1; o < 64; o <<= 1) v += __shfl_xor(v, o);
    return v; }
DI float wave_max(float v) {
#pragma unroll
    for (int o = 1; o < 64; o <<= 1) v = fmaxf(v, __shfl_xor(v, o));
    return v; }
#define MFMA32(a, b, c) __builtin_amdgcn_mfma_f32_32x32x16_bf16((a), (b), (c), 0, 0, 0)
DI bf16x8 pack8(const f32x16& x, int s) {
    u32x4 p; p.x = pk2(x[8 * s], x[8 * s + 1]); p.y = pk2(x[8 * s + 2], x[8 * s + 3]); p.z = pk2(x[8 * s + 4], x[8 * s + 5]); p.w = pk2(x[8 * s + 6], x[8 * s + 7]);
    return __builtin_bit_cast(bf16x8, p); }
DI s16x4 vtr(LAS const unsigned char* p) { return __builtin_bit_cast(s16x4, __builtin_amdgcn_ds_read_tr16_b64_v4i16((LAS v4i16_t*)p)); }
template <bool PERMK> DI bf16x8 tr_frag(LAS const unsigned char* tile, int k0, int n0, int lane) {
    const int hh = lane >> 5, q = (lane & 15) >> 2, col = n0 + 16 * ((lane >> 4) & 1) + 4 * (lane & 3);
    const int r1 = k0 + (PERMK ? 4 * hh : 8 * hh) + q, r2 = r1 + (PERMK ? 8 : 4);
    const s16x4 lo = vtr(tile + r1 * VSTR + col * 2), hi = vtr(tile + r2 * VSTR + col * 2);
    return __builtin_shufflevector(lo, hi, 0, 1, 2, 3, 4, 5, 6, 7); }
DI f32x16 zero16() { f32x16 z; for (int i = 0; i < 16; ++i) z[i] = 0.f; return z; }

struct XcdBarrier { unsigned* bar; unsigned x; volatile LAS unsigned* st; };
struct Ctx {
    const Params* P; LAS unsigned char* lds; LAS unsigned char* wl; int tid, lane, wave, vcu, G, gw, NGW;
    unsigned char* ws; float* out; XcdBarrier xb;
};

DI Ctx fresh(const Ctx& C0) { return C0; }
struct EpiZ {
    static constexpr bool PERM = true;
    bf16* Z; const float* ssq; float* gate; bf16* KV;
    DI void operator()(const f32x4 (&acc)[2][2][4][2], const pg8::Unit& u, int wr, int wc, int fr, int fq) const {
        const int row0 = u.pm * 256 + wr * 64 + fr, col0 = u.pn * 256 + wc * 32 + 8 * fq;
#pragma unroll
        for (int ai = 0; ai < 2; ++ai)
#pragma unroll
            for (int m = 0; m < 4; ++m) { const int row = row0 + ai * 128 + m * 16; const float rs = __builtin_amdgcn_rsqf(ssq[row] * (1.0f / D) + EPS);
                bf16* rowp = Z + (size_t)row * NZ + col0;
#pragma unroll
                for (int bj = 0; bj < 2; ++bj) { const f32x4 v0 = acc[ai][bj][m][0] * rs, v1 = acc[ai][bj][m][1] * rs;
                    u32x4 w; w.x = pk2(v0[0], v0[1]); w.y = pk2(v0[2], v0[3]); w.z = pk2(v1[0], v1[1]); w.w = pk2(v1[2], v1[3]);
                    if (u.pn >= 2 && u.pn <= 5) { const int hc = col0 + bj * 128 - 512, kv = hc >> 9, head = (hc >> 6) & 7, d = hc & 63;
                        *(u32x4*)(KV + (size_t)kv * ((size_t)NB * 8 * SEQ * 64) + ((size_t)((row >> 12) * 8 + head) * SEQ + (row & (SEQ - 1))) * 64 + d) = w; }
                    else *(u32x4*)(rowp + bj * 128) = w;
                    if (u.pn == 14 && bj == 0 && col0 == ZG) { *(f32x4*)(gate + (size_t)row * 8) = v0; *(f32x4*)(gate + (size_t)row * 8 + 4) = v1; } } }
    }
};
struct EpiAct {
    static constexpr bool PERM = true;
    bf16* O; const float* ssq;
    DI void operator()(const f32x4 (&acc)[2][2][4][2], const pg8::Unit& u, int wr, int wc, int fr, int fq) const {
        const int row0 = u.pm * 256 + wr * 64 + fr, col0 = u.pn * 256 + wc * 32 + 8 * fq;
#pragma unroll
        for (int ai = 0; ai < 2; ++ai)
#pragma unroll
            for (int m = 0; m < 4; ++m) { const int row = row0 + ai * 128 + m * 16; const float rs = __builtin_amdgcn_rsqf(ssq[row] * (1.0f / D) + EPS);
                bf16* rowp = O + (size_t)row * FF + col0;
#pragma unroll
                for (int bj = 0; bj < 2; ++bj) { f32x4 v0 = acc[ai][bj][m][0] * rs, v1 = acc[ai][bj][m][1] * rs;
#pragma unroll
                    for (int j = 0; j < 4; ++j) { const float a = fmaxf(v0[j], 0.f), b = fmaxf(v1[j], 0.f); v0[j] = a * a; v1[j] = b * b; }
                    u32x4 w; w.x = pk2(v0[0], v0[1]); w.y = pk2(v0[2], v0[3]); w.z = pk2(v1[0], v1[1]); w.w = pk2(v1[2], v1[3]);
                    *(u32x4*)(rowp + bj * 128) = w; } }
    }
};
struct EpiRes {
    static constexpr bool PERM = true;
    bf16* HB; float* ssq;
    DI void operator()(const f32x4 (&acc)[2][2][4][2], const pg8::Unit& u, int wr, int wc, int fr, int fq) const {
        const int row0 = u.pm * 256 + wr * 64 + fr, col0 = u.pn * 256 + wc * 32 + 8 * fq;
#pragma unroll
        for (int ai = 0; ai < 2; ++ai)
#pragma unroll
            for (int m = 0; m < 4; ++m) { const int row = row0 + ai * 128 + m * 16; bf16* bp = HB + (size_t)row * D + col0; float s = 0.f;
#pragma unroll
                for (int bj = 0; bj < 2; ++bj) { const u32x4 hw = *(const u32x4*)(bp + bj * 128); const f32x4 a0 = acc[ai][bj][m][0], a1 = acc[ai][bj][m][1];
                    const float x0 = lo16(hw.x) + a0[0], x1 = hi16(hw.x) + a0[1], x2 = lo16(hw.y) + a0[2], x3 = hi16(hw.y) + a0[3];
                    const float x4 = lo16(hw.z) + a1[0], x5 = hi16(hw.z) + a1[1], x6 = lo16(hw.w) + a1[2], x7 = hi16(hw.w) + a1[3];
                    u32x4 w; w.x = pk2(x0, x1); w.y = pk2(x2, x3); w.z = pk2(x4, x5); w.w = pk2(x6, x7); *(u32x4*)(bp + bj * 128) = w;
                    s += ((x0 * x0 + x1 * x1) + (x2 * x2 + x3 * x3)) + ((x4 * x4 + x5 * x5) + (x6 * x6 + x7 * x7)); }
                s += __shfl_xor(s, 16); s += __shfl_xor(s, 32);
                if (fq == 0) atomicAdd(ssq + row, s); }
    }
};

DI void transpose_item(const float* __restrict__ W, int Nsrc, int src_c0, int nvalid, const float* __restrict__ gs, bf16* __restrict__ WT, int K, int dst_row0, int k0, LAS float* scr, int lane) {
    const int n4 = 4 * (lane & 15);
    f32x4 v[16];
#pragma unroll
    for (int i = 0; i < 16; ++i) { const int kk = 4 * i + (lane >> 4);
        v[i] = (n4 < nvalid) ? __builtin_nontemporal_load((const f32x4*)(W + (size_t)(k0 + kk) * Nsrc + src_c0 + n4)) : (f32x4){0.f, 0.f, 0.f, 0.f}; }
#pragma unroll
    for (int i = 0; i < 16; ++i) { const int kk = 4 * i + (lane >> 4); const float g = gs ? gs[k0 + kk] : 1.0f;
        scr[kk * 65 + n4] = v[i].x * g; scr[kk * 65 + n4 + 1] = v[i].y * g; scr[kk * 65 + n4 + 2] = v[i].z * g; scr[kk * 65 + n4 + 3] = v[i].w * g; }
    asm volatile("s_waitcnt lgkmcnt(0)" ::: "memory");
    const int c = lane & 7;
#pragma unroll
    for (int j = 0; j < 8; ++j) { const int n = (lane >> 3) + 8 * j; const LAS float* s = scr + (8 * c) * 65 + n;
        u32x4 o; o.x = pk2(s[0 * 65], s[1 * 65]); o.y = pk2(s[2 * 65], s[3 * 65]); o.z = pk2(s[4 * 65], s[5 * 65]); o.w = pk2(s[6 * 65], s[7 * 65]);
        *(u32x4*)(WT + (size_t)(dst_row0 + n) * K + k0 + 8 * c) = o; }
    asm volatile("s_waitcnt lgkmcnt(0)" ::: "memory");
}
DI void convert_weights(const Ctx& C, int l, int w0, int nw) {
    const Params& P = *C.P; const int lane = C.lane;
    LAS float* scr = (LAS float*)C.wl;
    constexpr int I_IN = 16 * (NZ / 64), I_OUT = 16 * (D / 64), I_UP = 16 * (FF / 64), I_DN = 64 * (D / 64), I_L = I_IN + I_OUT + I_UP + I_DN;
    for (int it = w0; it < I_L; it += nw) {
        int r = it;
        if (r < I_IN) { const int nb = r % (NZ / 64), kb = r / (NZ / 64), n0 = nb * 64;
            int c0, nv;
            if (n0 < 2560) { c0 = n0; nv = 64; } else if (n0 < ZG) { c0 = n0 + 8; nv = 64; } else if (n0 == ZG) { c0 = 2560; nv = 8; } else { c0 = 0; nv = 0; }
            transpose_item(P.in[11] + (size_t)l * D * 3592, 3592, c0, nv, P.in[10] + l * D, (bf16*)(C.ws + WS_WIN) + (size_t)l * NZ * D, D, n0, kb * 64, scr, lane); continue; }
        r -= I_IN;
        if (r < I_OUT) { const int nb = r % (D / 64), kb = r / (D / 64);
            transpose_item(P.in[17] + (size_t)l * D * D, D, nb * 64, 64, nullptr, (bf16*)(C.ws + WS_WOUT) + (size_t)l * D * D, D, nb * 64, kb * 64, scr, lane); continue; }
        r -= I_OUT;
        if (r < I_UP) { const int nb = r % (FF / 64), kb = r / (FF / 64);
            transpose_item(P.in[19] + (size_t)l * D * FF, FF, nb * 64, 64, P.in[18] + l * D, (bf16*)(C.ws + WS_WUP) + (size_t)l * FF * D, D, nb * 64, kb * 64, scr, lane); continue; }
        r -= I_UP;
        { const int nb = r % (D / 64), kb = r / (D / 64);
            transpose_item(P.in[20] + (size_t)l * FF * D, D, nb * 64, 64, nullptr, (bf16*)(C.ws + WS_WDN) + (size_t)l * D * FF, FF, nb * 64, kb * 64, scr, lane); }
    }
}
DI void ph_prologue(const Ctx& C) {
    const Params& P = *C.P; const int lane = C.lane;
    convert_weights(C, 0, C.gw, C.NGW);
    bf16* HB = (bf16*)(C.ws + WS_HB); float* SSQ = (float*)(C.ws + WS_SSQ);
#pragma unroll 2
    for (int m = C.gw; m < MPAD; m += C.NGW) {
        f32x4 v[4]; float s = 0.f;
        if (m < MT) { const float* xr = (m < MP) ? P.in[0] + (size_t)m * D : P.in[1] + (size_t)(m - MP) * D;
#pragma unroll
            for (int j = 0; j < 4; ++j) { v[j] = __builtin_nontemporal_load((const f32x4*)(xr + 4 * lane + 256 * j)); s += (v[j].x * v[j].x + v[j].y * v[j].y) + (v[j].z * v[j].z + v[j].w * v[j].w); }
        } else {
#pragma unroll
            for (int j = 0; j < 4; ++j) v[j] = (f32x4){0.f, 0.f, 0.f, 0.f}; }
        s = wave_sum(s);
#pragma unroll
        for (int j = 0; j < 4; ++j) { u32x2 w; w.x = pk2(v[j].x, v[j].y); w.y = pk2(v[j].z, v[j].w); *(u32x2*)(HB + (size_t)m * D + 4 * lane + 256 * j) = w; }
        if (lane == 0) SSQ[m] = s;
    }
    for (int i = C.gw * 64 + lane; i < 4 * MPAD; i += C.NGW * 64) SSQ[MPAD + i] = 0.f;
    float* BT = (float*)(C.ws + WS_BIAST);
    for (int i = C.gw * 64 + lane; i < 3 * 8 * 132; i += C.NGW * 64) { const int br = i / (8 * 132), h = (i / 132) % 8, j = i % 132; BT[i] = (j <= 128) ? P.in[9][(int)P.bucket[br][j] * 8 + h] : 0.f; }
    float* LBV = (float*)(C.ws + WS_LBV);
    for (int i = C.gw * 64 + lane; i < 512; i += C.NGW * 64) { const int c = i & 255; LBV[i] = (i < 256) ? 0.f : sigm(P.in[15][256 + c] - P.in[15][c]); }
}

DI void attn_step(f32x16& S, float& mx, float& lsum, f32x16 (&O)[2], const LAS float* bp, LAS const unsigned char* vt, int lane) {
    constexpr float SC = 0.125f * LOG2E;
    float tm = -1e30f;
#pragma unroll
    for (int reg = 0; reg < 16; ++reg) { const float sc = S[reg] * SC + bp[(reg & 3) + 8 * (reg >> 2)]; S[reg] = sc; tm = fmaxf(tm, sc); }
    tm = fmaxf(tm, __shfl_xor(tm, 32));
    const float mn = fmaxf(mx, tm), alpha = __builtin_amdgcn_exp2f(mx - mn); mx = mn;
    float ps = 0.f;
#pragma unroll
    for (int reg = 0; reg < 16; ++reg) { const float pe = __builtin_amdgcn_exp2f(S[reg] - mn); S[reg] = pe; ps += pe; }
    lsum = lsum * alpha + ps;
#pragma unroll
    for (int reg = 0; reg < 16; ++reg) { O[0][reg] *= alpha; O[1][reg] *= alpha; }
#pragma unroll
    for (int ks = 0; ks < 2; ++ks) { const bf16x8 pf = pack8(S, ks);
#pragma unroll
        for (int db = 0; db < 2; ++db) O[db] = MFMA32(tr_frag<true>(vt, 16 * ks, 32 * db, lane), pf, O[db]); }
}
template <int br> DI void attn_unit(const Ctx& C, int l, int u) {
    const int lane = C.lane, t = lane & 31, hh = lane >> 5;
    constexpr int dil = br == 0 ? 1 : (br == 1 ? 4 : 16), npair = 64 / dil;
    const int bh = u >> 6, rem = u & 63, r = rem / npair, p = rem % npair, b = bh >> 3, h = bh & 7, i0 = p * 64;
    const bf16* zb = (const bf16*)(C.ws + WS_Z) + (size_t)(b * SEQ) * NZ;
    const float* BT = (const float*)(C.ws + WS_BIAST) + (br * 8 + h) * 132;
    LAS float* btl = (LAS float*)(C.wl + 64 * VSTR) + 64;
    bf16x8 qf[2][4];
#pragma unroll
    for (int qb = 0; qb < 2; ++qb)
#pragma unroll
        for (int s = 0; s < 4; ++s) qf[qb][s] = ldg8(zb + (size_t)((i0 + 32 * qb + t) * dil + r) * NZ + ZQ + h * 64 + 16 * s + 8 * hh);
    btl[lane - 64] = -1e30f; btl[lane + 129] = -1e30f;
    btl[128 - lane] = BT[lane] * LOG2E; btl[64 - lane] = BT[lane + 64] * LOG2E; if (lane == 0) btl[0] = BT[128] * LOG2E;
    const int kt0 = p < 2 ? 4 - 2 * p : 0;
    const ptrdiff_t tile_step = (ptrdiff_t)32 * dil * 64;
    const bf16* kb_ = (const bf16*)(C.ws + WS_KC) + (size_t)(b * 8 + h) * SEQ * 64; const bf16* vb_ = (const bf16*)(C.ws + WS_VC) + (size_t)(b * 8 + h) * SEQ * 64;
    const bf16* kp = kb_ + ((ptrdiff_t)(i0 - 128 + (lane >> 3)) * dil + r) * 64 + 8 * (lane & 7) + kt0 * tile_step;
    const bf16* vp = vb_ + ((ptrdiff_t)(i0 - 128 + (lane >> 3)) * dil + r) * 64 + 8 * (lane & 7) + kt0 * tile_step;
    f32x16 O[2][2]; O[0][0] = zero16(); O[0][1] = zero16(); O[1][0] = zero16(); O[1][1] = zero16();
    float mx[2] = {-1e30f, -1e30f}, lsum[2] = {0.f, 0.f};
    bf16x8 kf[4], vf[4];
#pragma unroll
    for (int s = 0; s < 4; ++s) { kf[s] = ldg8(kp + (ptrdiff_t)(8 * s) * dil * 64); vf[s] = ldg8(vp + (ptrdiff_t)(8 * s) * dil * 64); }
    LAS unsigned char* ktile = C.wl + 72 * VSTR;
#pragma unroll 1
    for (int kt = kt0; kt < 6; ++kt) {
        f32x16 S[2];
#pragma unroll
        for (int i = 0; i < 4; ++i) *(LAS bf16x8*)(ktile + ((lane >> 3) + 8 * i) * VSTR + (lane & 7) * 16) = kf[i];
        { bf16x8 ka[4];
#pragma unroll
          for (int s = 0; s < 4; ++s) ka[s] = *(LAS const bf16x8*)(ktile + t * VSTR + 32 * s + 16 * hh);
#pragma unroll
          for (int qb = 0; qb < 2; ++qb) { S[qb] = zero16();
#pragma unroll
            for (int s = 0; s < 4; ++s) S[qb] = MFMA32(ka[s], qf[qb][s], S[qb]); } }
        LAS unsigned char* vt = C.wl + (kt & 1) * (32 * VSTR);
#pragma unroll
        for (int i = 0; i < 4; ++i) *(LAS bf16x8*)(vt + ((lane >> 3) + 8 * i) * VSTR + (lane & 7) * 16) = vf[i];
        if (kt < 5) { kp += tile_step; vp += tile_step;
#pragma unroll
            for (int s = 0; s < 4; ++s) { kf[s] = ldg8(kp + (ptrdiff_t)(8 * s) * dil * 64); vf[s] = ldg8(vp + (ptrdiff_t)(8 * s) * dil * 64); } }
        const LAS float* bpA = btl + (32 * kt - t + 4 * hh); const LAS float* bpB = bpA - 32;
        if (kt <= 4) attn_step(S[0], mx[0], lsum[0], O[0], bpA, vt, lane);
        __builtin_amdgcn_sched_barrier(0);
        if (kt >= 1) attn_step(S[1], mx[1], lsum[1], O[1], bpB, vt, lane);
    }
    LAS unsigned char* T0 = C.wl; LAS unsigned char* T1 = C.wl + 32 * VSTR; LAS unsigned char* T2 = ktile;
#pragma unroll
    for (int qb = 0; qb < 2; ++qb) {
        const size_t rowr = (size_t)b * SEQ + (size_t)(i0 + 32 * qb + (lane >> 3)) * dil + r;
        float ls = lsum[qb]; ls += __shfl_xor(ls, 32);
        const float inv = 1.0f / ls, lse = (mx[qb] + __builtin_amdgcn_logf(ls)) * 0.6931471805599453f;
        const size_t row = (size_t)b * SEQ + (i0 + 32 * qb + t) * dil + r;
        if (br != 0) {
#pragma unroll
            for (int db = 0; db < 2; ++db)
#pragma unroll
                for (int g = 0; g < 4; ++g) { u32x2 w; w.x = pk2(O[qb][db][4 * g] * inv, O[qb][db][4 * g + 1] * inv); w.y = pk2(O[qb][db][4 * g + 2] * inv, O[qb][db][4 * g + 3] * inv);
                    *(LAS u32x2*)(T2 + t * VSTR + (32 * db + 8 * g + 4 * hh) * 2) = w; }
            bf16* po = (bf16*)(C.ws + WS_PO) + (size_t)(br - 1) * MP * 512 + h * 64 + 8 * (lane & 7);
#pragma unroll
            for (int i = 0; i < 4; ++i) *(u32x4*)(po + (rowr + (size_t)(8 * i) * dil) * 512) = *(LAS const u32x4*)(T2 + ((lane >> 3) + 8 * i) * VSTR + (lane & 7) * 16);
            if (hh == 0) ((float*)(C.ws + WS_PLSE))[(size_t)(br - 1) * MP * 8 + row * 8 + h] = lse;
        } else {
            const float l1 = ((const float*)(C.ws + WS_PLSE))[row * 8 + h], l2 = ((const float*)(C.ws + WS_PLSE))[(size_t)MP * 8 + row * 8 + h];
            const bf16* p1 = (const bf16*)(C.ws + WS_PO) + h * 64 + 8 * (lane & 7);
#pragma unroll
            for (int i = 0; i < 4; ++i) { const size_t ro = (rowr + (size_t)(8 * i) * dil) * 512;
                *(LAS u32x4*)(T0 + ((lane >> 3) + 8 * i) * VSTR + (lane & 7) * 16) = __builtin_nontemporal_load((const u32x4*)(p1 + ro));
                *(LAS u32x4*)(T1 + ((lane >> 3) + 8 * i) * VSTR + (lane & 7) * 16) = __builtin_nontemporal_load((const u32x4*)(p1 + (size_t)MP * 512 + ro)); }
            const float M = fmaxf(lse, fmaxf(l1, l2)), w0 = fexp(lse - M), w1 = fexp(l1 - M), w2 = fexp(l2 - M), iw = 1.0f / (w0 + w1 + w2);
            const float c0 = w0 * iw * inv, c1 = w1 * iw, c2 = w2 * iw;
#pragma unroll
            for (int db = 0; db < 2; ++db)
#pragma unroll
                for (int g = 0; g < 4; ++g) { const int d0 = 32 * db + 8 * g + 4 * hh; const u32x2 a = *(LAS const u32x2*)(T0 + t * VSTR + d0 * 2), bq = *(LAS const u32x2*)(T1 + t * VSTR + d0 * 2);
                    const float y0 = c0 * O[qb][db][4 * g] + c1 * lo16(a.x) + c2 * lo16(bq.x), y1 = c0 * O[qb][db][4 * g + 1] + c1 * hi16(a.x) + c2 * hi16(bq.x);
                    const float y2 = c0 * O[qb][db][4 * g + 2] + c1 * lo16(a.y) + c2 * lo16(bq.y), y3 = c0 * O[qb][db][4 * g + 3] + c1 * hi16(a.y) + c2 * hi16(bq.y);
                    u32x2 w; w.x = pk2(y0, y1); w.y = pk2(y2, y3); *(LAS u32x2*)(T2 + t * VSTR + d0 * 2) = w; }
            bf16* mxo = (bf16*)(C.ws + WS_MIX) + h * 64 + 8 * (lane & 7);
#pragma unroll
            for (int i = 0; i < 4; ++i) *(u32x4*)(mxo + (rowr + (size_t)(8 * i) * dil) * D) = *(LAS const u32x4*)(T2 + ((lane >> 3) + 8 * i) * VSTR + (lane & 7) * 16);
        }
    }
}

DI void attn_sample_item(const Ctx& C, int l, int it) {
    const Params& P = *C.P; const int lane = C.lane, g = lane >> 4, i = lane & 15;
    const int br = it % 3, bth = it / 3, b = bth >> 5, t = (bth >> 3) & 3, h = bth & 7, srow = MP + b * 4 + t, dil = br == 0 ? 1 : (br == 1 ? 4 : 16);
    const bf16* z = (const bf16*)(C.ws + WS_Z);
    const float* BT = (const float*)(C.ws + WS_BIAST) + (br * 8 + h) * 132;
    const u32x2 qw = *(const u32x2*)(z + (size_t)srow * NZ + ZQ + h * 64 + 4 * i);
    constexpr float SC = 0.125f * LOG2E;
    const float q0 = lo16(qw.x) * SC, q1 = hi16(qw.x) * SC, q2 = lo16(qw.y) * SC, q3 = hi16(qw.y) * SC;
    const float* ck = P.in[2] + ((size_t)(l * SB + b) * WB) * 512 + h * 64 + 4 * i;
    const float* cv = P.in[3] + ((size_t)(l * SB + b) * WB) * 512 + h * 64 + 4 * i;
    const bf16* zn = z + (size_t)(MP + b * 4) * NZ + h * 64 + 4 * i;
    float mx = -1e30f, ls = 0.f; f32x4 acc = (f32x4){0.f, 0.f, 0.f, 0.f};
    f32x4 kA[8], vA[8], kB[8], vB[8];
#define SA_LOAD(kk, vv, j0) do { _Pragma("unroll") for (int u = 0; u < 8; ++u) { int j = (j0) + 4 * u + g; j = j > 128 ? 128 : j; const int idx = WB + t - dil * j; \
        const size_t off = (size_t)(idx < WB ? idx : WB - 1) * 512; kk[u] = __builtin_nontemporal_load((const f32x4*)(ck + off)); vv[u] = __builtin_nontemporal_load((const f32x4*)(cv + off)); } } while (0)
#define SA_PROC(kk, vv, j0) do { float sc[8]; float tm = -1e30f; \
        _Pragma("unroll") for (int u = 0; u < 8; ++u) { const int j = (j0) + 4 * u + g, jc = j > 128 ? 128 : j, idx = WB + t - dil * jc; \
            if (idx >= WB) { const u32x2 w = *(const u32x2*)(zn + (size_t)(idx - WB) * NZ + ZK), w2 = *(const u32x2*)(zn + (size_t)(idx - WB) * NZ + ZV); \
                kk[u] = (f32x4){lo16(w.x), hi16(w.x), lo16(w.y), hi16(w.y)}; vv[u] = (f32x4){lo16(w2.x), hi16(w2.x), lo16(w2.y), hi16(w2.y)}; } \
            float s = q0 * kk[u].x + q1 * kk[u].y + q2 * kk[u].z + q3 * kk[u].w; \
            s += __shfl_xor(s, 1); s += __shfl_xor(s, 2); s += __shfl_xor(s, 4); s += __shfl_xor(s, 8); \
            s = (j <= 128) ? s + BT[jc] * LOG2E : -1e30f; sc[u] = s; tm = fmaxf(tm, s); } \
        tm = fmaxf(tm, __shfl_xor(tm, 16)); tm = fmaxf(tm, __shfl_xor(tm, 32)); \
        const float mn = fmaxf(mx, tm), alpha = __builtin_amdgcn_exp2f(mx - mn); mx = mn; ls *= alpha; acc *= alpha; \
        _Pragma("unroll") for (int u = 0; u < 8; ++u) { const float p = __builtin_amdgcn_exp2f(sc[u] - mn); ls += p; acc += vv[u] * p; } } while (0)
    SA_LOAD(kA, vA, 0);
#pragma unroll 1
    for (int jj = 0; jj < 128; jj += 64) { SA_LOAD(kB, vB, jj + 32); SA_PROC(kA, vA, jj); SA_LOAD(kA, vA, jj + 64); SA_PROC(kB, vB, jj + 32); }
    SA_PROC(kA, vA, 128);
#undef SA_LOAD
#undef SA_PROC
    ls += __shfl_xor(ls, 16); ls += __shfl_xor(ls, 32);
#pragma unroll
    for (int c = 0; c < 4; ++c) { acc[c] += __shfl_xor(acc[c], 16); acc[c] += __shfl_xor(acc[c], 32); }
    float* sp = (float*)(C.ws + WS_SAP) + (size_t)it * 68;
    if (g == 0) { const float inv = 1.0f / ls; *(f32x4*)(sp + 4 * i) = acc * inv; if (i == 0) sp[64] = (mx + __builtin_amdgcn_logf(ls)) * 0.6931471805599453f; }
}
DI void attn_sample_combine(const Ctx& C, int it) {
    const int lane = C.lane, bth = it * 4 + (lane >> 4), i = lane & 15, b = bth >> 5, t = (bth >> 3) & 3, h = bth & 7;
    const float* sp = (const float*)(C.ws + WS_SAP) + (size_t)bth * 3 * 68;
    const float l0 = sp[64], l1 = sp[68 + 64], l2 = sp[136 + 64], M = fmaxf(l0, fmaxf(l1, l2)), w0 = fexp(l0 - M), w1 = fexp(l1 - M), w2 = fexp(l2 - M), iw = 1.0f / (w0 + w1 + w2);
    const f32x4 o = (*(const f32x4*)(sp + 4 * i) * w0 + *(const f32x4*)(sp + 68 + 4 * i) * w1 + *(const f32x4*)(sp + 136 + 4 * i) * w2) * iw;
    u32x2 w; w.x = pk2(o.x, o.y); w.y = pk2(o.z, o.w);
    *(u32x2*)((bf16*)(C.ws + WS_MIX) + (size_t)(MP + b * 4 + t) * D + h * 64 + 4 * i) = w;
}

DI float rdlane(float x, int l) { return __builtin_bit_cast(float, __builtin_amdgcn_readlane(__builtin_bit_cast(int, x), l)); }
DI float scan_add(float x, int lane) {
#pragma unroll
    for (int o = 1; o < 64; o <<= 1) { const float v = __shfl_up(x, o); if (lane >= o) x += v; }
    return x; }
DI float scan_max(float x, int lane) {
#pragma unroll
    for (int o = 1; o < 64; o <<= 1) { const float v = __shfl_up(x, o); if (lane >= o) x = fmaxf(x, v); }
    return x; }

DI void conv8(const bf16* zcol, int ts, const float* w, float scale, float (&y)[8]) {
#pragma unroll
    for (int e = 0; e < 8; ++e) y[e] = 0.f;
#pragma unroll
    for (int j = 0; j < 4; ++j) { const int tj = ts - 3 + j;
        if (tj >= 0) { const bf16x8 x = ldg8(zcol + (ptrdiff_t)(j - 3) * NZ); const f32x4 w0 = *(const f32x4*)(w + j * 512), w1 = *(const f32x4*)(w + j * 512 + 4);
            const u32x4 xw = __builtin_bit_cast(u32x4, x);
            y[0] += w0.x * lo16(xw.x); y[1] += w0.y * hi16(xw.x); y[2] += w0.z * lo16(xw.y); y[3] += w0.w * hi16(xw.y);
            y[4] += w1.x * lo16(xw.z); y[5] += w1.y * hi16(xw.z); y[6] += w1.z * lo16(xw.w); y[7] += w1.w * hi16(xw.w); } }
#pragma unroll
    for (int e = 0; e < 8; ++e) y[e] = silu(y[e]) * scale;
}

DI void conv_win(const bf16* zcol  , int ts0  , const float* w, float scale, u32x4 (&out)[8]) {
    u32x4 x[11];
#pragma unroll
    for (int j = 0; j < 11; ++j) { x[j] = (ts0 - 3 + j >= 0) ? __builtin_bit_cast(u32x4, ldg8(zcol + (ptrdiff_t)(j - 3) * NZ)) : (u32x4){0u, 0u, 0u, 0u}; }
    f32x4 w0[4], w1[4];
#pragma unroll
    for (int j = 0; j < 4; ++j) { w0[j] = *(const f32x4*)(w + j * 512); w1[j] = *(const f32x4*)(w + j * 512 + 4); }
#pragma unroll
    for (int tk = 0; tk < 8; ++tk) { float y[8];
#pragma unroll
        for (int e = 0; e < 8; ++e) y[e] = 0.f;
#pragma unroll
        for (int j = 0; j < 4; ++j) { const u32x4 xw = x[tk + j];
            y[0] += w0[j].x * lo16(xw.x); y[1] += w0[j].y * hi16(xw.x); y[2] += w0[j].z * lo16(xw.y); y[3] += w0[j].w * hi16(xw.y);
            y[4] += w1[j].x * lo16(xw.z); y[5] += w1[j].y * hi16(xw.z); y[6] += w1[j].z * lo16(xw.w); y[7] += w1[j].w * hi16(xw.w); }
#pragma unroll
        for (int e = 0; e < 8; ++e) y[e] = silu(y[e]) * scale;
        out[tk].x = pk2(y[0], y[1]); out[tk].y = pk2(y[2], y[3]); out[tk].z = pk2(y[4], y[5]); out[tk].w = pk2(y[6], y[7]); }
}
DI void mlstm_m1_item(const Ctx& C, int l, int it) {
    const Params& P = *C.P; const int lane = C.lane, hh = lane >> 5, g8 = lane >> 3, cgp = lane & 7;
    const int bh = it >> 6, c = it & 63, b = bh >> 2, h = bh & 3, row0 = b * SEQ + c * 64;
    const bf16* z = (const bf16*)(C.ws + WS_Z);
    const float* gate = (const float*)(C.ws + WS_GATE);
    LAS unsigned char* kt_ = C.wl; LAS unsigned char* vt_ = C.wl + 64 * VSTR;
    const float ig = gate[(size_t)(row0 + lane) * 8 + h] + P.in[12][l * 8 + h];
    const float lf = logsig(gate[(size_t)(row0 + lane) * 8 + 4 + h] + P.in[12][l * 8 + 4 + h]);
    const int ch = h * 64 + 8 * cgp, tl0 = 8 * g8;
    const float* cw = P.in[13] + (size_t)l * 4 * 512;
    bf16* QC = (bf16*)(C.ws + WS_MLQC); bf16* KC = (bf16*)(C.ws + WS_MLKC);
    u32x4 vraw[8];
#pragma unroll
    for (int tk = 0; tk < 8; ++tk) vraw[tk] = __builtin_bit_cast(u32x4, ldg8(z + (size_t)(row0 + tl0 + tk) * NZ + ZMV + ch));
    u32x4 kc[8];
    conv_win(z + (size_t)(row0 + tl0) * NZ + ZMK + ch, c * 64 + tl0, cw + 256 + ch, 0.125f, kc);
#pragma unroll
    for (int tk = 0; tk < 8; ++tk) { *(u32x4*)(KC + (size_t)(row0 + tl0 + tk) * 256 + ch) = kc[tk]; *(LAS u32x4*)(kt_ + (tl0 + tk) * VSTR + cgp * 16) = kc[tk]; }
    const float bc = scan_add(lf, lane), bL = __shfl(bc, 63), uu = ig - bc, umax = wave_max(uu);
    const float dpr = fexp(uu - umax);
    ((float*)(C.ws + WS_MLB))[bh * SEQ + c * 64 + lane] = bc; ((float*)(C.ws + WS_MLU))[bh * SEQ + c * 64 + lane] = uu;
    if (lane == 0) { ((float*)(C.ws + WS_MLA))[bh * 64 + c] = bL + umax; ((float*)(C.ws + WS_MLBL))[bh * 64 + c] = bL; }
#pragma unroll
    for (int tk = 0; tk < 8; ++tk) { const float dp = __shfl(dpr, tl0 + tk); const u32x4 vw = vraw[tk];
        u32x4 vo; vo.x = pk2(lo16(vw.x) * dp, hi16(vw.x) * dp); vo.y = pk2(lo16(vw.y) * dp, hi16(vw.y) * dp); vo.z = pk2(lo16(vw.z) * dp, hi16(vw.z) * dp); vo.w = pk2(lo16(vw.w) * dp, hi16(vw.w) * dp);
        *(LAS u32x4*)(vt_ + (tl0 + tk) * VSTR + cgp * 16) = vo; }
    { u32x4 qc[8];
      conv_win(z + (size_t)(row0 + tl0) * NZ + ZMQ + ch, c * 64 + tl0, cw + ch, 1.0f, qc);
#pragma unroll
      for (int tk = 0; tk < 8; ++tk) *(u32x4*)(QC + (size_t)(row0 + tl0 + tk) * 256 + ch) = qc[tk]; }
    f32x16 acc[2][2]; acc[0][0] = zero16(); acc[0][1] = zero16(); acc[1][0] = zero16(); acc[1][1] = zero16();
#pragma unroll
    for (int ks = 0; ks < 4; ++ks) { bf16x8 A[2], B[2];
#pragma unroll
        for (int x = 0; x < 2; ++x) { A[x] = tr_frag<false>(vt_, 16 * ks, 32 * x, lane); B[x] = tr_frag<false>(kt_, 16 * ks, 32 * x, lane); }
#pragma unroll
        for (int fb = 0; fb < 2; ++fb)
#pragma unroll
            for (int eb = 0; eb < 2; ++eb) acc[fb][eb] = MFMA32(A[fb], B[eb], acc[fb][eb]); }
    float kn = 0.f;
#pragma unroll 8
    for (int s = 0; s < 64; ++s) kn += rdlane(dpr, s) * bf2f(*(LAS const bf16*)(kt_ + s * VSTR + lane * 2));
    float* KVT = (float*)(C.ws + WS_MLKVT) + (size_t)(bh * 64 + c) * 4096;
#pragma unroll
    for (int fb = 0; fb < 2; ++fb)
#pragma unroll
        for (int eb = 0; eb < 2; ++eb)
#pragma unroll
            for (int reg = 0; reg < 16; ++reg) KVT[(32 * fb + crow(reg, hh)) * 64 + 32 * eb + (lane & 31)] = acc[fb][eb][reg];
    ((float*)(C.ws + WS_MLKN))[(size_t)(bh * 64 + c) * 64 + lane] = kn;
}

DI void mlstm_m2_item(const Ctx& C, int l, int it) {
    const int lane = C.lane, bh = it < 1024 ? it >> 6 : it - 1024, f = it < 1024 ? it & 63 : 64, b = bh >> 2, h = bh & 3;
    const float* __restrict__ MA = (const float*)(C.ws + WS_MLA) + bh * 64; const float* __restrict__ MBL = (const float*)(C.ws + WS_MLBL) + bh * 64;
    const float* __restrict__ KVT = (const float*)(C.ws + WS_MLKVT) + (size_t)bh * 64 * 4096 + f * 64 + lane;
    const float* __restrict__ KN = (const float*)(C.ws + WS_MLKN) + (size_t)bh * 64 * 64 + lane;
    bf16* __restrict__ CT = (bf16*)(C.ws + WS_MLCT) + (size_t)bh * 64 * 4096 + f * 64 + lane;
    float* __restrict__ NC = (float*)(C.ws + WS_MLNC) + (size_t)bh * 64 * 64 + lane;
    float* __restrict__ MC = (float*)(C.ws + WS_MLMC) + bh * 64;
    const float a_l = MA[lane], bL_l = MBL[lane];
    if (f >= 64) {
        float knv[64];
#pragma unroll
        for (int c = 0; c < 64; ++c) knv[c] = KN[c * 64];
        float m = 0.f, nv = 0.f, ms = 0.f;
#pragma unroll
        for (int c = 0; c < 64; ++c) { const float a = rdlane(a_l, c), bL = rdlane(bL_l, c), mn = fmaxf(bL + m, a), gL = fexp(bL + m - mn), sc = fexp(a - mn);
            NC[c * 64] = nv; nv = gL * nv + sc * knv[c]; if (lane == c) ms = m; m = mn; }
        MC[lane] = ms;
        C.out[O_PN + (size_t)((l * NB + b) * 4 + h) * 64 + lane] = nv; if (lane == 0) C.out[O_PM + (l * NB + b) * 4 + h] = m;
        return; }
    float kv[64];
#pragma unroll
    for (int c = 0; c < 64; ++c) kv[c] = __builtin_nontemporal_load(KVT + (size_t)c * 4096);
    float m = 0.f, Cv = 0.f;
#pragma unroll
    for (int c = 0; c < 64; ++c) {
        const float a = rdlane(a_l, c), bL = rdlane(bL_l, c), mn = fmaxf(bL + m, a), gL = fexp(bL + m - mn), sc = fexp(a - mn);
        CT[(size_t)c * 4096] = f2bf(Cv);
        Cv = gL * Cv + sc * kv[c];
        m = mn;
    }
    C.out[O_PC + ((size_t)((l * NB + b) * 4 + h) * 64 + lane) * 64 + f] = Cv;
}

DI void mlstm_m3_item(const Ctx& C, int l, int it) {
    const Params& P = *C.P; const int lane = C.lane, t = lane & 31, hh = lane >> 5;
    const int half = it & 1, c = (it >> 1) & 63, bh = it >> 7, b = bh >> 2, h = bh & 3, row0 = b * SEQ + c * 64, tok = 32 * half + t, row = row0 + tok;
    const bf16* z = (const bf16*)(C.ws + WS_Z);
    const bf16* QC = (const bf16*)(C.ws + WS_MLQC); const bf16* KC = (const bf16*)(C.ws + WS_MLKC);
    LAS float* us = (LAS float*)(C.wl + 64 * VSTR);
    bf16x8 qf[4], kf[2][4], vr[2][4];
#pragma unroll
    for (int s = 0; s < 4; ++s) qf[s] = ldg8(QC + (size_t)row * 256 + h * 64 + 16 * s + 8 * hh);
    const float u_l = ((const float*)(C.ws + WS_MLU))[bh * SEQ + c * 64 + lane], b_l = ((const float*)(C.ws + WS_MLB))[bh * SEQ + c * 64 + lane];
    const float m_c = ((const float*)(C.ws + WS_MLMC))[bh * 64 + c];
#pragma unroll
    for (int kt = 0; kt < 2; ++kt) if (kt <= half) {
#pragma unroll
        for (int s = 0; s < 4; ++s) { kf[kt][s] = ldg8(KC + (size_t)(row0 + 32 * kt + t) * 256 + h * 64 + 8 * hh + 16 * s);
            vr[kt][s] = ldg8(z + (size_t)(row0 + 32 * kt + (lane >> 3) + 8 * s) * NZ + ZMV + h * 64 + 8 * (lane & 7)); } }
    const float cm = scan_max(u_l, lane), mt_l = b_l + fmaxf(m_c, cm);
    us[lane] = u_l;
    const float b_t = __shfl(b_l, tok), mt_t = __shfl(mt_l, tok), g_t = fexp(b_t + m_c - mt_t);
    f32x16 S[2]; S[0] = zero16(); S[1] = zero16();
#pragma unroll
    for (int kt = 0; kt < 2; ++kt) if (kt <= half) {
#pragma unroll
        for (int s = 0; s < 4; ++s) S[kt] = MFMA32(kf[kt][s], qf[s], S[kt]);
#pragma unroll
        for (int i = 0; i < 4; ++i) *(LAS bf16x8*)(C.wl + kt * (32 * VSTR) + ((lane >> 3) + 8 * i) * VSTR + (lane & 7) * 16) = vr[kt][i]; }
    const bf16* CT = (const bf16*)(C.ws + WS_MLCT) + (size_t)(bh * 64 + c) * 4096;
    bf16x8 ctf[2][4];
#pragma unroll
    for (int fb = 0; fb < 2; ++fb)
#pragma unroll
        for (int s = 0; s < 4; ++s) ctf[fb][s] = ldg8(CT + (32 * fb + t) * 64 + 16 * s + 8 * hh);
    const float* NCp = (const float*)(C.ws + WS_MLNC) + (size_t)(bh * 64 + c) * 64;
    f32x4 ncv[8];
#pragma unroll
    for (int s = 0; s < 4; ++s) { ncv[2 * s] = *(const f32x4*)(NCp + 16 * s + 8 * hh); ncv[2 * s + 1] = *(const f32x4*)(NCp + 16 * s + 8 * hh + 4); }
    LAS unsigned char* OG = C.wl + 64 * VSTR + 256;
#pragma unroll
    for (int i = 0; i < 4; ++i) *(LAS bf16x8*)(OG + ((lane >> 3) + 8 * i) * VSTR + (lane & 7) * 16) = ldg8(z + (size_t)(row0 + 32 * half + (lane >> 3) + 8 * i) * NZ + ZMO + h * 64 + 8 * (lane & 7));
    f32x16 O[2]; O[0] = zero16(); O[1] = zero16();
    float den = 0.f;
#pragma unroll
    for (int kt = 0; kt < 2; ++kt) if (kt <= half) {
#pragma unroll
        for (int reg = 0; reg < 16; ++reg) { const int sidx = 32 * kt + crow(reg, hh);
            const float w = (sidx <= tok) ? fexp(b_t + us[sidx] - mt_t) * S[kt][reg] : 0.f; S[kt][reg] = w; den += w; }
#pragma unroll
        for (int ks = 0; ks < 2; ++ks) { const bf16x8 pf = pack8(S[kt], ks);
#pragma unroll
            for (int fb = 0; fb < 2; ++fb) O[fb] = MFMA32(tr_frag<true>(C.wl + kt * (32 * VSTR), 16 * ks, 32 * fb, lane), pf, O[fb]); } }
    f32x16 X[2]; X[0] = zero16(); X[1] = zero16();
#pragma unroll
    for (int fb = 0; fb < 2; ++fb)
#pragma unroll
        for (int s = 0; s < 4; ++s) X[fb] = MFMA32(ctf[fb][s], qf[s], X[fb]);
    float qn = 0.f;
#pragma unroll
    for (int s = 0; s < 4; ++s) { const u32x4 qw = __builtin_bit_cast(u32x4, qf[s]); const f32x4 n0 = ncv[2 * s], n1 = ncv[2 * s + 1];
        qn += lo16(qw.x) * n0.x + hi16(qw.x) * n0.y + lo16(qw.y) * n0.z + hi16(qw.y) * n0.w + lo16(qw.z) * n1.x + hi16(qw.z) * n1.y + lo16(qw.w) * n1.z + hi16(qw.w) * n1.w; }
    qn += __shfl_xor(qn, 32); den += __shfl_xor(den, 32);
    den += g_t * qn;
    const float idn = __builtin_amdgcn_rcpf(fmaxf(fabsf(den), fexp(-mt_t)));
    float ssq = 0.f;
#pragma unroll
    for (int fb = 0; fb < 2; ++fb)
#pragma unroll
        for (int reg = 0; reg < 16; ++reg) { const float hv = (O[fb][reg] + g_t * X[fb][reg]) * idn; O[fb][reg] = hv; ssq += hv * hv; }
    ssq += __shfl_xor(ssq, 32);
    const float rs = __builtin_amdgcn_rsqf(ssq * (1.0f / 64) + EPS);
    const float* gn = P.in[14] + l * 256 + h * 64;
    LAS unsigned char* OT = C.wl;
#pragma unroll
    for (int fb = 0; fb < 2; ++fb)
#pragma unroll
        for (int g = 0; g < 4; ++g) { const int f0 = 32 * fb + 8 * g + 4 * hh; const u32x2 ow = *(LAS const u32x2*)(OG + t * VSTR + f0 * 2); const f32x4 gv = *(const f32x4*)(gn + f0);
            u32x2 w; w.x = pk2(O[fb][4 * g] * rs * gv.x * sigm(lo16(ow.x)), O[fb][4 * g + 1] * rs * gv.y * sigm(hi16(ow.x)));
            w.y = pk2(O[fb][4 * g + 2] * rs * gv.z * sigm(lo16(ow.y)), O[fb][4 * g + 3] * rs * gv.w * sigm(hi16(ow.y)));
            *(LAS u32x2*)(OT + t * VSTR + f0 * 2) = w; }
    bf16* mxp = (bf16*)(C.ws + WS_MIX) + (size_t)(row0 + 32 * half + (lane >> 3)) * D + 512 + h * 64 + 8 * (lane & 7);
#pragma unroll
    for (int i = 0; i < 4; ++i) *(u32x4*)(mxp + (size_t)(8 * i) * D) = *(LAS const u32x4*)(OT + ((lane >> 3) + 8 * i) * VSTR + (lane & 7) * 16);
}

DI void mlstm_sample_item(const Ctx& C, int l, int it) {
    const Params& P = *C.P; const int lane = C.lane, b = it >> 2, h = it & 3;
    const bf16* z = (const bf16*)(C.ws + WS_Z); const float* gate = (const float*)(C.ws + WS_GATE);
    const size_t sb = (size_t)(l * SB + b) * 4 + h;
    const float* C0 = P.in[5] + sb * 4096;
    LAS float* Cs = (LAS float*)C.wl;
    { float c0[64];
#pragma unroll
      for (int e = 0; e < 64; ++e) c0[e] = __builtin_nontemporal_load(C0 + e * 64 + lane);
#pragma unroll
      for (int e = 0; e < 64; ++e) Cs[e * 64 + lane] = c0[e]; }
    float nv = P.in[6][sb * 64 + lane], m = P.in[7][sb];
    const float* cw = P.in[13] + (size_t)l * 4 * 512; const float* cb = P.in[4] + (size_t)(l * SB + b) * 3 * 512;
    float xq[7], xk[7];
#pragma unroll
    for (int j = 0; j < 3; ++j) { xq[j] = cb[j * 512 + h * 64 + lane]; xk[j] = cb[j * 512 + 256 + h * 64 + lane]; }
#pragma unroll
    for (int j = 0; j < 4; ++j) { xq[3 + j] = bf2f(z[(size_t)(MP + b * 4 + j) * NZ + ZMQ + h * 64 + lane]); xk[3 + j] = bf2f(z[(size_t)(MP + b * 4 + j) * NZ + ZMK + h * 64 + lane]); }
    float wq[4], wk[4];
#pragma unroll
    for (int j = 0; j < 4; ++j) { wq[j] = cw[j * 512 + h * 64 + lane]; wk[j] = cw[j * 512 + 256 + h * 64 + lane]; }
    const float gnv = P.in[14][l * 256 + h * 64 + lane];
#pragma unroll
    for (int t = 0; t < 4; ++t) { const int row = MP + b * 4 + t;
        float qc = 0.f, kc = 0.f;
#pragma unroll
        for (int j = 0; j < 4; ++j) { qc += wq[j] * xq[t + j]; kc += wk[j] * xk[t + j]; }
        qc = silu(qc); kc = silu(kc) * 0.125f;
        const float ig = gate[(size_t)row * 8 + h] + P.in[12][l * 8 + h], lf = logsig(gate[(size_t)row * 8 + 4 + h] + P.in[12][l * 8 + 4 + h]);
        const float mn = fmaxf(lf + m, ig), fp = fexp(lf + m - mn), ip = fexp(ig - mn);
        const float vf = bf2f(z[(size_t)row * NZ + ZMV + h * 64 + lane]) * ip;
        float num = 0.f;
#pragma unroll 4
        for (int e = 0; e < 64; ++e) { const float ke = rdlane(kc, e), qe = rdlane(qc, e); const float cv = fp * Cs[e * 64 + lane] + ke * vf; Cs[e * 64 + lane] = cv; num += qe * cv; }
        nv = fp * nv + ip * kc;
        const float qn = wave_sum(qc * nv);
        const float hv = num / fmaxf(fabsf(qn), fexp(-mn));
        const float ssq = wave_sum(hv * hv), rs = __builtin_amdgcn_rsqf(ssq * (1.0f / 64) + EPS);
        const float og = bf2f(z[(size_t)row * NZ + ZMO + h * 64 + lane]);
        ((bf16*)(C.ws + WS_MIX))[(size_t)row * D + 512 + h * 64 + lane] = f2bf(hv * rs * gnv * sigm(og));
        m = mn; }
    float* oc = C.out + O_SC + sb * 4096;
#pragma unroll 8
    for (int e = 0; e < 64; ++e) oc[e * 64 + lane] = Cs[e * 64 + lane];
    C.out[O_SN + sb * 64 + lane] = nv; if (lane == 0) C.out[O_SM + sb] = m;
}

DI void hgrn_m1_item(const Ctx& C, int l, int it) {
    const int lane = C.lane, hh = lane >> 5;
    const int bh = it >> 6, c = it & 63, b = bh >> 2, h = bh & 3, row0 = b * SEQ + c * 64;
    const bf16* z = (const bf16*)(C.ws + WS_Z);
    LAS unsigned char* ft = C.wl; LAS unsigned char* kt_ = C.wl + 64 * VSTR; LAS unsigned char* vt_ = C.wl + 96 * VSTR;
    const float lb = ((const float*)(C.ws + WS_LBV))[l * 256 + h * 64 + lane];
#pragma unroll
    for (int i = 0; i < 8; ++i) { const int id = lane + 64 * i, rr = id >> 3, cgp = id & 7;
        *(LAS bf16x8*)(ft + rr * VSTR + cgp * 16) = ldg8(z + (size_t)(row0 + rr) * NZ + ZHF + h * 64 + 8 * cgp); }
    float ba = 0.f, r = 0.f;
#pragma unroll 8
    for (int t = 0; t < 64; ++t) { const float x = bf2f(*(LAS const bf16*)(ft + t * VSTR + lane * 2)); const float fg = lb + (1.0f - lb) * sigm(x); ba += flog(fg); if (t == 31) r = ba; }
    const float bL = ba, er = fexp(r), eLr = fexp(bL - r);
    bf16* QT = (bf16*)(C.ws + WS_HGQT); bf16* KT = (bf16*)(C.ws + WS_HGKT); bf16* QB = (bf16*)(C.ws + WS_HGQB);
    f32x16 acc[2][2]; acc[0][0] = zero16(); acc[0][1] = zero16(); acc[1][0] = zero16(); acc[1][1] = zero16();
    ba = 0.f;
    for (int hf = 0; hf < 2; ++hf) {
#pragma unroll
        for (int i = 0; i < 4; ++i) { const int id = lane + 64 * i, rr = id >> 3, cgp = id & 7;
            *(LAS bf16x8*)(vt_ + rr * VSTR + cgp * 16) = ldg8(z + (size_t)(row0 + 32 * hf + rr) * NZ + ZHQ + h * 64 + 8 * cgp); }
#pragma unroll 8
        for (int tt = 0; tt < 32; ++tt) { const int t = 32 * hf + tt;
            const float x = bf2f(*(LAS const bf16*)(ft + t * VSTR + lane * 2)); const float fg = lb + (1.0f - lb) * sigm(x), kk = 1.0f - fg;
            ba += flog(fg);
            const float q = silu(bf2f(*(LAS const bf16*)(vt_ + tt * VSTR + lane * 2)));
            const size_t o = (size_t)(row0 + t) * 256 + h * 64 + lane;
            const float e1 = fexp(ba - r), qt = q * e1, ktv = kk * __builtin_amdgcn_rcpf(e1);
            QT[o] = f2bf(qt); KT[o] = f2bf(ktv); QB[o] = f2bf(qt * er);
            *(LAS bf16*)(kt_ + tt * VSTR + lane * 2) = f2bf(ktv * eLr); }
#pragma unroll
        for (int i = 0; i < 4; ++i) { const int id = lane + 64 * i, rr = id >> 3, cgp = id & 7;
            *(LAS bf16x8*)(vt_ + rr * VSTR + cgp * 16) = ldg8(z + (size_t)(row0 + 32 * hf + rr) * NZ + ZHI + h * 64 + 8 * cgp); }
#pragma unroll
        for (int ks = 0; ks < 2; ++ks) { bf16x8 A[2], B[2];
#pragma unroll
            for (int x = 0; x < 2; ++x) { A[x] = tr_frag<false>(vt_, 16 * ks, 32 * x, lane); B[x] = tr_frag<false>(kt_, 16 * ks, 32 * x, lane); }
#pragma unroll
            for (int vb = 0; vb < 2; ++vb)
#pragma unroll
                for (int kb = 0; kb < 2; ++kb) acc[vb][kb] = MFMA32(A[vb], B[kb], acc[vb][kb]); }
    }
    float* GT = (float*)(C.ws + WS_HGGT) + (size_t)(bh * 64 + c) * 4096;
#pragma unroll
    for (int vb = 0; vb < 2; ++vb)
#pragma unroll
        for (int kb = 0; kb < 2; ++kb)
#pragma unroll
            for (int reg = 0; reg < 16; ++reg) GT[(32 * vb + crow(reg, hh)) * 64 + 32 * kb + (lane & 31)] = acc[vb][kb][reg];
    ((float*)(C.ws + WS_HGDL))[(size_t)(bh * 64 + c) * 64 + lane] = fexp(bL);
}
DI void hgrn_m2_item(const Ctx& C, int l, int it) {
    const int lane = C.lane, bh = it >> 6, v = it & 63, b = bh >> 2, h = bh & 3;
    const float* __restrict__ GT = (const float*)(C.ws + WS_HGGT) + (size_t)bh * 64 * 4096 + v * 64 + lane;
    const float* __restrict__ DL = (const float*)(C.ws + WS_HGDL) + (size_t)bh * 64 * 64 + lane;
    bf16* __restrict__ ST = (bf16*)(C.ws + WS_HGST) + (size_t)bh * 64 * 4096 + v * 64 + lane;
    float gt[64], dl[64];
#pragma unroll
    for (int c = 0; c < 64; ++c) { gt[c] = __builtin_nontemporal_load(GT + (size_t)c * 4096); dl[c] = DL[c * 64]; }
    float S = 0.f;
#pragma unroll
    for (int c = 0; c < 64; ++c) { ST[(size_t)c * 4096] = f2bf(S); S = dl[c] * S + gt[c]; }
    C.out[O_PS + ((size_t)((l * NB + b) * 4 + h) * 64 + lane) * 64 + v] = S;
}
DI void hgrn_m3_item(const Ctx& C, int l, int it) {
    const Params& P = *C.P; const int lane = C.lane, t = lane & 31, hh = lane >> 5;
    const int half = it & 1, c = (it >> 1) & 63, bh = it >> 7, b = bh >> 2, h = bh & 3, row0 = b * SEQ + c * 64, tok = 32 * half + t, row = row0 + tok;
    const bf16* z = (const bf16*)(C.ws + WS_Z);
    const bf16* QT = (const bf16*)(C.ws + WS_HGQT); const bf16* KT = (const bf16*)(C.ws + WS_HGKT); const bf16* QB = (const bf16*)(C.ws + WS_HGQB);
    bf16x8 qf[4], kf[2][4], vr[2][4];
#pragma unroll
    for (int s = 0; s < 4; ++s) qf[s] = ldg8(QT + (size_t)row * 256 + h * 64 + 16 * s + 8 * hh);
#pragma unroll
    for (int kt = 0; kt < 2; ++kt) if (kt <= half) {
#pragma unroll
        for (int s = 0; s < 4; ++s) { kf[kt][s] = ldg8(KT + (size_t)(row0 + 32 * kt + t) * 256 + h * 64 + 8 * hh + 16 * s);
            vr[kt][s] = ldg8(z + (size_t)(row0 + 32 * kt + (lane >> 3) + 8 * s) * NZ + ZHI + h * 64 + 8 * (lane & 7)); } }
    f32x16 S[2]; S[0] = zero16(); S[1] = zero16();
#pragma unroll
    for (int kt = 0; kt < 2; ++kt) if (kt <= half) {
#pragma unroll
        for (int s = 0; s < 4; ++s) S[kt] = MFMA32(kf[kt][s], qf[s], S[kt]);
#pragma unroll
        for (int i = 0; i < 4; ++i) *(LAS bf16x8*)(C.wl + kt * (32 * VSTR) + ((lane >> 3) + 8 * i) * VSTR + (lane & 7) * 16) = vr[kt][i]; }
    const bf16* ST = (const bf16*)(C.ws + WS_HGST) + (size_t)(bh * 64 + c) * 4096;
    bf16x8 stf[2][4], qb[4];
#pragma unroll
    for (int s = 0; s < 4; ++s) { qb[s] = ldg8(QB + (size_t)row * 256 + h * 64 + 16 * s + 8 * hh);
#pragma unroll
        for (int vb = 0; vb < 2; ++vb) stf[vb][s] = ldg8(ST + (32 * vb + t) * 64 + 16 * s + 8 * hh); }
    LAS unsigned char* OG = C.wl + 64 * VSTR + 256;
#pragma unroll
    for (int i = 0; i < 4; ++i) *(LAS bf16x8*)(OG + ((lane >> 3) + 8 * i) * VSTR + (lane & 7) * 16) = ldg8(z + (size_t)(row0 + 32 * half + (lane >> 3) + 8 * i) * NZ + ZHG + h * 64 + 8 * (lane & 7));
    f32x16 O[2]; O[0] = zero16(); O[1] = zero16();
#pragma unroll
    for (int kt = 0; kt < 2; ++kt) if (kt <= half) {
#pragma unroll
        for (int reg = 0; reg < 16; ++reg) { const int sidx = 32 * kt + crow(reg, hh); S[kt][reg] = (sidx <= tok) ? S[kt][reg] : 0.f; }
#pragma unroll
        for (int ks = 0; ks < 2; ++ks) { const bf16x8 pf = pack8(S[kt], ks);
#pragma unroll
            for (int vb = 0; vb < 2; ++vb) O[vb] = MFMA32(tr_frag<true>(C.wl + kt * (32 * VSTR), 16 * ks, 32 * vb, lane), pf, O[vb]); } }
#pragma unroll
    for (int s = 0; s < 4; ++s)
#pragma unroll
        for (int vb = 0; vb < 2; ++vb) O[vb] = MFMA32(stf[vb][s], qb[s], O[vb]);
    float ssq = 0.f;
#pragma unroll
    for (int vb = 0; vb < 2; ++vb)
#pragma unroll
        for (int reg = 0; reg < 16; ++reg) ssq += O[vb][reg] * O[vb][reg];
    ssq += __shfl_xor(ssq, 32);
    const float rs = __builtin_amdgcn_rsqf(ssq * (1.0f / 64) + EPS);
    const float* gn = P.in[16] + l * 256 + h * 64;
    LAS unsigned char* OT = C.wl;
#pragma unroll
    for (int vb = 0; vb < 2; ++vb)
#pragma unroll
        for (int g = 0; g < 4; ++g) { const int f0 = 32 * vb + 8 * g + 4 * hh; const u32x2 ow = *(LAS const u32x2*)(OG + t * VSTR + f0 * 2); const f32x4 gv = *(const f32x4*)(gn + f0);
            u32x2 w; w.x = pk2(O[vb][4 * g] * rs * gv.x * sigm(lo16(ow.x)), O[vb][4 * g + 1] * rs * gv.y * sigm(hi16(ow.x)));
            w.y = pk2(O[vb][4 * g + 2] * rs * gv.z * sigm(lo16(ow.y)), O[vb][4 * g + 3] * rs * gv.w * sigm(hi16(ow.y)));
            *(LAS u32x2*)(OT + t * VSTR + f0 * 2) = w; }
    bf16* mxp = (bf16*)(C.ws + WS_MIX) + (size_t)(row0 + 32 * half + (lane >> 3)) * D + 768 + h * 64 + 8 * (lane & 7);
#pragma unroll
    for (int i = 0; i < 4; ++i) *(u32x4*)(mxp + (size_t)(8 * i) * D) = *(LAS const u32x4*)(OT + ((lane >> 3) + 8 * i) * VSTR + (lane & 7) * 16);
}
DI void hgrn_sample_item(const Ctx& C, int l, int it) {
    const Params& P = *C.P; const int lane = C.lane, b = it >> 2, h = it & 3;
    const bf16* z = (const bf16*)(C.ws + WS_Z);
    const size_t sb = (size_t)(l * SB + b) * 4 + h;
    const float* S0 = P.in[8] + sb * 4096;
    LAS float* Ss = (LAS float*)C.wl;
    { float s0[64];
#pragma unroll
      for (int k = 0; k < 64; ++k) s0[k] = __builtin_nontemporal_load(S0 + k * 64 + lane);
#pragma unroll
      for (int k = 0; k < 64; ++k) Ss[k * 64 + lane] = s0[k]; }
    const float lb = ((const float*)(C.ws + WS_LBV))[l * 256 + h * 64 + lane], gnv = P.in[16][l * 256 + h * 64 + lane];
#pragma unroll
    for (int t = 0; t < 4; ++t) { const size_t zr = (size_t)(MP + b * 4 + t) * NZ;
        const float fg = lb + (1.0f - lb) * sigm(bf2f(z[zr + ZHF + h * 64 + lane])), kk = 1.0f - fg, q = silu(bf2f(z[zr + ZHQ + h * 64 + lane]));
        const float iv = bf2f(z[zr + ZHI + h * 64 + lane]);
        float o = 0.f;
#pragma unroll 4
        for (int k = 0; k < 64; ++k) { const float sv = rdlane(fg, k) * Ss[k * 64 + lane] + rdlane(kk, k) * iv; Ss[k * 64 + lane] = sv; o += rdlane(q, k) * sv; }
        const float ssq = wave_sum(o * o), rs = __builtin_amdgcn_rsqf(ssq * (1.0f / 64) + EPS);
        const float og = bf2f(z[zr + ZHG + h * 64 + lane]);
        ((bf16*)(C.ws + WS_MIX))[(size_t)(MP + b * 4 + t) * D + 768 + h * 64 + lane] = f2bf(o * rs * gnv * sigm(og)); }
    float* os = C.out + O_SS + sb * 4096;
#pragma unroll 8
    for (int k = 0; k < 64; ++k) os[k * 64 + lane] = Ss[k * 64 + lane];
}

DI void copy_row(const bf16* src, float* dst, int lane) {
    const u32x4 w = __builtin_bit_cast(u32x4, ldg8(src + 8 * lane));
    *(f32x4*)(dst + 8 * lane) = (f32x4){lo16(w.x), hi16(w.x), lo16(w.y), hi16(w.y)};
    *(f32x4*)(dst + 8 * lane + 4) = (f32x4){lo16(w.z), hi16(w.z), lo16(w.w), hi16(w.w)}; }
constexpr int CO_PKV8 = 2 * NB * WB / 8, CO_SKV = 2 * MS, CO_PCV = NB * 3, CO_SCV = SB * 3, CO_ALL = CO_PKV8 + CO_SKV + CO_PCV + CO_SCV;
DI void copyout_item(const Ctx& C, int l, int it) {
    const bf16* z = (const bf16*)(C.ws + WS_Z); const int lane = C.lane;
    if (it < CO_PKV8) { const int which = it / (NB * WB / 8), r = it % (NB * WB / 8), b = r / (WB / 8), j = (r % (WB / 8)) * 8;
        const bf16* src = (const bf16*)(C.ws + (which ? WS_VC : WS_KC)) + ((size_t)(b * 8 + (lane >> 3)) * SEQ + (SEQ - WB) + j) * 64 + 8 * (lane & 7); float* dst = C.out + (which ? O_PV : O_PK) + ((size_t)(l * NB + b) * WB + j) * 512 + 8 * lane;
        u32x4 w[8];
#pragma unroll
        for (int q = 0; q < 8; ++q) w[q] = __builtin_nontemporal_load((const u32x4*)(src + (size_t)q * 64));
#pragma unroll
        for (int q = 0; q < 8; ++q) { __builtin_nontemporal_store((f32x4){lo16(w[q].x), hi16(w[q].x), lo16(w[q].y), hi16(w[q].y)}, (f32x4*)(dst + q * 512)); __builtin_nontemporal_store((f32x4){lo16(w[q].z), hi16(w[q].z), lo16(w[q].w), hi16(w[q].w)}, (f32x4*)(dst + q * 512 + 4)); }
        return; }
    it -= CO_PKV8;
    if (it < CO_SKV) { const int which = it / MS, r = it % MS;
        copy_row(z + (size_t)(MP + r) * NZ + (which ? ZV : ZK), C.out + (which ? O_SV : O_SK) + ((size_t)l * MS + r) * 512, lane); return; }
    it -= CO_SKV;
    if (it < CO_PCV) { const int b = it / 3, j = it % 3;
        copy_row(z + (size_t)(b * SEQ + SEQ - 3 + j) * NZ + ZMQ, C.out + O_PCONV + ((size_t)(l * NB + b) * 3 + j) * 512, lane); return; }
    it -= CO_PCV;
    { const int b = it / 3, j = it % 3;
        copy_row(z + (size_t)(MP + b * 4 + 1 + j) * NZ + ZMQ, C.out + O_SCONV + ((size_t)(l * SB + b) * 3 + j) * 512, lane); }
}

#define STAMP(i) do { if (PROBE_T0 >= 0 && blockIdx.x == PROBE_BLK && threadIdx.x == 0) ((unsigned long long*)(C.ws + WS_TS))[(i)] = __builtin_amdgcn_s_memrealtime(); } while (0)
#define STAMPB(i) do { if (PROBE_T0 >= 0 && blockIdx.x == PROBE_BLK && threadIdx.x == 256) ((unsigned long long*)(C.ws + WS_TS))[(i)] = __builtin_amdgcn_s_memrealtime(); } while (0)
#define ITEM_LOOP(N, rot, call) do { for (int it = (C.wave * C.G + C.vcu + C.NGW - ((rot) % C.NGW)) % C.NGW; it < (N); it += C.NGW) { call; } } while (0)
DI int grab_lds(const Ctx& C, int k) { unsigned v = 0; if (C.lane == 0) v = __hip_atomic_fetch_add((LAS unsigned*)(C.lds + LDS_CTL) + 8 + k, 1u, __ATOMIC_RELAXED, __HIP_MEMORY_SCOPE_WORKGROUP); return (int)__builtin_amdgcn_readfirstlane(v); }
#define QUEUE_LOOP(N, k, call) do { const int per = (N) / C.G, base = C.vcu * per; for (int q = grab_lds(C, (k)); q < per; q = grab_lds(C, (k))) { const int it = base + q; call; } } while (0)
#define QUEUE_RESET() do { if (C.tid < 8) ((LAS unsigned*)(C.lds + LDS_CTL))[8 + C.tid] = 0u; __syncthreads(); } while (0)
template <int l> DI void ph_m1(const Ctx& C) {
    QUEUE_RESET();
    if (l == 0) { STAMP(20); STAMPB(40); }
    if (C.wave == 7) { if (C.vcu < 128) mlstm_sample_item(C, l, C.vcu); else hgrn_sample_item(C, l, C.vcu - 128); }
    if (C.wave < 3) { QUEUE_LOOP(3072, 0, attn_sample_item(C, l, it)); }
    else { QUEUE_LOOP(2048, 4, attn_unit<2>(C, l, it)); }
    if (l == 0) { STAMP(21); STAMPB(41); }
    QUEUE_LOOP(1024, 1, hgrn_m1_item(C, l, it));
    if (l == 0) { STAMP(22); STAMPB(42); }
    QUEUE_LOOP(1024, 2, mlstm_m1_item(C, l, it));
    if (l == 0) { STAMP(23); STAMPB(43); }
    if (l == 0) { STAMP(24); STAMPB(44); }
    QUEUE_LOOP(2048, 3, attn_unit<1>(C, l, it));
    if (l == 0) { STAMP(25); STAMPB(45); }
}
template <int l> DI void ph_m2(const Ctx& C) {
    ITEM_LOOP(1040, 0, mlstm_m2_item(C, l, it));
    ITEM_LOOP(1024, 1040, hgrn_m2_item(C, l, it));
    ITEM_LOOP(256, 1040, attn_sample_combine(C, it));
}
template <int l> DI void ph_m3(const Ctx& C) {
    QUEUE_RESET();
    if (l == 0) STAMP(28);
    if (l == 0 && C.wave < 2) convert_weights(C, 1, C.wave * 256 + C.vcu, 512);
    QUEUE_LOOP(2048, 0, mlstm_m3_item(C, l, it));
    if (l == 0) STAMP(29);
    QUEUE_LOOP(2048, 1, hgrn_m3_item(C, l, it));
    if (l == 0) STAMP(30);
    QUEUE_LOOP(2048, 2, attn_unit<0>(C, l, it));
    if (l == 0) STAMP(31);
    ITEM_LOOP(CO_ALL, 0, copyout_item(C, l, it));
    if (l == 0) STAMP(32);
}
DI void ph_final(const Ctx& C) {
    const Params& P = *C.P; const int lane = C.lane;
    const bf16* HB = (const bf16*)(C.ws + WS_HB); const float* SSQ = (const float*)(C.ws + WS_SSQ) + 4 * MPAD;
#pragma unroll 4
    for (int m = C.gw; m < MT; m += C.NGW) {
        const float rs = __builtin_amdgcn_rsqf(SSQ[m] * (1.0f / D) + EPS);
        float* o = (m < MP) ? C.out + O_YP + (size_t)m * D : C.out + O_YS + (size_t)(m - MP) * D;
#pragma unroll
        for (int j = 0; j < 2; ++j) { const u32x4 hw = __builtin_nontemporal_load((const u32x4*)(HB + (size_t)m * D + 8 * lane + 512 * j)); const f32x4 g0 = *(const f32x4*)(P.in[21] + 8 * lane + 512 * j), g1 = *(const f32x4*)(P.in[21] + 8 * lane + 512 * j + 4);
            __builtin_nontemporal_store((f32x4){lo16(hw.x), hi16(hw.x), lo16(hw.y), hi16(hw.y)} * rs * g0, (f32x4*)(o + 8 * lane + 512 * j));
            __builtin_nontemporal_store((f32x4){lo16(hw.z), hi16(hw.z), lo16(hw.w), hi16(hw.w)} * rs * g1, (f32x4*)(o + 8 * lane + 512 * j + 4)); }
    }
}

constexpr int SGS = 272;
template <int NBK  > DI void sgemm_acc(const Ctx& C, const bf16* __restrict__ A, const bf16* __restrict__ Bt, int K, int rb, int cb, int k_lo, int k_hi, int lane, f32x16& acc) {
    const int r = lane & 31, hh = lane >> 5, lr = lane >> 4, lc = lane & 15;
    const bf16* ap = A + (size_t)(32 * rb + lr) * K + 8 * lc; const bf16* bp = Bt + (size_t)(32 * cb + lr) * K + 8 * lc;
    LAS unsigned char* ta = C.wl; LAS unsigned char* tb = C.wl + 32 * SGS;
    bf16x8 ga[8], gb[8];
#pragma unroll
    for (int i = 0; i < 8; ++i) { ga[i] = ldg8(ap + (size_t)(4 * i) * K + k_lo); gb[i] = ldg8(bp + (size_t)(4 * i) * K + k_lo); }
#pragma unroll 1
    for (int k = k_lo; k < k_hi; k += 128) {
#pragma unroll
        for (int i = 0; i < 8; ++i) { *(LAS bf16x8*)(ta + (4 * i + lr) * SGS + lc * 16) = ga[i]; *(LAS bf16x8*)(tb + (4 * i + lr) * SGS + lc * 16) = gb[i]; }
        if (k + 128 < k_hi) {
#pragma unroll
            for (int i = 0; i < 8; ++i) { ga[i] = ldg8(ap + (size_t)(4 * i) * K + k + 128); gb[i] = ldg8(bp + (size_t)(4 * i) * K + k + 128); } }
#pragma unroll
        for (int s = 0; s < 8; ++s) acc = MFMA32(*(LAS const bf16x8*)(ta + r * SGS + 32 * s + 16 * hh), *(LAS const bf16x8*)(tb + r * SGS + 32 * s + 16 * hh), acc);
    }
}
template <int KIND> DI void sgemm_epi(const Ctx& C, int l, int rb, int cb, int reg, int lane, float v) {
    const int hh = lane >> 5, row = MP + 32 * rb + crow(reg, hh), col = 32 * cb + (lane & 31);
    float* SSQ = (float*)(C.ws + WS_SSQ);
    if (KIND == 0) { const float rs = __builtin_amdgcn_rsqf(SSQ[(2 * l) * MPAD + row] * (1.0f / D) + EPS); const float x = v * rs;
        ((bf16*)(C.ws + WS_Z))[(size_t)row * NZ + col] = f2bf(x); if (col >= ZG && col < ZG + 8) ((float*)(C.ws + WS_GATE))[(size_t)row * 8 + col - ZG] = x; }
    else if (KIND == 2) { const float rs = __builtin_amdgcn_rsqf(SSQ[(2 * l + 1) * MPAD + row] * (1.0f / D) + EPS); const float x = fmaxf(v * rs, 0.f);
        ((bf16*)(C.ws + WS_ACT))[(size_t)row * FF + col] = f2bf(x * x); }
    else { bf16* hp = (bf16*)(C.ws + WS_HB) + (size_t)row * D + col; const float x = bf2f(*hp) + v; *hp = f2bf(x);
        float s = x * x; s += __shfl_xor(s, 1); s += __shfl_xor(s, 2); s += __shfl_xor(s, 4); s += __shfl_xor(s, 8); s += __shfl_xor(s, 16);
        if ((lane & 31) == 0) atomicAdd(SSQ + (KIND == 1 ? 2 * l + 1 : 2 * l + 2) * MPAD + row, s); }
}
template <int KIND> DI void sgemm_phase(const Ctx& C0, int l) {
    const Ctx C = fresh(C0); const int lane = C.lane;
    constexpr int K = KIND == 3 ? FF : D;
    const bf16* A = (const bf16*)(C.ws + (KIND == 1 ? WS_MIX : (KIND == 3 ? WS_ACT : WS_HB))) + (size_t)MP * K;
    const bf16* Bt = (const bf16*)(C.ws + (KIND == 0 ? WS_WIN : (KIND == 1 ? WS_WOUT : (KIND == 2 ? WS_WUP : WS_WDN)))) + (size_t)l * (KIND == 0 ? NZ * D : (KIND == 1 ? D * D : FF * D));
    if (KIND == 0) {
        int u = -1; if ((int)blockIdx.x >= 192) u = ((int)blockIdx.x - 192) * 8 + C.wave; if (u >= 480) u = -1;
        if (u >= 0) { const int rb = u & 3, cb = u >> 2; f32x16 acc = zero16();
            sgemm_acc<16>(C, A, Bt, K, rb, cb, 0, K, lane, acc);
#pragma unroll
            for (int reg = 0; reg < 16; ++reg) sgemm_epi<0>(C, l, rb, cb, reg, lane, acc[reg]); }
        return; }
    constexpr int KS = KIND == 2 ? 4 : 8;
    if (KIND != 2 && C.vcu >= 128) return;
    const int grp = C.wave / KS, ki = C.wave % KS, u = KIND == 2 ? C.vcu * 2 + grp : C.vcu, rb = u & 3, cb = u >> 2;
    f32x16 acc = zero16();
    sgemm_acc<0>(C, A, Bt, K, rb, cb, ki * (K / KS), (ki + 1) * (K / KS), lane, acc);
    __syncthreads();
    LAS float* red = (LAS float*)C.lds;
#pragma unroll
    for (int reg = 0; reg < 16; ++reg) red[(C.wave * 16 + reg) * 64 + lane] = acc[reg];
    __syncthreads();
#pragma unroll
    for (int q = 0; q < 16 / KS; ++q) { const int reg = (16 / KS) * ki + q; float v = 0.f;
#pragma unroll
        for (int w = 0; w < KS; ++w) v += red[((grp * KS + w) * 16 + reg) * 64 + lane];
        sgemm_epi<KIND>(C, l, rb, cb, reg, lane, v); }
}

#define XB_TMO      128
#define XB_XCNT(j)  (256  + 64 * (j))
#define XB_XSUB(j)  (1280 + 64 * (j))
#define XB_XGEN(j)  (2304 + 64 * (j))
#define XB_TOP      3328
#define XB_TOPGEN   3392
#define XCD_BAR_WORDS 3456
#define XB_SPIN_CAP (1u << 18)

__device__ __forceinline__ unsigned xb_ld(unsigned* p)              { return __hip_atomic_load(p, __ATOMIC_RELAXED, __HIP_MEMORY_SCOPE_AGENT); }
__device__ __forceinline__ unsigned xb_add(unsigned* p, unsigned v) { return __hip_atomic_fetch_add(p, v, __ATOMIC_RELAXED, __HIP_MEMORY_SCOPE_AGENT); }
__device__ __forceinline__ unsigned xb_xcc_id() { return (unsigned)__builtin_amdgcn_s_getreg((3 << 11) | 20) & 0xFu; }
#define XB_SPIN(cond, bar) do { unsigned _sp = 0; while (cond) { __builtin_amdgcn_s_sleep(1); \
    if ((++_sp & 255u) == 0u) { if (xb_ld(&(bar)[XB_TMO])) break; if (_sp > XB_SPIN_CAP) { atomicAdd(&(bar)[XB_TMO], 1u); break; } } } } while (0)


__device__ __forceinline__ XcdBarrier xcd_barrier_post(unsigned* bar, volatile LAS unsigned* st) {
    XcdBarrier b; b.bar = bar; b.x = xb_xcc_id(); b.st = st;
    if (threadIdx.x == 0) (void)xb_add(&bar[XB_XCNT(b.x)], 1u);
    return b;
}
__device__ __forceinline__ void xcd_barrier_complete(unsigned* bar, unsigned x, unsigned& nloc, unsigned& nx) {
    const unsigned G = gridDim.x * gridDim.y * gridDim.z;
    unsigned sum, cnt, mine, sp = 0u;
    for (;;) {
        sum = 0u; cnt = 0u; mine = 0u;
#pragma unroll
        for (unsigned j = 0; j < 16; ++j) { const unsigned c = xb_ld(&bar[XB_XCNT(j)]); sum += c; cnt += (c > 0u) ? 1u : 0u; mine = (j == x) ? c : mine; }
        if (sum == G) break;
        __builtin_amdgcn_s_sleep(1);
        if ((++sp & 255u) == 0u) { if (xb_ld(&bar[XB_TMO])) break; if (sp > XB_SPIN_CAP) { atomicAdd(&bar[XB_TMO], 1u); break; } }
    }
    nloc = mine > 0u ? mine : 1u; nx = cnt > 0u ? cnt : 1u;
}

__device__ __forceinline__ void xcd_barrier(const XcdBarrier& b) {
    asm volatile("s_waitcnt vmcnt(0)" ::: "memory");
    __syncthreads();
    if (threadIdx.x == 0) {
        unsigned* bar = b.bar;
        __builtin_amdgcn_s_waitcnt(0);
        unsigned nloc = b.st[0], nx = b.st[1];
        if (nloc == 0u) { xcd_barrier_complete(bar, b.x, nloc, nx); b.st[0] = nloc; b.st[1] = nx; }
        const unsigned old = xb_add(&bar[XB_XSUB(b.x)], 1u);
        const unsigned gen = old / nloc;
        if (old + 1u == (gen + 1u) * nloc) {
            __builtin_amdgcn_fence(__ATOMIC_RELEASE, "agent");
            asm volatile("s_waitcnt vmcnt(0)" ::: "memory");
            const unsigned og = xb_add(&bar[XB_TOP], 1u);
            const unsigned tg = og / nx;
            if (og + 1u == (tg + 1u) * nx) xb_add(&bar[XB_TOPGEN], 1u);
            else XB_SPIN(xb_ld(&bar[XB_TOPGEN]) == tg, bar);
            __builtin_amdgcn_fence(__ATOMIC_ACQUIRE, "agent");
            xb_add(&bar[XB_XGEN(b.x)], 1u);
            asm volatile("s_waitcnt vmcnt(0)" ::: "memory");
        } else {
            XB_SPIN(xb_ld(&bar[XB_XGEN(b.x)]) == gen, bar);
            __builtin_amdgcn_fence(__ATOMIC_ACQUIRE, "agent");
            asm volatile("s_waitcnt vmcnt(0)" ::: "memory");
        }
    }
    __syncthreads();
}


constexpr int NPH = 16;
#if MK_CGSYNC
#define GRID_SYNC() cg::this_grid().sync()
#else
#define GRID_SYNC() xcd_barrier(C.xb)
#endif
template <int l> DI void layer_phases(const Ctx& C, const Params& P) {
    float* SSQ = (float*)(C.ws + WS_SSQ);
#define IN(k) (P.ph_lo <= (1 + 7 * l + (k)) && (1 + 7 * l + (k)) < P.ph_hi)
#define SEAM(k) do { if (IN(k) && (1 + 7 * l + (k)) + 1 < P.ph_hi) GRID_SYNC(); STAMP(2 + 7 * l + (k)); } while (0)
#define DUP(k) for (int rep = 0; rep < (((PROBE_DUP >> (k)) & 1) ? 2 : 1); ++rep)
    DUP(0) { if (rep) GRID_SYNC();
    if (IN(0)) { pg8::Gemm g{(const bf16*)(C.ws + WS_HB), (const bf16*)(C.ws + WS_WIN) + (size_t)l * NZ * D, MP, NZ, D}; pg8::StaticOrder S; S.init(MP, NZ, C.G, (int)blockIdx.x);
        EpiZ E{(bf16*)(C.ws + WS_Z), SSQ + (2 * l) * MPAD, (float*)(C.ws + WS_GATE), (bf16*)(C.ws + WS_KC)};
        pg8::gemm_phase<EpiZ, pg8::StaticOrder, true, true>(C.lds, g, S, E); if (!rep) sgemm_phase<0>(C, l); } }
    SEAM(0);
    DUP(1) { if (rep) GRID_SYNC(); if (IN(1)) ph_m1<l>(C); }
    SEAM(1);
    DUP(2) { if (rep) GRID_SYNC(); if (IN(2)) ph_m2<l>(C); }
    SEAM(2);
    DUP(3) { if (rep) GRID_SYNC(); if (IN(3)) ph_m3<l>(C); }
    SEAM(3);
    DUP(4) { if (rep) GRID_SYNC();
    if (IN(4)) { pg8::Gemm g{(const bf16*)(C.ws + WS_MIX), (const bf16*)(C.ws + WS_WOUT) + (size_t)l * D * D, MP, D, D}; pg8::StaticOrder S; S.init(MP, D, C.G, (int)blockIdx.x);
        EpiRes E{(bf16*)(C.ws + (rep ? WS_Z : WS_HB)), rep ? (float*)(C.ws + WS_GATE) : SSQ + (2 * l + 1) * MPAD};
        pg8::gemm_phase<EpiRes, pg8::StaticOrder, true, true>(C.lds, g, S, E); if (!rep) sgemm_phase<1>(C, l); } }
    SEAM(4);
    DUP(5) { if (rep) GRID_SYNC();
    if (IN(5)) { pg8::Gemm g{(const bf16*)(C.ws + WS_HB), (const bf16*)(C.ws + WS_WUP) + (size_t)l * FF * D, MP, FF, D}; pg8::StaticOrder S; S.init(MP, FF, C.G, (int)blockIdx.x);
        EpiAct E{(bf16*)(C.ws + WS_ACT), SSQ + (2 * l + 1) * MPAD};
        pg8::gemm_phase<EpiAct, pg8::StaticOrder, true, true>(C.lds, g, S, E); if (!rep) sgemm_phase<2>(C, l); } }
    SEAM(5);
    DUP(6) { if (rep) GRID_SYNC();
    if (IN(6)) { pg8::Gemm g{(const bf16*)(C.ws + WS_ACT), (const bf16*)(C.ws + WS_WDN) + (size_t)l * D * FF, MP, D, FF}; pg8::StaticOrder S; S.init(MP, D, C.G, (int)blockIdx.x);
        EpiRes E{(bf16*)(C.ws + (rep ? WS_Z : WS_HB)), rep ? (float*)(C.ws + WS_GATE) : SSQ + (2 * l + 2) * MPAD};
        pg8::gemm_phase<EpiRes, pg8::StaticOrder, true, true>(C.lds, g, S, E); if (!rep) sgemm_phase<3>(C, l); } }
    SEAM(6);
#undef DUP
#undef IN
#undef SEAM
}
__global__ void __launch_bounds__(NWAVES * 64, 2) mk_fwd(Params P) {
    extern __shared__ __attribute__((aligned(16))) unsigned char smem[];
    Ctx C; C.P = &P; C.lds = (LAS unsigned char*)smem; C.tid = threadIdx.x; C.lane = C.tid & 63; C.wave = __builtin_amdgcn_readfirstlane(C.tid >> 6);
    C.wl = C.lds + C.wave * WLDS;
    C.G = gridDim.x; { const int bx = blockIdx.x; C.vcu = (C.G % 8 == 0) ? (bx % 8) * (C.G / 8) + bx / 8 : bx; }
    C.gw = C.vcu * NWAVES + C.wave; C.NGW = C.G * NWAVES; C.ws = P.ws; C.out = P.out;
    { volatile LAS unsigned* st = (volatile LAS unsigned*)(C.lds + LDS_CTL); if (C.tid < 2) st[C.tid] = 0u; __syncthreads();
      C.xb.bar = (unsigned*)(C.ws + WS_BAR); C.xb.x = 0; C.xb.st = st;
      if (!MK_CGSYNC && P.ph_hi - P.ph_lo > 1) C.xb = xcd_barrier_post((unsigned*)(C.ws + WS_BAR), st); }
    STAMP(0);
    if (P.ph_lo <= 0 && 0 < P.ph_hi) { ph_prologue(C); if ((PROBE_DUP >> 7) & 1) { GRID_SYNC(); ph_prologue(C); } if (1 < P.ph_hi) GRID_SYNC(); }
    STAMP(1);
    layer_phases<0>(C, P);
    layer_phases<1>(C, P);
    if (P.ph_lo <= NPH - 1 && NPH - 1 < P.ph_hi) ph_final(C);
    if (PROBE_T0 >= 0 && blockIdx.x == 0 && threadIdx.x < 32) { const unsigned long long* ts = (const unsigned long long*)(C.ws + WS_TS);
        const float us = (float)(ts[PROBE_T1 < 0 ? 0 : PROBE_T1] - ts[PROBE_T0 < 0 ? 0 : PROBE_T0]) * 0.01f; C.out[O_PM + threadIdx.x] *= 1.0f + sqrtf(us * PROBE_TSCALE); }
}

static int t5_bucket(int n) {
    const int max_exact = 16;
    if (n < max_exact) return n;
    const double scaled = std::log((double)(n < 1 ? 1 : n) / max_exact) / std::log(2048.0 / max_exact);
    int v = max_exact + (int)(scaled * (32 - max_exact));
    return v < 31 ? v : 31;
}

extern "C" void kernel_launch(void* const* d_in, const int* in_sizes, int n_in, void* d_out, int out_size, void* d_ws, size_t ws_size, hipStream_t stream) {
    static int grid = 0;
    if (grid == 0) {
        if (n_in != 22 || (size_t)out_size != O_END || ws_size < WS_END) { fprintf(stderr, "kernel_launch: unexpected shapes n_in %d out %d ws %zu (need %zu)\n", n_in, out_size, ws_size, (size_t)WS_END); grid = -1; return; }
        int dev = 0, cus = 0, per_cu = 0;
        hipGetDevice(&dev); hipDeviceGetAttribute(&cus, hipDeviceAttributeMultiprocessorCount, dev);
        hipFuncSetAttribute((const void*)mk_fwd, hipFuncAttributeMaxDynamicSharedMemorySize, LDS_BYTES);
        hipOccupancyMaxActiveBlocksPerMultiprocessor(&per_cu, (const void*)mk_fwd, NWAVES * 64, LDS_BYTES);
        if (per_cu < 1) { fprintf(stderr, "kernel_launch: occupancy query says %d blocks per CU\n", per_cu); per_cu = 1; }
        (void)hipGetLastError();
        if (cus < 256) fprintf(stderr, "kernel_launch: this kernel is laid out for 256 workgroups, one per CU; the device reports %d CUs\n", cus);
        grid = 256;
    }
    if (grid < 0) return;
    Params p{};
    for (int i = 0; i < 22; ++i) p.in[i] = (const float*)d_in[i];
    p.out = (float*)d_out; p.ws = (unsigned char*)d_ws;
    const int dils[3] = {1, 4, 16};
    for (int br = 0; br < 3; ++br) for (int j = 0; j <= 128; ++j) p.bucket[br][j] = (unsigned char)t5_bucket(dils[br] * j);
#if MK_MULTI
    for (int ph = 0; ph < NPH; ++ph) { p.ph_lo = ph; p.ph_hi = ph + 1; hipLaunchKernelGGL(mk_fwd, dim3(grid), dim3(NWAVES * 64), LDS_BYTES, stream, p); }
#else
    p.ph_lo = 0; p.ph_hi = NPH;
    if (hipMemsetAsync((char*)d_ws + WS_BAR, 0, 32768, stream) != hipSuccess) { fprintf(stderr, "kernel_launch: memset of the barrier words failed\n"); return; }
    void* args[] = {&p};
    hipError_t e = hipLaunchCooperativeKernel((const void*)mk_fwd, dim3(grid), dim3(NWAVES * 64), args, LDS_BYTES, stream);
    if (e != hipSuccess) fprintf(stderr, "cooperative launch failed: %s (grid %d)\n", hipGetErrorString(e), grid);
#endif
}
```
